# Optimizing an MI355X kernel written in HIP

```python
import jax
import jax.numpy as jnp
from jax import lax
import numpy as np


D_MODEL = 1024
BATCH = 4
SEQ = 4096
DEPTH = 2

GRID_W = 64
CTX_LEN = 256
MLA_HEADS = 8
MLA_NOPE = 64
MLA_ROPE = 32
MLA_QK = MLA_NOPE + MLA_ROPE
MLA_V = 64
Q_LORA = 256
KV_LORA = 128
GQA_HEADS = 8
GQA_KV_HEADS = 2
GQA_GROUP = GQA_HEADS // GQA_KV_HEADS
GQA_HD = 64
N_EXPERTS = 16
N_GROUPS = 4
EXPERTS_PER_GROUP = N_EXPERTS // N_GROUPS
TOP_K = 2
FF_EXPERT = 512
FF_SHARED = 512
ROPE_THETA = 10000.0
EPS = 1e-6
Q_BLOCK = 128
IN_SIZES = (Q_LORA, KV_LORA, MLA_ROPE, GQA_HEADS * GQA_HD, GQA_KV_HEADS * GQA_HD, GQA_KV_HEADS * GQA_HD, 2 * D_MODEL)
IN_COLS = Q_LORA + KV_LORA + MLA_ROPE + GQA_HEADS * GQA_HD + 2 * GQA_KV_HEADS * GQA_HD + 2 * D_MODEL

kernel_name = 'hybrid_mla_gqa_grouped_moe_dit_block'


def rmsnorm(x, g):
    xf = x.astype(jnp.float32)
    y = xf * lax.rsqrt(jnp.mean(xf * xf, axis=-1, keepdims=True) + EPS)
    return (y * g.astype(jnp.float32)).astype(x.dtype)


def modulate(h, shift, scale):
    return h * (1 + scale[:, None, :]) + shift[:, None, :]


def axial_angles(pos, half_dim):
    inv = ROPE_THETA ** (-jnp.arange(0, half_dim, 2, dtype=jnp.float32) / half_dim)
    return pos.astype(jnp.float32)[:, None] * inv[None, :]


def rotate(x, ang):
    cos = jnp.cos(ang)[None, :, None, :].astype(x.dtype)
    sin = jnp.sin(ang)[None, :, None, :].astype(x.dtype)
    x1, x2 = jnp.split(x, 2, axis=-1)
    return jnp.concatenate([x1 * cos - x2 * sin, x1 * sin + x2 * cos], axis=-1)


def rope_2d(x, ang_row, ang_col):
    xr, xc = jnp.split(x, 2, axis=-1)
    return jnp.concatenate([rotate(xr, ang_row), rotate(xc, ang_col)], axis=-1)


def attend(q, k, v, scale):
    b, n, hk, g, d = q.shape
    nb = n // Q_BLOCK
    qb = q.reshape(b, nb, Q_BLOCK, hk, g, d).transpose(1, 0, 2, 3, 4, 5)

    def one_block(qi):
        s = jnp.einsum('bqhgd,bkhd->bhgqk', qi, k).astype(jnp.float32) * scale
        p = jax.nn.softmax(s, axis=-1).astype(v.dtype)
        return jnp.einsum('bhgqk,bkhe->bqhge', p, v)

    o = lax.map(one_block, qb)
    return o.transpose(1, 0, 2, 3, 4, 5).reshape(b, n, hk * g * v.shape[-1])


def mixer_inputs(h, w_in_l, g_cq_l, w_uq_l, g_ckv_l, w_ukv_l, g_qa_l, g_ka_l, g_qb_l, g_kb_l, angles):
    b, n, _ = h.shape
    proj = h @ w_in_l
    splits = [int(s) for s in np.cumsum(IN_SIZES)[:-1]]
    cq, ckv, kr, qb, kb, vb, gts = jnp.split(proj, splits, axis=-1)
    qa = (rmsnorm(cq, g_cq_l) @ w_uq_l).reshape(b, n, MLA_HEADS, MLA_QK)
    kva = (rmsnorm(ckv, g_ckv_l) @ w_ukv_l).reshape(b, n, MLA_HEADS, MLA_NOPE + MLA_V)
    k_nope, va = jnp.split(kva, [MLA_NOPE], axis=-1)
    k_rope = jnp.broadcast_to(kr[:, :, None, :], (b, n, MLA_HEADS, MLA_ROPE))
    ka = jnp.concatenate([k_nope, k_rope], axis=-1)
    qa = rmsnorm(qa, g_qa_l)
    ka = rmsnorm(ka, g_ka_l)
    qb = rmsnorm(qb.reshape(b, n, GQA_HEADS, GQA_HD), g_qb_l)
    kb = rmsnorm(kb.reshape(b, n, GQA_KV_HEADS, GQA_HD), g_kb_l)
    vb = vb.reshape(b, n, GQA_KV_HEADS, GQA_HD)
    if angles is not None:
        ar_a, ac_a, ar_b, ac_b = angles
        qa = jnp.concatenate([qa[..., :MLA_NOPE], rope_2d(qa[..., MLA_NOPE:], ar_a, ac_a)], axis=-1)
        ka = jnp.concatenate([ka[..., :MLA_NOPE], rope_2d(ka[..., MLA_NOPE:], ar_a, ac_a)], axis=-1)
        qb = rope_2d(qb, ar_b, ac_b)
        kb = rope_2d(kb, ar_b, ac_b)
    qa = qa[:, :, :, None, :]
    qb = qb.reshape(b, n, GQA_KV_HEADS, GQA_GROUP, GQA_HD)
    ga, gb = jnp.split(gts, 2, axis=-1)
    return (qa, ka, va, qb, kb, vb, ga, gb)


def merge_branches(oa, ob, ga, gb, w_oa_l, w_ob_l, w_out_l):
    y = jax.nn.sigmoid(ga) * (oa @ w_oa_l) + jax.nn.sigmoid(gb) * (ob @ w_ob_l)
    return y @ w_out_l


def swiglu(h, wg, wu, wd):
    return (jax.nn.silu(h @ wg) * (h @ wu)) @ wd


def moe(h, w_router, b_router, wg, wu, wd, sg, su, sd):
    scores = jax.nn.sigmoid(jnp.einsum('bnd,de->bne', h, w_router).astype(jnp.float32))
    sel = scores + b_router.astype(jnp.float32)
    grp = sel.reshape(sel.shape[:-1] + (N_GROUPS, EXPERTS_PER_GROUP))
    grp_score = lax.top_k(grp, TOP_K)[0].sum(axis=-1)
    best = jnp.argmax(grp_score, axis=-1)
    gmask = jnp.arange(N_GROUPS)[None, None, :] == best[..., None]
    masked = jnp.where(gmask[..., None], grp, -jnp.inf).reshape(sel.shape)
    _, idx = lax.top_k(masked, TOP_K)
    w = jnp.take_along_axis(scores, idx, axis=-1)
    w = w / jnp.sum(w, axis=-1, keepdims=True)
    gate = jnp.sum(jax.nn.one_hot(idx, N_EXPERTS, dtype=jnp.float32) * w[..., None], axis=-2).astype(h.dtype)
    y = swiglu(h, sg, su, sd)
    for e in range(N_EXPERTS):
        y = y + gate[..., e:e + 1] * swiglu(h, wg[e], wu[e], wd[e])
    return y


def setup_inputs(seed: int = 0) -> dict:
    key = jax.random.key(seed)
    ks = jax.random.split(key, 32)
    f32 = jnp.float32

    def nrm(k, shape, fan_in, mult=1.0):
        return jax.random.normal(k, shape, f32) * (mult * fan_in ** -0.5)

    def gain(k, shape):
        return 1.0 + 0.02 * jax.random.normal(k, shape, f32)

    L = DEPTH
    return {
        'x': jax.random.normal(ks[0], (BATCH, SEQ, D_MODEL), f32),
        'c': jax.random.normal(ks[1], (BATCH, D_MODEL), f32),
        'ctx': jax.random.normal(ks[2], (BATCH, CTX_LEN, D_MODEL), f32),
        'c_ctx': jax.random.normal(ks[3], (D_MODEL,), f32),
        'w_mod': nrm(ks[4], (L, D_MODEL, 6 * D_MODEL), D_MODEL, 0.5),
        'b_mod': 0.02 * jax.random.normal(ks[5], (L, 6 * D_MODEL), f32),
        'g_attn': gain(ks[6], (L, D_MODEL)),
        'g_ffn': gain(ks[7], (L, D_MODEL)),
        'w_in': nrm(ks[8], (L, D_MODEL, IN_COLS), D_MODEL),
        'g_cq': gain(ks[9], (L, Q_LORA)),
        'w_uq': nrm(ks[10], (L, Q_LORA, MLA_HEADS * MLA_QK), Q_LORA),
        'g_ckv': gain(ks[11], (L, KV_LORA)),
        'w_ukv': nrm(ks[12], (L, KV_LORA, MLA_HEADS * (MLA_NOPE + MLA_V)), KV_LORA),
        'g_qa': gain(ks[13], (L, MLA_QK)),
        'g_ka': gain(ks[14], (L, MLA_QK)),
        'g_qb': gain(ks[15], (L, GQA_HD)),
        'g_kb': gain(ks[16], (L, GQA_HD)),
        'w_oa': nrm(ks[17], (L, MLA_HEADS * MLA_V, D_MODEL), MLA_HEADS * MLA_V),
        'w_ob': nrm(ks[18], (L, GQA_HEADS * GQA_HD, D_MODEL), GQA_HEADS * GQA_HD),
        'w_out': nrm(ks[19], (L, D_MODEL, D_MODEL), D_MODEL),
        'w_router': nrm(ks[20], (D_MODEL, N_EXPERTS), D_MODEL),
        'b_router': 0.01 * jax.random.normal(ks[21], (N_EXPERTS,), f32),
        'w_e_gate': nrm(ks[22], (L, N_EXPERTS, D_MODEL, FF_EXPERT), D_MODEL),
        'w_e_up': nrm(ks[23], (L, N_EXPERTS, D_MODEL, FF_EXPERT), D_MODEL),
        'w_e_down': nrm(ks[24], (L, N_EXPERTS, FF_EXPERT, D_MODEL), FF_EXPERT),
        'w_s_gate': nrm(ks[25], (L, D_MODEL, FF_SHARED), D_MODEL),
        'w_s_up': nrm(ks[26], (L, D_MODEL, FF_SHARED), D_MODEL),
        'w_s_down': nrm(ks[27], (L, FF_SHARED, D_MODEL), FF_SHARED),
    }


def reference(x, c, ctx, c_ctx, w_mod, b_mod, g_attn, g_ffn, w_in, g_cq, w_uq, g_ckv, w_ukv,
              g_qa, g_ka, g_qb, g_kb, w_oa, w_ob, w_out, w_router, b_router,
              w_e_gate, w_e_up, w_e_down, w_s_gate, w_s_up, w_s_down):
    n_lat = x.shape[1]
    n_ctx = ctx.shape[1]
    rows_n = n_lat // GRID_W
    rows = jnp.broadcast_to(jnp.arange(rows_n)[:, None], (rows_n, GRID_W)).reshape(-1)
    cols = jnp.broadcast_to(jnp.arange(GRID_W)[None, :], (rows_n, GRID_W)).reshape(-1)
    angles = (axial_angles(rows, MLA_ROPE // 2), axial_angles(cols, MLA_ROPE // 2),
              axial_angles(rows, GQA_HD // 2), axial_angles(cols, GQA_HD // 2))
    scale_a = MLA_QK ** -0.5
    scale_b = GQA_HD ** -0.5

    for l in range(DEPTH):
        last = l == DEPTH - 1
        mod_l = jax.nn.silu(c) @ w_mod[l] + b_mod[l]
        mod_c = jax.nn.silu(c_ctx)[None, :] @ w_mod[l] + b_mod[l]
        sh1_l, sc1_l, gt1_l, sh2_l, sc2_l, gt2_l = jnp.split(mod_l, 6, axis=-1)
        sh1_c, sc1_c, gt1_c, sh2_c, sc2_c, gt2_c = jnp.split(mod_c, 6, axis=-1)
        wl = (w_in[l], g_cq[l], w_uq[l], g_ckv[l], w_ukv[l], g_qa[l], g_ka[l], g_qb[l], g_kb[l])

        h_l = modulate(rmsnorm(x, g_attn[l]), sh1_l, sc1_l)
        h_c = modulate(rmsnorm(ctx, g_attn[l]), sh1_c, sc1_c)
        qa_l, ka_l, va_l, qb_l, kb_l, vb_l, ga_l, gb_l = mixer_inputs(h_l, *wl, angles)
        qa_c, ka_c, va_c, qb_c, kb_c, vb_c, ga_c, gb_c = mixer_inputs(h_c, *wl, None)
        oa_l = attend(qa_l, jnp.concatenate([ka_c, ka_l], axis=1), jnp.concatenate([va_c, va_l], axis=1), scale_a)
        ob_l = attend(qb_l, jnp.concatenate([kb_c, kb_l], axis=1), jnp.concatenate([vb_c, vb_l], axis=1), scale_b)
        x_new = x + gt1_l[:, None, :] * merge_branches(oa_l, ob_l, ga_l, gb_l, w_oa[l], w_ob[l], w_out[l])
        if not last:
            oa_c = attend(qa_c, ka_c, va_c, scale_a)
            ob_c = attend(qb_c, kb_c, vb_c, scale_b)
            ctx = ctx + gt1_c[:, None, :] * merge_branches(oa_c, ob_c, ga_c, gb_c, w_oa[l], w_ob[l], w_out[l])
        x = x_new

        e_args = (w_router, b_router, w_e_gate[l], w_e_up[l], w_e_down[l], w_s_gate[l], w_s_up[l], w_s_down[l])
        f_l = modulate(rmsnorm(x, g_ffn[l]), sh2_l, sc2_l)
        if not last:
            f_c = modulate(rmsnorm(ctx, g_ffn[l]), sh2_c, sc2_c)
            y_all = moe(jnp.concatenate([f_c, f_l], axis=1), *e_args)
            ctx = ctx + gt2_c[:, None, :] * y_all[:, :n_ctx]
            x = x + gt2_l[:, None, :] * y_all[:, n_ctx:]
        else:
            x = x + gt2_l[:, None, :] * moe(f_l, *e_args)
    return x
```

```cpp
#define REPMASK 0x00
#define BARX 1
#include <hip/hip_runtime.h>
#ifdef MK_PER_PHASE
#define MK_PER_PHASE_ MK_PER_PHASE
#else
#define MK_PER_PHASE_ 0
#endif
#include <cstdio>
#include <cstdint>

#define GAS __attribute__((address_space(1)))
#define LAS __attribute__((address_space(3)))
typedef unsigned short bf16;
typedef short bf16x8 __attribute__((ext_vector_type(8)));
typedef short s16x4 __attribute__((ext_vector_type(4)));
typedef float f32x2 __attribute__((ext_vector_type(2)));
typedef float f32x4 __attribute__((ext_vector_type(4)));
typedef float f32x16 __attribute__((ext_vector_type(16)));
typedef unsigned u32x2 __attribute__((ext_vector_type(2)));
typedef unsigned u32x4 __attribute__((ext_vector_type(4)));

constexpr int DM = 1024, NB = 4, SEQ = 4096, CTXL = 256, NLAYER = 2;
constexpr int TC = NB * CTXL;
constexpr int TL = NB * SEQ;
constexpr int T = TC + TL;
constexpr int LK = CTXL + SEQ;
constexpr int INC = 3232, INCP = 3328;
constexpr int C_CQ = 0, C_CKV = 256, C_KR = 384, C_QB = 416, C_KB = 928, C_VB = 1056, C_GA = 1184, C_GB = 2208;
constexpr int PQ8 = 1024, PK8 = 1536, PV8 = 1664;
constexpr int PROW = INCP * 2, GA8 = 2560, GB8 = 3584;
constexpr int NEXP = 16, FF = 512;
constexpr float EPS = 1e-6f;
constexpr float LOG2E = 1.4426950408889634f;
constexpr float SCA = 0.10206207261596575f * LOG2E;
constexpr float SCB = 0.125f * LOG2E;
constexpr int NWAVES = 8, NTHR = 512;

constexpr size_t MiB = 1u << 20;
constexpr size_t WS_CTL = 0, CTL_ZERO_BYTES = (MK_PER_PHASE_ ? 1024 : 64) * 1024;
constexpr size_t WS_MISC = 1 * MiB;
constexpr size_t WS_CTXS = 2 * MiB;
constexpr size_t WS_ROUTE = 6 * MiB;
constexpr size_t WS_W = 9 * MiB;
constexpr size_t WS_R1 = 73 * MiB;
constexpr size_t WS_R2 = 107 * MiB;
constexpr size_t WS_R3 = 218 * MiB;
constexpr size_t WS_R4 = 286 * MiB;
constexpr size_t WS_R5 = 312 * MiB;
constexpr size_t WS_END = 346 * MiB;
constexpr size_t MO_MODV = 0;
constexpr size_t MO_TABA = 256 * 1024;
constexpr size_t MO_TABB = MO_TABA + 4096;
constexpr size_t MO_CB = MO_TABB + 8192;
constexpr size_t RO_LISTE = 0;
constexpr size_t RO_ROWW = (size_t)NEXP * T * 4;
constexpr size_t RO_TOKPOS = 2 * RO_ROWW;
constexpr size_t WO_IN = 0;
constexpr size_t WO_UQ = WO_IN + (size_t)INCP * 1024 / 2;
constexpr size_t WO_UKV = WO_UQ + 768 * 256;
constexpr size_t WO_OA = WO_UKV + 1024 * 256;
constexpr size_t WO_OUT = WO_OA + 1024 * 1024 / 2;
constexpr size_t WO_GU = WO_OUT + 1024 * 1024 / 2;
constexpr size_t WO_DN = WO_GU + (size_t)17 * 1024 * 1024 / 2;
constexpr size_t WO_END = WO_DN + (size_t)17 * 1024 * 512 / 2;
constexpr size_t WL_STRIDE = 16 * MiB;
static_assert(WO_END <= WL_STRIDE && WS_W + 2 * WL_STRIDE * 2 <= WS_R1, "weights region");
constexpr size_t R3_KA = 0, R3_VA = (size_t)T * 1024, R3_QB = R3_VA + (size_t)T * 512 * 2, R3_KB = R3_QB + (size_t)T * 512, R3_VB = R3_KB + (size_t)T * 128, R3_QA = R3_VB + (size_t)T * 128 * 2;
constexpr size_t R3_Y1 = 0, R3_Y = (size_t)T * 1024 * 2, R3_HH = 0;
constexpr int HHROWS = 3 * T + 17 * 256;
static_assert(R3_QA + (size_t)T * 1024 <= 68 * MiB && (size_t)HHROWS * 512 * 2 <= 68 * MiB && (size_t)HHROWS * 1024 * 2 <= 111 * MiB, "regions");
constexpr int CW_STEAL = 512;
constexpr int CW_CNT = 1024;
constexpr int CW_BAR = 4096;

constexpr int RING_BYTES = 131072;
constexpr int LDSX_OFF = RING_BYTES;
constexpr int LDSX_GTAB = LDSX_OFF;
constexpr int LDSX_PFX = LDSX_OFF + 8192;
constexpr int LDSX_MISC = LDSX_OFF + 8192 + 256;
constexpr int LDS_BYTES = 147456;

__device__ __forceinline__ unsigned f2bf(float f) { unsigned u = __builtin_bit_cast(unsigned, f); return (u + 0x7fffu + ((u >> 16) & 1u)) >> 16; }
typedef __bf16 bf16x2_hw __attribute__((ext_vector_type(2)));
__device__ __forceinline__ unsigned pk2(float lo, float hi) { const f32x2 v = {lo, hi}; return __builtin_bit_cast(unsigned, __builtin_convertvector(v, bf16x2_hw)); }
__device__ __forceinline__ unsigned pk4_fp8(float a, float b, float c, float d) { int w = 0; w = __builtin_amdgcn_cvt_pk_fp8_f32(a, b, w, false); w = __builtin_amdgcn_cvt_pk_fp8_f32(c, d, w, true); return (unsigned)w; }
constexpr int I8_AEXP = 4, I8_WEXP = 9;
__device__ __forceinline__ unsigned pk4_i8(float a, float b, float c, float d, float scl) {
    const float M = 12582912.0f;
    const unsigned qa = __builtin_bit_cast(unsigned, __builtin_amdgcn_fmed3f(a * scl, -127.f, 127.f) + M), qb = __builtin_bit_cast(unsigned, __builtin_amdgcn_fmed3f(b * scl, -127.f, 127.f) + M);
    const unsigned qc = __builtin_bit_cast(unsigned, __builtin_amdgcn_fmed3f(c * scl, -127.f, 127.f) + M), qd = __builtin_bit_cast(unsigned, __builtin_amdgcn_fmed3f(d * scl, -127.f, 127.f) + M);
    const unsigned lo = __builtin_amdgcn_perm(qb, qa, 0x0c0c0400u), hi = __builtin_amdgcn_perm(qd, qc, 0x0c0c0400u);
    return __builtin_amdgcn_perm(hi, lo, 0x05040100u);
}
__device__ __forceinline__ unsigned pk4_fp8_sat(float a, float b, float c, float d) {
    return pk4_fp8(__builtin_amdgcn_fmed3f(a, -448.f, 448.f), __builtin_amdgcn_fmed3f(b, -448.f, 448.f), __builtin_amdgcn_fmed3f(c, -448.f, 448.f), __builtin_amdgcn_fmed3f(d, -448.f, 448.f)); }
constexpr int FP8_WEXP = 5;
constexpr int FP8_AEXP = 3;
__device__ __forceinline__ float bflo(unsigned w) { return __builtin_bit_cast(float, w << 16); }
__device__ __forceinline__ float bfhi(unsigned w) { return __builtin_bit_cast(float, w & 0xffff0000u); }
template <int CTRL> __device__ __forceinline__ float dppf(float v) { return __builtin_bit_cast(float, __builtin_amdgcn_update_dpp(0, __builtin_bit_cast(int, v), CTRL, 0xF, 0xF, true)); }
#define DPP_X1 0xB1
#define DPP_X2 0x4E
#define DPP_HM 0x141
#define DPP_RM 0x140
__device__ __forceinline__ float rlane(float v, int l) { return __builtin_bit_cast(float, __builtin_amdgcn_readlane(__builtin_bit_cast(int, v), l)); }
__device__ __forceinline__ float row_sum16(float v) { v += dppf<DPP_X1>(v); v += dppf<DPP_X2>(v); v += dppf<DPP_HM>(v); v += dppf<DPP_RM>(v); return v; }
__device__ __forceinline__ float wave_sum(float v, int) { v = row_sum16(v); return (rlane(v, 0) + rlane(v, 16)) + (rlane(v, 32) + rlane(v, 48)); }
__device__ __forceinline__ float sum8(float v, int) { v += dppf<DPP_X1>(v); v += dppf<DPP_X2>(v); v += dppf<DPP_HM>(v); return v; }
__device__ __forceinline__ float shx(float v, int lane, int o) { return __builtin_bit_cast(float, __builtin_amdgcn_ds_bpermute((lane ^ o) << 2, __builtin_bit_cast(int, v))); }
__device__ __forceinline__ float sigmoidf_(float x) { return __builtin_amdgcn_rcpf(1.0f + __builtin_amdgcn_exp2f(-x * LOG2E)); }
__device__ __forceinline__ f32x4 sigmoid4(f32x4 x) {
    const f32x4 t = x * (-LOG2E); f32x4 e; e.x = __builtin_amdgcn_exp2f(t.x); e.y = __builtin_amdgcn_exp2f(t.y); e.z = __builtin_amdgcn_exp2f(t.z); e.w = __builtin_amdgcn_exp2f(t.w);
    const f32x4 d = e + 1.0f; f32x4 r; r.x = __builtin_amdgcn_rcpf(d.x); r.y = __builtin_amdgcn_rcpf(d.y); r.z = __builtin_amdgcn_rcpf(d.z); r.w = __builtin_amdgcn_rcpf(d.w); return r;
}
#define LDS_WAIT() asm volatile("s_waitcnt lgkmcnt(0)" ::: "memory")
#define VM_WAIT() asm volatile("s_waitcnt vmcnt(0)" ::: "memory")

namespace pg8 {
constexpr int BM = 256, BK = 64, HALF = 128, HTB = HALF * BK * 2, STAGE_BYTES = 8 * HTB, NXCD = 8, WGM = 8;
__device__ __forceinline__ int lds_byte(int r, int c) { const int st = (r >> 4) * 2 + (c >> 5), rr = r & 15, cc = c & 31, ob = rr * 64 + cc * 2; return st * 1024 + (ob ^ (((ob >> 9) & 1) << 5)); }
__device__ __forceinline__ void stage_rc(int b, int& R, int& C) { const int st = b / 1024, sb = b % 1024, swz = sb ^ (((sb >> 9) & 1) << 5); R = (st >> 1) * 16 + swz / 64; C = (st & 1) * 32 + (swz % 64) / 2; }
__device__ __forceinline__ int perm32(int rho) { const int n = rho >> 4, i = rho & 15; return 8 * (i >> 2) + 4 * n + (i & 3); }

struct Unit { int pm, pn, e, lt; };

struct StaticOrder {
    int nM, nN, nwg, G, c, lda, K;
    __device__ __forceinline__ void init(int M, int N, int G_, int c_, int lda_, int K_) { nM = M / BM; nN = N / BM; nwg = nM * nN; G = G_; c = c_; lda = lda_; K = K_; }
    __device__ __forceinline__ bool next(int i, Unit& u) const {
        const long L = (long)i * G + c; if (L >= nwg) return false;
        int wgid = (int)L; { const int q = nwg / NXCD, r = nwg % NXCD, xcd = wgid % NXCD, off = wgid / NXCD; wgid = (xcd < r ? xcd * (q + 1) : r * (q + 1) + (xcd - r) * q) + off; }
        const int nig = WGM * nN, gid = wgid / nig, fm = gid * WGM, gsz = (nM - fm) < WGM ? (nM - fm) : WGM;
        u.pm = fm + ((wgid % nig) % gsz); u.pn = (wgid % nig) / gsz; u.e = 0; u.lt = 0; return true;
    }
    __device__ __forceinline__ size_t a_off(const Unit& u) const { return (size_t)u.pm * BM * lda * 2; }
    __device__ __forceinline__ size_t b_off(const Unit& u) const { return (size_t)u.pn * BM * K * 2; }
};
struct GroupedOrder {
    const LAS int* pfx; int G, vcu, K; size_t estride;
    size_t a_stride;
    __device__ __forceinline__ bool next(int i, Unit& u) const {
        const int U = i * G + vcu, ntl = __builtin_amdgcn_readfirstlane(pfx[17]);
        if (U >= ntl * 4) return false;
        const int rt = U >> 2; int e = 0;
#pragma unroll
        for (int k = 1; k < 17; ++k) e += (rt >= __builtin_amdgcn_readfirstlane(pfx[k])) ? 1 : 0;
        u.pm = rt; u.pn = U & 3; u.e = e; u.lt = rt - __builtin_amdgcn_readfirstlane(pfx[e]); return true;
    }
    __device__ __forceinline__ size_t a_off(const Unit& u) const { return (size_t)u.pm * a_stride; }
    __device__ __forceinline__ size_t b_off(const Unit& u) const { return (size_t)u.e * estride + (size_t)u.pn * BM * K * 2; }
};

__device__ __forceinline__ unsigned cvt_pk_bf16(float lo, float hi) { unsigned r; asm volatile("v_cvt_pk_bf16_f32 %0, %1, %2" : "=v"(r) : "v"(lo), "v"(hi)); return r; }

#define OPAQ(x) asm volatile("" : "+v"(x))
struct EpiBf16 {
    static constexpr bool PERM = true, WIDE = false; static constexpr int NPRE = 0;
    bf16* O; int ldc;
    __device__ __forceinline__ void operator()(const f32x4 (&acc)[2][2][4][2], const Unit& u, int wr, int wc, int fr, int fq) const {
        char* base = (char*)(O + (size_t)u.pm * BM * ldc + u.pn * BM);
        unsigned off = (unsigned)((wr * 64 + fr) * ldc + wc * 32 + 8 * fq) * 2u; OPAQ(off);
#pragma unroll
        for (int ai = 0; ai < 2; ++ai)
#pragma unroll
          for (int m = 0; m < 4; ++m) {
#pragma unroll
            for (int bj = 0; bj < 2; ++bj) { const f32x4 v0 = acc[ai][bj][m][0], v1 = acc[ai][bj][m][1];
                u32x4 w; w.x = cvt_pk_bf16(v0[0], v0[1]); w.y = cvt_pk_bf16(v0[2], v0[3]); w.z = cvt_pk_bf16(v1[0], v1[1]); w.w = cvt_pk_bf16(v1[2], v1[3]);
                *(u32x4*)(base + off + bj * HALF * 2) = w; }
            off += (unsigned)((m == 3 ? 80 : 16) * ldc) * 2u; OPAQ(off); }
    }
};
struct EpiF8 {
    static constexpr bool PERM = true, WIDE = true; static constexpr int NPRE = 0;
    unsigned char* O; int ldc;
    __device__ __forceinline__ void operator()(const f32x4 (&acc)[2][2][4][2], const Unit& u, int wr, int wc, int fr, int fq) const {
        char* base = (char*)O + (size_t)u.pm * BM * ldc + u.pn * BM;
        unsigned off = (unsigned)((wr * 64 + fr) * ldc + wc * 64 + 16 * fq); OPAQ(off);
        constexpr float sa = (float)(1 << FP8_AEXP);
#pragma unroll
        for (int ai = 0; ai < 2; ++ai)
#pragma unroll
          for (int m = 0; m < 4; ++m) {
            const f32x4 v0 = acc[ai][0][m][0] * sa, v1 = acc[ai][0][m][1] * sa, v2 = acc[ai][1][m][0] * sa, v3 = acc[ai][1][m][1] * sa;
            u32x4 w; w.x = pk4_fp8_sat(v0[0], v0[1], v0[2], v0[3]); w.y = pk4_fp8_sat(v1[0], v1[1], v1[2], v1[3]); w.z = pk4_fp8_sat(v2[0], v2[1], v2[2], v2[3]); w.w = pk4_fp8_sat(v3[0], v3[1], v3[2], v3[3]);
            *(u32x4*)(base + off) = w;
            off += (unsigned)((m == 3 ? 80 : 16) * ldc); OPAQ(off); }
    }
};
struct EpiProj {
    static constexpr bool PERM = true, WIDE = false; static constexpr int NPRE = 0;
    bf16* O;
    __device__ __forceinline__ void operator()(const f32x4 (&acc)[2][2][4][2], const Unit& u, int wr, int wc, int fr, int fq) const {
        if (u.pn >= 2 && u.pn < 5) {
            char* base = (char*)O + (size_t)u.pm * BM * PROW + PQ8 + (u.pn - 2) * BM;
            unsigned off = (unsigned)((wr * 64 + fr) * PROW + wc * 32 + 8 * fq); OPAQ(off);
            constexpr float sa = (float)(1 << FP8_AEXP);
#pragma unroll
            for (int ai = 0; ai < 2; ++ai)
#pragma unroll
              for (int m = 0; m < 4; ++m) {
#pragma unroll
                for (int bj = 0; bj < 2; ++bj) { const f32x4 v0 = acc[ai][bj][m][0] * sa, v1 = acc[ai][bj][m][1] * sa;
                    u32x2 w; w.x = pk4_fp8_sat(v0[0], v0[1], v0[2], v0[3]); w.y = pk4_fp8_sat(v1[0], v1[1], v1[2], v1[3]);
                    *(u32x2*)(base + off + bj * HALF) = w; }
                off += (unsigned)((m == 3 ? 80 : 16) * PROW); OPAQ(off); }
        } else if (u.pn < 2) {
            char* base = (char*)(O + (size_t)u.pm * BM * INCP + u.pn * BM);
            unsigned off = (unsigned)((wr * 64 + fr) * INCP + wc * 32 + 8 * fq) * 2u; OPAQ(off);
#pragma unroll
            for (int ai = 0; ai < 2; ++ai)
#pragma unroll
              for (int m = 0; m < 4; ++m) {
#pragma unroll
                for (int bj = 0; bj < 2; ++bj) { const f32x4 v0 = acc[ai][bj][m][0], v1 = acc[ai][bj][m][1];
                    u32x4 w; w.x = cvt_pk_bf16(v0[0], v0[1]); w.y = cvt_pk_bf16(v0[2], v0[3]); w.z = cvt_pk_bf16(v1[0], v1[1]); w.w = cvt_pk_bf16(v1[2], v1[3]);
                    *(u32x4*)(base + off + bj * HALF * 2) = w; }
                off += (unsigned)((m == 3 ? 80 : 16) * INCP) * 2u; OPAQ(off); }
        } else {
            char* base = (char*)O + (size_t)u.pm * BM * PROW + GA8 + (u.pn - 5) * BM;
            unsigned off = (unsigned)((wr * 64 + fr) * PROW + wc * 32 + 8 * fq); OPAQ(off);
#pragma unroll
            for (int ai = 0; ai < 2; ++ai)
#pragma unroll
              for (int m = 0; m < 4; ++m) {
#pragma unroll
                for (int bj = 0; bj < 2; ++bj) { u32x2 w;
#pragma unroll
                    for (int n = 0; n < 2; ++n) { f32x4 y = sigmoid4(acc[ai][bj][m][n]) * 255.0f + 0.5f;
                        if (u.pn >= 9) { y.x = fmaxf(y.x, 1.0f); y.y = fmaxf(y.y, 1.0f); y.z = fmaxf(y.z, 1.0f); y.w = fmaxf(y.w, 1.0f); }
                        const unsigned pk = (unsigned)y.x | ((unsigned)y.y << 8) | ((unsigned)y.z << 16) | ((unsigned)y.w << 24); if (n == 0) w.x = pk; else w.y = pk; }
                    *(u32x2*)(base + off + bj * HALF) = w; }
                off += (unsigned)((m == 3 ? 80 : 16) * PROW); OPAQ(off); }
        }
    }
};
template <bool SECOND> struct EpiGate {
    static constexpr bool PERM = true, WIDE = false; static constexpr int NPRE = 0;
    bf16* O; const bf16* Gt; const bf16* Y1;
    __device__ __forceinline__ void operator()(const f32x4 (&acc)[2][2][4][2], const Unit& u, int wr, int wc, int fr, int fq) const {
        char* obase = SECOND ? (char*)O + (size_t)u.pm * BM * DM + u.pn * BM : (char*)(O + (size_t)u.pm * BM * DM + u.pn * BM); const char* ybase = (const char*)(Y1 + (size_t)u.pm * BM * DM + u.pn * BM);
        const char* gbase = (const char*)(Gt + (size_t)u.pm * BM * INCP + u.pn * BM);
        unsigned off = (unsigned)((wr * 64 + fr) * DM + wc * 32 + 8 * fq) * 2u, goff = (unsigned)((wr * 64 + fr) * INCP + wc * 32 + 8 * fq) * 2u; OPAQ(off); OPAQ(goff);
#pragma unroll
        for (int ai = 0; ai < 2; ++ai)
#pragma unroll
          for (int m = 0; m < 4; ++m) {
#pragma unroll
            for (int bj = 0; bj < 2; ++bj) { const f32x4 v0 = acc[ai][bj][m][0], v1 = acc[ai][bj][m][1];
                const u32x4 g = *(const u32x4*)(gbase + goff + bj * HALF * 2);
                float r[8];
                r[0] = v0[0] * sigmoidf_(bflo(g.x)); r[1] = v0[1] * sigmoidf_(bfhi(g.x)); r[2] = v0[2] * sigmoidf_(bflo(g.y)); r[3] = v0[3] * sigmoidf_(bfhi(g.y));
                r[4] = v1[0] * sigmoidf_(bflo(g.z)); r[5] = v1[1] * sigmoidf_(bfhi(g.z)); r[6] = v1[2] * sigmoidf_(bflo(g.w)); r[7] = v1[3] * sigmoidf_(bfhi(g.w));
                if (SECOND) { const u32x4 y = *(const u32x4*)(ybase + off + bj * HALF * 2);
                    r[0] += bflo(y.x); r[1] += bfhi(y.x); r[2] += bflo(y.y); r[3] += bfhi(y.y); r[4] += bflo(y.z); r[5] += bfhi(y.z); r[6] += bflo(y.w); r[7] += bfhi(y.w); }
                if (SECOND) { constexpr float sa = (float)(1 << FP8_AEXP); u32x2 w; w.x = pk4_fp8(r[0] * sa, r[1] * sa, r[2] * sa, r[3] * sa); w.y = pk4_fp8(r[4] * sa, r[5] * sa, r[6] * sa, r[7] * sa);
                    *(u32x2*)(obase + (off >> 1) + bj * HALF) = w; }
                else { u32x4 w; w.x = cvt_pk_bf16(r[0], r[1]); w.y = cvt_pk_bf16(r[2], r[3]); w.z = cvt_pk_bf16(r[4], r[5]); w.w = cvt_pk_bf16(r[6], r[7]);
                    *(u32x4*)(obase + off + bj * HALF * 2) = w; } }
            off += (unsigned)((m == 3 ? 80 : 16) * DM) * 2u; goff += (unsigned)((m == 3 ? 80 : 16) * INCP) * 2u; OPAQ(off); OPAQ(goff); }
    }
};
struct EpiGateF {
    static constexpr bool PERM = true, WIDE = true; static constexpr int NPRE = 0;
    unsigned char* O; const unsigned char* G;
    __device__ __forceinline__ static float ub(unsigned w, int i) { return (float)((w >> (8 * i)) & 0xffu); }
    __device__ __forceinline__ void mid(f32x4 (&acc)[2][2][4][2], const Unit& u, int wr, int wc, int fr, int fq) const {
        const char* gbase = (const char*)G + (size_t)u.pm * BM * PROW + u.pn * BM;
        unsigned gl = (unsigned)((wr * 64 + fr) * PROW + wc * 64 + 16 * fq); OPAQ(gl);
        u32x4 ra[8], rb[8];
#pragma unroll
        for (int g = 0; g < 8; ++g) { ra[g] = *(const u32x4*)(gbase + GA8 + gl); rb[g] = *(const u32x4*)(gbase + GB8 + gl);
            gl += (unsigned)(((g & 3) == 3 ? 80 : 16) * PROW); OPAQ(gl); }
#pragma unroll
        for (int g = 0; g < 8; ++g) { const int ai = g >> 2, m = g & 3;
            const u32x4 a = ra[g], b = rb[g];
#pragma unroll
            for (int bj = 0; bj < 2; ++bj)
#pragma unroll
                for (int n = 0; n < 2; ++n) { const unsigned wa = a[2 * bj + n], wb = b[2 * bj + n];
                    const f32x4 qa = (f32x4){ub(wa, 0), ub(wa, 1), ub(wa, 2), ub(wa, 3)};
                    const f32x4 rq = (f32x4){__builtin_amdgcn_rcpf(ub(wb, 0)), __builtin_amdgcn_rcpf(ub(wb, 1)), __builtin_amdgcn_rcpf(ub(wb, 2)), __builtin_amdgcn_rcpf(ub(wb, 3))};
                    acc[ai][bj][m][n] = acc[ai][bj][m][n] * (qa * rq); } }
    }
    __device__ __forceinline__ void operator()(const f32x4 (&acc)[2][2][4][2], const Unit& u, int wr, int wc, int fr, int fq) const {
        char* obase = (char*)O + (size_t)u.pm * BM * DM + u.pn * BM; const char* gbase = (const char*)G + (size_t)u.pm * BM * PROW + GB8 + u.pn * BM;
        unsigned off = (unsigned)((wr * 64 + fr) * DM + wc * 64 + 16 * fq), gl = (unsigned)((wr * 64 + fr) * PROW + wc * 64 + 16 * fq); OPAQ(off); OPAQ(gl);
        constexpr float sa = (float)(1 << FP8_AEXP) / 255.0f;
        u32x4 rb[8];
#pragma unroll
        for (int g = 0; g < 8; ++g) { rb[g] = *(const u32x4*)(gbase + gl); gl += (unsigned)(((g & 3) == 3 ? 80 : 16) * PROW); OPAQ(gl); }
#pragma unroll
        for (int g = 0; g < 8; ++g) { const int ai = g >> 2, m = g & 3;
            const u32x4 b = rb[g]; u32x4 w4;
#pragma unroll
            for (int bj = 0; bj < 2; ++bj)
#pragma unroll
                for (int n = 0; n < 2; ++n) { const unsigned wb = b[2 * bj + n];
                    const f32x4 v = (acc[ai][bj][m][n] * sa) * (f32x4){ub(wb, 0), ub(wb, 1), ub(wb, 2), ub(wb, 3)};
                    w4[2 * bj + n] = pk4_fp8_sat(v[0], v[1], v[2], v[3]); }
            *(u32x4*)(obase + off) = w4;
            off += (unsigned)((m == 3 ? 80 : 16) * DM); OPAQ(off); }
    }
};
struct EpiRes {
    static constexpr bool PERM = true, WIDE = false; static constexpr int NPRE = 0;
    bf16* xs; const float* gtv;
    int rowbase, gch;
    __device__ __forceinline__ void operator()(const f32x4 (&acc)[2][2][4][2], const Unit& u, int wr, int wc, int fr, int fq) const {
        const int lrow = rowbase + u.pm * BM;
        const int which = (lrow < TC) ? 4 : ((lrow - TC) >> 12);
        const char* gt = (const char*)(gtv + ((size_t)which * 6 + gch) * DM + u.pn * BM);
        char* ob = (char*)(xs + (size_t)lrow * DM + u.pn * BM);
        unsigned off = (unsigned)((wr * 64 + fr) * DM + wc * 32 + 8 * fq) * 2u; const unsigned goff = (unsigned)(wc * 32 + 8 * fq) * 4u; OPAQ(off);
        f32x4 gv[2][2];
#pragma unroll
        for (int bj = 0; bj < 2; ++bj)
#pragma unroll
            for (int n = 0; n < 2; ++n) gv[bj][n] = *(const f32x4*)(gt + goff + (bj * HALF + n * 4) * 4);
        u32x4 rr[8][2]; unsigned ol = off;
#pragma unroll
        for (int g = 0; g < 8; ++g) {
#pragma unroll
            for (int bj = 0; bj < 2; ++bj) rr[g][bj] = *(const u32x4*)(ob + ol + bj * HALF * 2);
            ol += (unsigned)(((g & 3) == 3 ? 80 : 16) * DM) * 2u; OPAQ(ol); }
#pragma unroll
        for (int g = 0; g < 8; ++g) { const int ai = g >> 2, m = g & 3;
#pragma unroll
            for (int bj = 0; bj < 2; ++bj) { const u32x4 w_ = rr[g][bj];
                const f32x4 c0 = (f32x4){bflo(w_.x), bfhi(w_.x), bflo(w_.y), bfhi(w_.y)}, c1 = (f32x4){bflo(w_.z), bfhi(w_.z), bflo(w_.w), bfhi(w_.w)};
                const f32x4 o0 = c0 + gv[bj][0] * acc[ai][bj][m][0], o1 = c1 + gv[bj][1] * acc[ai][bj][m][1];
                u32x4 w; w.x = cvt_pk_bf16(o0[0], o0[1]); w.y = cvt_pk_bf16(o0[2], o0[3]); w.z = cvt_pk_bf16(o1[0], o1[1]); w.w = cvt_pk_bf16(o1[2], o1[3]); *(u32x4*)(ob + off + bj * HALF * 2) = w; }
            off += (unsigned)((m == 3 ? 80 : 16) * DM) * 2u; OPAQ(off); }
    }
};
struct EpiGlu {
    static constexpr bool PERM = true, WIDE = false; static constexpr int NPRE = 0;
    bf16* HH;
    __device__ __forceinline__ void operator()(const f32x4 (&acc)[2][2][4][2], const Unit& u, int wr, int wc, int fr, int fq) const {
        char* base = (char*)HH + (size_t)u.pm * BM * FF + u.pn * HALF;
        unsigned off = (unsigned)((wr * 64 + fr) * FF + wc * 32 + 8 * fq); OPAQ(off);
#pragma unroll
        for (int ai = 0; ai < 2; ++ai)
#pragma unroll
          for (int m = 0; m < 4; ++m) {
            constexpr float sa = (float)(1 << FP8_AEXP);
            const f32x4 g0 = acc[ai][0][m][0], g1 = acc[ai][0][m][1];
            const f32x4 r0 = (g0 * sigmoid4(g0)) * (acc[ai][1][m][0] * sa), r1 = (g1 * sigmoid4(g1)) * (acc[ai][1][m][1] * sa);
            u32x2 w; w.x = pk4_fp8_sat(r0.x, r0.y, r0.z, r0.w); w.y = pk4_fp8_sat(r1.x, r1.y, r1.z, r1.w);
            *(u32x2*)(base + off) = w;
            off += (unsigned)((m == 3 ? 80 : 16) * FF); OPAQ(off); }
    }
};
struct EpiDown {
    static constexpr bool PERM = true, WIDE = true; static constexpr int NPRE = 1;
    unsigned char* YE; const float* roww;
    __device__ __forceinline__ void pre(const Unit& u, int wr, int wid, int lane, LAS unsigned char* lds) const {
        if (u.e == 16) return;
        const float* rw = roww + (size_t)(u.e & 15) * T + u.lt * BM + wr * 64 + lane;
        LAS unsigned* dst = (LAS unsigned*)(lds + LDSX_OFF + 12288) + wid * 128;
        __builtin_amdgcn_global_load_lds((const unsigned*)rw, dst, 4, 0, 0);
        __builtin_amdgcn_global_load_lds((const unsigned*)(rw + HALF), dst + 64, 4, 0, 0);
    }
    __device__ __forceinline__ void operator()(const f32x4 (&acc)[2][2][4][2], const Unit& u, int wr, int wc, int fr, int fq, int wid, LAS unsigned char* lds) const {
        char* base = (char*)YE + (size_t)u.pm * BM * DM + u.pn * BM;
        unsigned off = (unsigned)((wr * 64 + fr) * DM + wc * 64 + 16 * fq); OPAQ(off);
        const LAS float* wl = (const LAS float*)(lds + LDSX_OFF + 12288) + wid * 128 + fr;
        float wts[8];
        asm volatile("" ::: "memory");
#pragma unroll
        for (int g = 0; g < 8; ++g) wts[g] = (u.e == 16) ? 1.0f : *(const volatile LAS float*)(wl + (g >> 2) * 64 + (g & 3) * 16);
#pragma unroll
        for (int ai = 0; ai < 2; ++ai)
#pragma unroll
          for (int m = 0; m < 4; ++m) {
            const float wt = wts[ai * 4 + m] * (float)(1 << FP8_AEXP);
            { const f32x4 v0 = acc[ai][0][m][0] * wt, v1 = acc[ai][0][m][1] * wt, v2 = acc[ai][1][m][0] * wt, v3 = acc[ai][1][m][1] * wt;
                u32x4 w; w.x = pk4_fp8_sat(v0[0], v0[1], v0[2], v0[3]); w.y = pk4_fp8_sat(v1[0], v1[1], v1[2], v1[3]); w.z = pk4_fp8_sat(v2[0], v2[1], v2[2], v2[3]); w.w = pk4_fp8_sat(v3[0], v3[1], v3[2], v3[3]);
                *(u32x4*)(base + off) = w; }
            off += (unsigned)((m == 3 ? 80 : 16) * DM); OPAQ(off); }
    }
};

typedef int i32x4v __attribute__((ext_vector_type(4)));
typedef int i32x8v __attribute__((ext_vector_type(8)));
template <class Epi, class Sched, bool GATHER, int MODE = 0, bool MIDK = false>
__device__ __forceinline__ void gemm_phase(LAS unsigned char* lds, const bf16* A, int lda, const bf16* Bt, int K, const Sched& S, const Epi& E, const LAS int* gtab, int sclW = 0x7f7f7f7f, int sclA = 0x7f7f7f7f, float deq = 1.0f) {
    constexpr bool FP8 = (MODE == 1), I8 = (MODE == 2);
    int tid_ = threadIdx.x; asm volatile("" : "+v"(tid_));
    const int tid = tid_, wid = __builtin_amdgcn_readfirstlane(tid >> 6), lane = tid & 63, wr = wid >> 2, wc = wid & 3, fr = lane & 15, fq = lane >> 4;
    const int nt = K / BK;
    int RA[2], CA[2];
    unsigned voffA[2][2], voffB[2];
#pragma unroll
    for (int i = 0; i < 2; ++i) { int R, C; stage_rc(tid * 16 + i * 8192, R, C); const int Rb = Epi::WIDE ? (64 * (R >> 5) + 16 * ((R & 15) >> 2) + 4 * ((R >> 4) & 1) + (R & 3)) : (Epi::PERM ? ((R & ~31) + perm32(R & 31)) : R);
        RA[i] = R; CA[i] = C; voffB[i] = (unsigned)(Rb * K + C) * 2u;
        voffA[0][i] = (unsigned)(R * lda + C) * 2u; voffA[1][i] = 0u; }
    const size_t kstep = (size_t)(BK * 2);
    const size_t hstepB = Epi::WIDE ? (size_t)8 * K * 2 : (size_t)HALF * K * 2;
    const size_t hstepA = GATHER ? (size_t)0 : (size_t)HALF * lda * 2;
    const unsigned ldsw = (unsigned)wid * 1024u;
    const int aoff = lds_byte(wr * 64 + fr, fq * 8), boff = lds_byte(wc * 32 + fr, fq * 8);
#define PG8_SA(b, h) (((b) * 2 + (h)) * HTB)
#define PG8_SB(b, h) ((4 + (b) * 2 + (h)) * HTB)
#define PG8_STA(b, h, gbase) do { _Pragma("unroll") for (int _i = 0; _i < 2; ++_i) \
        __builtin_amdgcn_global_load_lds((const unsigned*)((const char*)(gbase) + (h) * hstepA + voffA[GATHER ? (h) : 0][_i]), (LAS unsigned*)(lds + PG8_SA(b, h) + ldsw + _i * 8192), 16, 0, 0); } while (0)
#define PG8_STB(b, h, gbase) do { _Pragma("unroll") for (int _i = 0; _i < 2; ++_i) \
        __builtin_amdgcn_global_load_lds((const unsigned*)((const char*)(gbase) + (h) * hstepB + voffB[_i]), (LAS unsigned*)(lds + PG8_SB(b, h) + ldsw + _i * 8192), 16, 0, 0); } while (0)
#define PG8_LDA(dst, b, h) do { _Pragma("unroll") for (int m = 0; m < 4; ++m) _Pragma("unroll") for (int k = 0; k < 2; ++k) dst[m][k] = *(const LAS bf16x8*)(lds + PG8_SA(b, h) + aoff + m * 2048 + k * 1024); } while (0)
#define PG8_LDB(dst, b, h) do { _Pragma("unroll") for (int n = 0; n < 2; ++n) _Pragma("unroll") for (int k = 0; k < 2; ++k) dst[n][k] = *(const LAS bf16x8*)(lds + PG8_SB(b, h) + boff + n * 2048 + k * 1024); } while (0)
#define PG8_CAT(x) __builtin_shufflevector(__builtin_bit_cast(i32x4v, x[0]), __builtin_bit_cast(i32x4v, x[1]), 0, 1, 2, 3, 4, 5, 6, 7)
#define PG8_MMA(ai, bj, At, Bt_) do { __builtin_amdgcn_s_setprio(1); _Pragma("unroll") for (int m = 0; m < 4; ++m) _Pragma("unroll") for (int n = 0; n < 2; ++n) { \
        if constexpr (FP8) { const i32x8v a8_ = PG8_CAT(Bt_[n]), b8_ = PG8_CAT(At[m]);   \
            asm volatile("v_mfma_scale_f32_16x16x128_f8f6f4 %0, %1, %2, %0, %3, %4 op_sel_hi:[0,0,0]" : "+v"(acc[ai][bj][m][n]) : "v"(a8_), "v"(b8_), "v"(sclW), "v"(sclA)); } \
        else if constexpr (I8) { _Pragma("unroll") for (int k = 0; k < 2; ++k) acc[ai][bj][m][n] = __builtin_bit_cast(f32x4, __builtin_amdgcn_mfma_i32_16x16x64_i8(__builtin_bit_cast(i32x4v, Bt_[n][k]), __builtin_bit_cast(i32x4v, At[m][k]), __builtin_bit_cast(i32x4v, acc[ai][bj][m][n]), 0, 0, 0)); } \
        else { _Pragma("unroll") for (int k = 0; k < 2; ++k) acc[ai][bj][m][n] = __builtin_amdgcn_mfma_f32_16x16x32_bf16(Bt_[n][k], At[m][k], acc[ai][bj][m][n], 0, 0, 0); } } \
        __builtin_amdgcn_s_setprio(0); } while (0)
#define PG8_WAIT_V(n) asm volatile("s_waitcnt vmcnt(" #n ")" ::: "memory")
#define PG8_WAIT_L(n) asm volatile("s_waitcnt lgkmcnt(" #n ")" ::: "memory")
#define PG8_BAR __builtin_amdgcn_s_barrier()
#define PG8_SCHED __builtin_amdgcn_sched_barrier(0)
#define PG8_GLOAD(ui_) do { _Pragma("unroll") for (int _h = 0; _h < 2; ++_h) _Pragma("unroll") for (int _i = 0; _i < 2; ++_i) \
        voffA[_h][_i] = (unsigned)(gtab[(ui_) * 256 + _h * HALF + RA[_i]] * lda + CA[_i]) * 2u; } while (0)
    Unit cur, nxt; int ui = 0;
    if (!S.next(0, cur)) return;
    f32x4 acc[2][2][4][2];
#pragma unroll
    for (int a = 0; a < 2; ++a)
#pragma unroll
        for (int b = 0; b < 2; ++b)
#pragma unroll
            for (int m = 0; m < 4; ++m)
#pragma unroll
                for (int n = 0; n < 2; ++n) acc[a][b][m][n] = (f32x4){0.f, 0.f, 0.f, 0.f};
    bf16x8 At[4][2], B0[2][2], B1[2][2];
    if constexpr (GATHER) { PG8_GLOAD(0); }
    const char* cA = (const char*)A + S.a_off(cur); const char* cB = (const char*)Bt + S.b_off(cur);
    PG8_STB(0, 0, cB); PG8_STB(0, 1, cB); PG8_STA(0, 0, cA); PG8_STA(0, 1, cA);
    if (wr == 1) PG8_BAR;
    PG8_WAIT_V(2); PG8_BAR;
    PG8_STB(1, 0, cB + kstep); PG8_STA(1, 0, cA + kstep); PG8_STB(1, 1, cB + kstep);
    PG8_WAIT_V(6); PG8_BAR;
    for (;;) {
        const bool has_next = S.next(ui + 1, nxt);
        const char* nA = has_next ? (const char*)A + S.a_off(nxt) : cA; const char* nB = has_next ? (const char*)Bt + S.b_off(nxt) : cB;
#pragma unroll 1
        for (int t = 0; t < nt; t += 2) {
            const bool last = (t == nt - 2);
            if constexpr (MIDK) { if (t == nt / 2) { if constexpr (FP8) asm volatile("s_nop 15\n\ts_nop 15\n\ts_nop 15\n\ts_nop 15" ::: "memory"); E.mid(acc, cur, wr, wc, fr, fq); } }
            if constexpr (Epi::NPRE > 0) { if (last) E.pre(cur, wr, wid, lane, lds); }
            const char* a1 = cA + (size_t)(t + 1) * kstep;
            const char* a2 = last ? nA : cA + (size_t)(t + 2) * kstep; const char* b2 = last ? nB : cB + (size_t)(t + 2) * kstep;
            const char* a3 = a2 + kstep; const char* b3 = b2 + kstep;
            PG8_LDB(B0, 0, 0); PG8_LDB(B1, 0, 1); PG8_SCHED; PG8_LDA(At, 0, 0); PG8_STA(1, 1, a1);
            if constexpr (GATHER) { if (last && has_next) { PG8_GLOAD(ui + 1); } }
            PG8_WAIT_V(8); PG8_WAIT_L(0); PG8_BAR; PG8_MMA(0, 0, At, B0); PG8_MMA(0, 1, At, B1); PG8_BAR; PG8_SCHED;
            PG8_LDA(At, 0, 1); PG8_STB(0, 0, b2); PG8_STB(0, 1, b2); PG8_STA(0, 0, a2);
            PG8_WAIT_V(8); PG8_WAIT_L(0); PG8_BAR; PG8_MMA(1, 0, At, B0); PG8_MMA(1, 1, At, B1); PG8_BAR; PG8_SCHED;
            PG8_LDB(B0, 1, 0); PG8_LDB(B1, 1, 1); PG8_SCHED; PG8_LDA(At, 1, 0); PG8_STA(0, 1, a2);
            PG8_WAIT_V(8); PG8_WAIT_L(0); PG8_BAR; PG8_MMA(0, 0, At, B0); PG8_MMA(0, 1, At, B1); PG8_BAR; PG8_SCHED;
            PG8_LDA(At, 1, 1); PG8_STB(1, 0, b3); PG8_STB(1, 1, b3); PG8_STA(1, 0, a3);
            PG8_WAIT_V(8); PG8_WAIT_L(0); PG8_BAR; PG8_MMA(1, 0, At, B0); PG8_MMA(1, 1, At, B1); PG8_BAR; PG8_SCHED;
        }
        if (wr == 0) PG8_BAR;
        if constexpr (FP8) asm volatile("s_nop 15\n\ts_nop 15\n\ts_nop 15\n\ts_nop 15" ::: "memory");
        if constexpr (I8) {
#pragma unroll
            for (int a = 0; a < 2; ++a)
#pragma unroll
                for (int b = 0; b < 2; ++b)
#pragma unroll
                    for (int m = 0; m < 4; ++m)
#pragma unroll
                        for (int n = 0; n < 2; ++n) { const i32x4v q = __builtin_bit_cast(i32x4v, acc[a][b][m][n]); acc[a][b][m][n] = (f32x4){(float)q[0] * deq, (float)q[1] * deq, (float)q[2] * deq, (float)q[3] * deq}; } }
        if constexpr (Epi::NPRE > 0) E(acc, cur, wr, wc, fr, fq, wid, lds); else E(acc, cur, wr, wc, fr, fq);
        if (!has_next) break;
#pragma unroll
        for (int a = 0; a < 2; ++a)
#pragma unroll
            for (int b = 0; b < 2; ++b)
#pragma unroll
                for (int m = 0; m < 4; ++m)
#pragma unroll
                    for (int n = 0; n < 2; ++n) acc[a][b][m][n] = (f32x4){0.f, 0.f, 0.f, 0.f};
        cur = nxt; cA = nA; cB = nB; ++ui;
        if (wr == 1) PG8_BAR;
    }
    PG8_WAIT_V(0);
    PG8_BAR;
#undef PG8_SA
#undef PG8_SB
#undef PG8_STA
#undef PG8_STB
#undef PG8_LDA
#undef PG8_LDB
#undef PG8_MMA
#undef PG8_CAT
#undef PG8_WAIT_V
#undef PG8_WAIT_L
#undef PG8_BAR
#undef PG8_SCHED
#undef PG8_GLOAD
}
}

namespace att {
constexpr int KSLOT = 8192, VSLOT = 8192, NSLOT = 3;
constexpr int L_K = 0, L_V = NSLOT * KSLOT, L_OST = L_V + NSLOT * VSLOT, L_BYTES = L_OST + NWAVES * 2048;
constexpr int QEXP = 3;
static_assert(L_BYTES <= RING_BYTES, "attention LDS");
#define SBAR() __builtin_amdgcn_sched_barrier(0)
typedef int i32x4a __attribute__((ext_vector_type(4)));
typedef int i32x8a __attribute__((ext_vector_type(8)));
__device__ __forceinline__ int crow(int r, int hi) { return (r & 3) + 8 * (r >> 2) + 4 * hi; }
__device__ __forceinline__ void glds16(const void* gsrc, unsigned lds_dst) { unsigned keep;
    asm volatile("s_mov_b32 %0, m0\n\ts_mov_b32 m0, %2\n\ts_nop 0\n\tglobal_load_lds_dwordx4 %1, off\n\ts_mov_b32 m0, %0" : "=&s"(keep) : "v"(gsrc), "s"(lds_dst) : "memory"); }
typedef float f32x2_t __attribute__((ext_vector_type(2))); typedef __bf16 bf16x2_t __attribute__((ext_vector_type(2)));
__device__ __forceinline__ unsigned cvtpk_s(float lo, float hi) { f32x2_t v = {lo, hi}; bf16x2_t b = __builtin_convertvector(v, bf16x2_t); return __builtin_bit_cast(unsigned, b); }
typedef __attribute__((address_space(3))) const char* lds_cptr;
typedef short v4i16_t __attribute__((ext_vector_type(4)));
__device__ __forceinline__ s16x4 vtr(lds_cptr p) { return __builtin_bit_cast(s16x4, __builtin_amdgcn_ds_read_tr16_b64_v4i16((LAS v4i16_t*)p)); }
__device__ __forceinline__ i32x8a kfrag(lds_cptr kp, int idx) {
    const i32x4a a = *(const LAS i32x4a*)(kp + (idx >> 1) * 4096 + (idx & 1) * 512), b = *(const LAS i32x4a*)(kp + (idx >> 1) * 4096 + (idx & 1) * 512 + 1024);
    return __builtin_shufflevector(a, b, 0, 1, 2, 3, 4, 5, 6, 7);
}
template <int DQK>
__device__ __forceinline__ void attn_unit(const unsigned char* Qw, int qpitch, const unsigned char* Kh, int kpitch, const bf16* Vh, int vpitch, unsigned char* Ow, int NT, float negc, LAS unsigned char* shm) {
    constexpr int NG = (DQK == 96) ? 2 : 1;
    int tid_ = threadIdx.x; asm volatile("" : "+v"(tid_));
    const int tid = tid_, lane = tid & 63, r32 = lane & 31, hi = lane >> 5; const int wid = __builtin_amdgcn_readfirstlane(tid >> 6);
    const unsigned lds0 = (unsigned)(uintptr_t)shm;
    i32x8a qr8[NG];
#pragma unroll
    for (int g = 0; g < NG; ++g) { const unsigned char* qp = Qw + (size_t)r32 * qpitch + g * 64 + hi * 32;
        const i32x4a a = *(const i32x4a*)qp, b = *(const i32x4a*)(qp + 16); qr8[g] = __builtin_shufflevector(a, b, 0, 1, 2, 3, 4, 5, 6, 7); }
    const bool kw = (NG == 2) || (wid < 4);
    const unsigned char* ksrc = Kh + (size_t)lane * kpitch + wid * 16;
    const bf16* vsrc = Vh + (size_t)(16 * (wid & 3) + (lane >> 2)) * vpitch + (wid >> 2) * 32 + (lane & 3) * 8;
    const unsigned kdst = lds0 + L_K + wid * 1024, vdst = lds0 + L_V + wid * 1024;
#define DMA_K(t, ks) do { if (kw) glds16(ksrc + (size_t)(t) * 64 * kpitch, (unsigned)__builtin_amdgcn_readfirstlane(kdst + (ks))); } while (0)
#define DMA_V(t, vs) glds16(vsrc + (size_t)(t) * 64 * vpitch, (unsigned)__builtin_amdgcn_readfirstlane(vdst + (vs)))
#define WAIT_BAR(NV, NK) do { if (kw) asm volatile("s_waitcnt vmcnt(%0) lgkmcnt(0)\n\ts_barrier" :: "n"((NV) + (NK)) : "memory"); \
                              else    asm volatile("s_waitcnt vmcnt(%0) lgkmcnt(0)\n\ts_barrier" :: "n"(NV) : "memory"); } while (0)
    DMA_K(0, 0); DMA_V(0, 0); DMA_K(1, KSLOT); DMA_K(2, 2 * KSLOT);
    f32x16 o[2]; o[0] = f32x16{}; o[1] = f32x16{}; f32x4 o2 = (f32x4){0.f, 0.f, 0.f, 0.f};
    f32x16 negm;
#pragma unroll
    for (int r = 0; r < 16; ++r) negm[r] = negc;
    if constexpr (NG == 1) asm volatile("" : "+v"(negm));
    int sclK = 0x7f7f7f7f, sclQ = 0x01010101 * (127 - QEXP); asm volatile("" : "+v"(sclK), "+v"(sclQ));
    const short ind1 = ((((lane & 15) == 0) && (((lane >> 4) & 1) == 0)) || (((lane & 15) == 1) && (((lane >> 4) & 1) == 1))) ? (short)0x3F80 : (short)0;
    const bf16x8 ones = (bf16x8){ind1, ind1, ind1, ind1, ind1, ind1, ind1, ind1};
#define MFSUM(a, c) __builtin_amdgcn_mfma_f32_16x16x32_bf16(a, ones, c, 0, 0, 0)
    const lds_cptr shm3 = (lds_cptr)shm; const lds_cptr kp0 = shm3 + L_K + (2 * hi) * 1024 + r32 * 16;
    const lds_cptr vp0 = shm3 + L_V + ((lane >> 4) & 1) * 32 + (lane & 3) * 8 + (4 * hi + ((lane & 15) >> 2)) * 64;
    f32x16 pA0, pA1, pB0, pB1; i32x8a kf[2 * NG];
    int kprev = 0, kcur = 0, knext = KSLOT, vprev = 0, vcur = 0, vnext = VSLOT;
#define ROT() do { kprev = kcur; kcur = knext; knext = (knext == 2 * KSLOT) ? 0 : knext + KSLOT; vprev = vcur; vcur = vnext; vnext = (vnext == 2 * VSLOT) ? 0 : vnext + VSLOT; } while (0)
#define MF32(a, b, c) __builtin_amdgcn_mfma_f32_32x32x16_bf16(a, b, c, 0, 0, 0)
#define QK_FIRST(D, A, B) do { if constexpr (NG == 1) D = __builtin_amdgcn_mfma_scale_f32_32x32x64_f8f6f4(A, B, negm, 0, 0, 0, sclK, 0, sclQ); \
                               else D = __builtin_amdgcn_mfma_scale_f32_32x32x64_f8f6f4(A, B, f32x16{}, 0, 0, 0, sclK, 0, sclQ); } while (0)
#define QK_ACC(D, A, B) D = __builtin_amdgcn_mfma_scale_f32_32x32x64_f8f6f4(A, B, D, 0, 0, 0, sclK, 0, sclQ)
#define QK_SETTLE(X, Y) do { PIN(X); PIN(Y); } while (0)
#define KEEP(x) asm volatile("" :: "v"(x))
    WAIT_BAR(1, 2);
#pragma unroll
    for (int i = 0; i < 2 * NG; ++i) kf[i] = kfrag(kp0, i);
    QK_FIRST(pA0, kf[0], qr8[0]); QK_FIRST(pA1, kf[1], qr8[0]);
    if constexpr (NG == 2) { QK_ACC(pA0, kf[2], qr8[1]); QK_ACC(pA1, kf[3], qr8[1]); }
#pragma unroll
    for (int r = 0; r < 16; ++r) { pA0[r] = __builtin_amdgcn_exp2f(pA0[r]); pA1[r] = __builtin_amdgcn_exp2f(pA1[r]); }
    WAIT_BAR(0, 0);
    DMA_K(3, 0); DMA_V(1, VSLOT);
    ROT();
#pragma unroll
    for (int i = 0; i < 2 * NG; ++i) kf[i] = kfrag(kp0 + kcur, i);
    WAIT_BAR(1, 1);
    s16x4 vlo[8], vhi[8]; u32x4 pw0, pw1, pw2, pw3;
#define PKW(P, B) cvtpk_s(P[B], P[B + 1])
#define PAF(k) __builtin_bit_cast(bf16x8, pw##k)
#define VFR(i) (bf16x8){vlo[i][0], vlo[i][1], vlo[i][2], vlo[i][3], vhi[i][0], vhi[i][1], vhi[i][2], vhi[i][3]}
#define PIN(x) asm volatile("" : "+v"(x))
#define EX(v) __builtin_amdgcn_exp2f(v)
#define VRD(i) do { vlo[i] = vtr(vp_ + (((i) >> 2) * 4096 + ((i) & 3) * 1024)); vhi[i] = vtr(vp_ + (((i) >> 2) * 4096 + ((i) & 3) * 1024 + 512)); } while (0)
#define PACK4(PW, P, B) do { PW[0] = PKW(P, B); PW[1] = PKW(P, (B) + 2); PW[2] = PKW(P, (B) + 4); PW[3] = PKW(P, (B) + 6); PIN(PW); } while (0)
#define KRD(G, i) do { if (G) { kf[i] = kfrag(kp0 + knext, i); SBAR(); } } while (0)
#define EXI(C0, C1, i) do { if ((i) < 16) C0[(i) & 15] = EX(C0[(i) & 15]); else C1[(i) & 15] = EX(C1[(i) & 15]); } while (0)
#define GAPB3(MF, C0, C1, I0) do { MF; EXI(C0, C1, I0); EXI(C0, C1, (I0) + 1); EXI(C0, C1, (I0) + 2); PIN(C0); PIN(C1); SBAR(); } while (0)
#define GAPB2(MF, C0, C1, I0) do { MF; EXI(C0, C1, I0); EXI(C0, C1, (I0) + 1); PIN(C0); PIN(C1); SBAR(); } while (0)
#define STEP(C0, C1, P0, P1, t, GK, GV, GL) do { SBAR(); \
    const lds_cptr vp_ = vp0 + vprev; \
      \
    VRD(0); VRD(4); SBAR(); \
    QK_FIRST(C0, kf[0], qr8[0]); PACK4(pw0, P0, 0); VRD(1); VRD(5); SBAR(); \
    QK_FIRST(C1, kf[1], qr8[0]); KEEP(kf[0]); PACK4(pw1, P0, 8); VRD(2); VRD(6); SBAR(); \
    if constexpr (NG == 2) { QK_ACC(C0, kf[2], qr8[1]); KEEP(kf[1]); PACK4(pw2, P1, 0); VRD(3); VRD(7); SBAR(); \
                             QK_ACC(C1, kf[3], qr8[1]); KEEP(kf[2]); PACK4(pw3, P1, 8); SBAR(); } \
    else { PACK4(pw2, P1, 0); VRD(3); VRD(7); PACK4(pw3, P1, 8); SBAR(); } \
    if (GK) { DMA_K((t) + 3, kcur); } if (GV) { DMA_V((t) + 1, vnext); } \
    QK_SETTLE(C0, C1); KEEP(kf[2 * NG - 1]); SBAR(); \
      \
    GAPB3(o[0] = MF32(PAF(0), VFR(0), o[0]), C0, C1, 0); \
    KRD(GL, 0); GAPB3(o[1] = MF32(PAF(0), VFR(4), o[1]), C0, C1, 3); \
    KRD(GL, 1); GAPB3(o2 = MFSUM(PAF(0), o2), C0, C1, 6); \
    KRD(GL && NG == 2, 2); GAPB3(o[0] = MF32(PAF(1), VFR(1), o[0]), C0, C1, 9); \
    KRD(GL && NG == 2, 3); GAPB3(o[1] = MF32(PAF(1), VFR(5), o[1]), C0, C1, 12); \
    GAPB3(o2 = MFSUM(PAF(1), o2), C0, C1, 15); \
    GAPB3(o[0] = MF32(PAF(2), VFR(2), o[0]), C0, C1, 18); \
    GAPB3(o[1] = MF32(PAF(2), VFR(6), o[1]), C0, C1, 21); \
    GAPB2(o2 = MFSUM(PAF(2), o2), C0, C1, 24); \
    GAPB2(o[0] = MF32(PAF(3), VFR(3), o[0]), C0, C1, 26); \
    GAPB2(o[1] = MF32(PAF(3), VFR(7), o[1]), C0, C1, 28); \
    GAPB2(o2 = MFSUM(PAF(3), o2), C0, C1, 30); \
    } while (0)
#define ENDW(tt) do { if ((tt) + 3 < NT) { WAIT_BAR(1, 1); } else if ((tt) + 2 < NT) { WAIT_BAR(1, 0); } else { WAIT_BAR(0, 0); } } while (0)
    int t = 1;
    for (; t + 5 < NT; t += 2) {
        STEP(pB0, pB1, pA0, pA1, t, true, true, true);     WAIT_BAR(1, 1); ROT();
        STEP(pA0, pA1, pB0, pB1, t + 1, true, true, true); WAIT_BAR(1, 1); ROT();
    }
    for (; t + 1 < NT; t += 2) {
        STEP(pB0, pB1, pA0, pA1, t, (t + 3 < NT), (t + 1 < NT), (t + 1 < NT));         ENDW(t);     ROT();
        STEP(pA0, pA1, pB0, pB1, t + 1, (t + 4 < NT), (t + 2 < NT), (t + 2 < NT));     ENDW(t + 1); ROT();
    }
    STEP(pB0, pB1, pA0, pA1, NT - 1, false, false, false);
    { PACK4(pw0, pB0, 0); PACK4(pw1, pB0, 8); PACK4(pw2, pB1, 0); PACK4(pw3, pB1, 8);
      const lds_cptr vp_ = vp0 + vcur;
      VRD(0); VRD(1); VRD(2); VRD(3); VRD(4); VRD(5); VRD(6); VRD(7);
      o[0] = MF32(PAF(0), VFR(0), o[0]); o[1] = MF32(PAF(0), VFR(4), o[1]); o2 = MFSUM(PAF(0), o2);
      o[0] = MF32(PAF(1), VFR(1), o[0]); o[1] = MF32(PAF(1), VFR(5), o[1]); o2 = MFSUM(PAF(1), o2);
      o[0] = MF32(PAF(2), VFR(2), o[0]); o[1] = MF32(PAF(2), VFR(6), o[1]); o2 = MFSUM(PAF(2), o2);
      o[0] = MF32(PAF(3), VFR(3), o[0]); o[1] = MF32(PAF(3), VFR(7), o[1]); o2 = MFSUM(PAF(3), o2); }
#undef DMA_K
#undef DMA_V
#undef WAIT_BAR
#undef ROT
#undef MF32
#undef MFSUM
#undef QK_FIRST
#undef QK_ACC
#undef QK_SETTLE
#undef KEEP
#undef PKW
#undef PAF
#undef VFR
#undef PIN
#undef EX
#undef VRD
#undef PACK4
#undef KRD
#undef EXI
#undef GAPB3
#undef GAPB2
#undef STEP
#undef ENDW
    { LAS unsigned char* stg = (LAS unsigned char*)(shm + L_OST) + wid * 2048;
      LAS float* lq = (LAS float*)stg;
      if ((lane & 15) < 2) { const int q0 = 16 * (lane & 15) + 4 * (lane >> 4);
#pragma unroll
          for (int k = 0; k < 4; ++k) lq[q0 + k] = o2[k]; }
      asm volatile("s_waitcnt lgkmcnt(0)" ::: "memory");
      float rl[16];
#pragma unroll
      for (int r = 0; r < 16; ++r) rl[r] = lq[crow(r, hi)];
      asm volatile("s_waitcnt lgkmcnt(0)" ::: "memory");
      constexpr float sa = (float)(1 << FP8_AEXP);
#pragma unroll
      for (int r = 0; r < 16; ++r) { const int orow = crow(r, hi); const float sc = __builtin_amdgcn_rcpf(rl[r]) * sa;
#pragma unroll
        for (int d0 = 0; d0 < 2; ++d0) stg[orow * 64 + d0 * 32 + r32] = (unsigned char)(pk4_fp8(__builtin_amdgcn_fmed3f(o[d0][r] * sc, -448.f, 448.f), 0.f, 0.f, 0.f) & 0xffu); }
      asm volatile("s_waitcnt lgkmcnt(0)" ::: "memory");
#pragma unroll
      for (int i = 0; i < 2; ++i) { const int row = i * 16 + (lane >> 2), ch = lane & 3; const u32x4 v = *(const LAS u32x4*)(stg + row * 64 + ch * 16); *(u32x4*)(Ow + (size_t)row * DM + ch * 16) = v; } }
    asm volatile("s_waitcnt lgkmcnt(0)\n\ts_barrier" ::: "memory");
}
#undef SBAR
}

#define XB_TMO      128
#define XB_XCNT(j)  (256  + 64 * (j))
#define XB_XSUB(j)  (1280 + 64 * (j))
#define XB_XGEN(j)  (2304 + 64 * (j))
#define XB_TOP      3328
#define XB_TOPGEN   3392
#define XCD_BAR_WORDS 3456
#define XB_SPIN_CAP (1u << 18)
__device__ __forceinline__ unsigned xb_ld(unsigned* p)              { return __hip_atomic_load(p, __ATOMIC_RELAXED, __HIP_MEMORY_SCOPE_AGENT); }
__device__ __forceinline__ unsigned xb_add(unsigned* p, unsigned v) { return __hip_atomic_fetch_add(p, v, __ATOMIC_RELAXED, __HIP_MEMORY_SCOPE_AGENT); }
__device__ __forceinline__ unsigned xb_xcc_id() { return (unsigned)__builtin_amdgcn_s_getreg((3 << 11) | 20) & 0xFu; }
#define XB_SPIN(cond, bar) do { unsigned _sp = 0; while (cond) { __builtin_amdgcn_s_sleep(1); \
    if ((++_sp & 255u) == 0u) { if (xb_ld(&(bar)[XB_TMO])) break; if (_sp > XB_SPIN_CAP) { atomicAdd(&(bar)[XB_TMO], 1u); break; } } } } while (0)
struct XcdBarrier { unsigned* bar; unsigned x; volatile LAS unsigned* st; };
__device__ __forceinline__ XcdBarrier xcd_barrier_post(unsigned* bar, volatile LAS unsigned* st) {
    XcdBarrier b; b.bar = bar; b.x = xb_xcc_id(); b.st = st;
    if (threadIdx.x == 0) (void)xb_add(&bar[XB_XCNT(b.x)], 1u);
    return b;
}
__device__ __forceinline__ void xcd_barrier_complete(unsigned* bar, unsigned x, unsigned& nloc, unsigned& nx) {
    const unsigned G = gridDim.x * gridDim.y * gridDim.z;
    unsigned sum, cnt, mine, sp = 0u;
    for (;;) {
        sum = 0u; cnt = 0u; mine = 0u;
#pragma unroll
        for (unsigned j = 0; j < 16; ++j) { const unsigned c = xb_ld(&bar[XB_XCNT(j)]); sum += c; cnt += (c > 0u) ? 1u : 0u; mine = (j == x) ? c : mine; }
        if (sum == G) break;
        __builtin_amdgcn_s_sleep(1);
        if ((++sp & 255u) == 0u) { if (xb_ld(&bar[XB_TMO])) break; if (sp > XB_SPIN_CAP) { atomicAdd(&bar[XB_TMO], 1u); break; } }
    }
    nloc = mine > 0u ? mine : 1u; nx = cnt > 0u ? cnt : 1u;
}
__device__ __forceinline__ void xcd_barrier(const XcdBarrier& b) {
    asm volatile("s_waitcnt vmcnt(0)" ::: "memory");
    __syncthreads();
    if (threadIdx.x == 0) {
        unsigned* bar = b.bar;
        __builtin_amdgcn_s_waitcnt(0);
        unsigned nloc = b.st[0], nx = b.st[1];
        if (nloc == 0u) { xcd_barrier_complete(bar, b.x, nloc, nx); b.st[0] = nloc; b.st[1] = nx; }
        const unsigned old = xb_add(&bar[XB_XSUB(b.x)], 1u);
        const unsigned gen = old / nloc;
        if (old + 1u == (gen + 1u) * nloc) {
            __builtin_amdgcn_fence(__ATOMIC_RELEASE, "agent");
            asm volatile("s_waitcnt vmcnt(0)" ::: "memory");
            const unsigned og = xb_add(&bar[XB_TOP], 1u);
            const unsigned tg = og / nx;
            if (og + 1u == (tg + 1u) * nx) xb_add(&bar[XB_TOPGEN], 1u);
            else XB_SPIN(xb_ld(&bar[XB_TOPGEN]) == tg, bar);
            __builtin_amdgcn_fence(__ATOMIC_ACQUIRE, "agent");
            xb_add(&bar[XB_XGEN(b.x)], 1u);
            asm volatile("s_waitcnt vmcnt(0)" ::: "memory");
        } else {
            XB_SPIN(xb_ld(&bar[XB_XGEN(b.x)]) == gen, bar);
            __builtin_amdgcn_fence(__ATOMIC_ACQUIRE, "agent");
            asm volatile("s_waitcnt vmcnt(0)" ::: "memory");
        }
    }
    __syncthreads();
}

struct Args { const float* in[28]; float* out; unsigned char* ws; int ph_lo, ph_hi, li, pad; };
typedef const __attribute__((address_space(4))) Args* ArgsP;
struct Ctx {
    LAS unsigned char* lds; int tid, lane, wave, vcu, G, gw, NGW;
    ArgsP ap;
};
#define CIN(k) (C.ap->in[k])
#define CWS (C.ap->ws)
#define COUT (C.ap->out)
template <bool MERGE>
__device__ __forceinline__ void ctx_mini_gemm(const Ctx& C, const unsigned char* A8, const unsigned char* W8, int sclW, int sclA,
                                              unsigned char* Y8, const unsigned char* G8, const float* xin, bf16* xs, const float* gt) {
    const int fr = C.lane & 15, fq = C.lane >> 4;
#pragma unroll 1
    for (int t = C.vcu; t < 256; t += C.G) {
        const int m = (t >> 4) * 64 + (C.wave & 3) * 16 + fr, n0 = (t & 15) * 64 + (C.wave >> 2) * 32;
        const unsigned char* ap = A8 + (size_t)m * DM + fq * 32;
        const unsigned char* bp = W8 + (size_t)(n0 + fr) * DM + fq * 32;
        const int nc = n0 + 4 * fq;
        unsigned ga[2], gb[2]; f32x4 xv[2], gv[2];
        if (MERGE) {
#pragma unroll
            for (int nb = 0; nb < 2; ++nb) { ga[nb] = *(const unsigned*)(G8 + (size_t)m * PROW + GA8 + nc + nb * 16); gb[nb] = *(const unsigned*)(G8 + (size_t)m * PROW + GB8 + nc + nb * 16); }
        } else {
#pragma unroll
            for (int nb = 0; nb < 2; ++nb) { const u32x2 w_ = *(const u32x2*)(xs + (size_t)m * DM + nc + nb * 16); xv[nb] = (f32x4){bflo(w_.x), bfhi(w_.x), bflo(w_.y), bfhi(w_.y)}; gv[nb] = *(const f32x4*)(gt + nc + nb * 16); }
        }
        f32x4 acc[2] = {(f32x4){0.f, 0.f, 0.f, 0.f}, (f32x4){0.f, 0.f, 0.f, 0.f}};
#pragma unroll
        for (int h = 0; h < 2; ++h) {
            u32x4 av[4][2], b0[4][2], b1[4][2];
#pragma unroll
            for (int k = 0; k < 4; ++k) { const int kb = (h * 4 + k) * 128;
                av[k][0] = *(const u32x4*)(ap + kb); av[k][1] = *(const u32x4*)(ap + kb + 16);
                b0[k][0] = *(const u32x4*)(bp + kb); b0[k][1] = *(const u32x4*)(bp + kb + 16);
                b1[k][0] = *(const u32x4*)(bp + 16 * DM + kb); b1[k][1] = *(const u32x4*)(bp + 16 * DM + kb + 16); }
#pragma unroll
            for (int k = 0; k < 4; ++k) {
                const pg8::i32x8v a8 = {(int)av[k][0].x, (int)av[k][0].y, (int)av[k][0].z, (int)av[k][0].w, (int)av[k][1].x, (int)av[k][1].y, (int)av[k][1].z, (int)av[k][1].w};
                const pg8::i32x8v w0 = {(int)b0[k][0].x, (int)b0[k][0].y, (int)b0[k][0].z, (int)b0[k][0].w, (int)b0[k][1].x, (int)b0[k][1].y, (int)b0[k][1].z, (int)b0[k][1].w};
                const pg8::i32x8v w1 = {(int)b1[k][0].x, (int)b1[k][0].y, (int)b1[k][0].z, (int)b1[k][0].w, (int)b1[k][1].x, (int)b1[k][1].y, (int)b1[k][1].z, (int)b1[k][1].w};
                acc[0] = __builtin_amdgcn_mfma_scale_f32_16x16x128_f8f6f4(w0, a8, acc[0], 0, 0, 0, sclW, 0, sclA);
                acc[1] = __builtin_amdgcn_mfma_scale_f32_16x16x128_f8f6f4(w1, a8, acc[1], 0, 0, 0, sclW, 0, sclA); }
            if (MERGE && h == 0) {
#pragma unroll
                for (int nb = 0; nb < 2; ++nb)
#pragma unroll
                    for (int k = 0; k < 4; ++k) acc[nb][k] *= pg8::EpiGateF::ub(ga[nb], k) * __builtin_amdgcn_rcpf(pg8::EpiGateF::ub(gb[nb], k));
            }
        }
        if (MERGE) { constexpr float sa = (float)(1 << FP8_AEXP) / 255.0f;
#pragma unroll
            for (int nb = 0; nb < 2; ++nb) { const f32x4 v = acc[nb]; const unsigned wb = gb[nb];
                *(unsigned*)(Y8 + (size_t)m * DM + nc + nb * 16) = pk4_fp8_sat(v[0] * sa * pg8::EpiGateF::ub(wb, 0), v[1] * sa * pg8::EpiGateF::ub(wb, 1), v[2] * sa * pg8::EpiGateF::ub(wb, 2), v[3] * sa * pg8::EpiGateF::ub(wb, 3)); }
        } else {
#pragma unroll
            for (int nb = 0; nb < 2; ++nb) { const f32x4 o = xv[nb] + gv[nb] * acc[nb];
                u32x2 w; w.x = pg8::cvt_pk_bf16(o[0], o[1]); w.y = pg8::cvt_pk_bf16(o[2], o[3]); *(u32x2*)(xs + (size_t)m * DM + nc + nb * 16) = w; }
        }
    }
}
__device__ __forceinline__ void transpose_item(const float* W, int N, bf16* WT, int ldo, int k0, int n0, int orow0, const float* gain, LAS float* scr, int lane) {
    float tv[32];
#pragma unroll
    for (int i = 0; i < 32; ++i) { const int kk = 2 * i + (lane >> 5); tv[i] = __builtin_nontemporal_load(W + (size_t)(k0 + kk) * N + n0 + (lane & 31)); }
#pragma unroll
    for (int i = 0; i < 32; ++i) { const int kk = 2 * i + (lane >> 5); float v = tv[i]; if (gain) v *= gain[k0 + kk]; scr[kk * 33 + (lane & 31)] = v; }
    LDS_WAIT(); asm volatile("" ::: "memory");
    const int c = lane & 7;
#pragma unroll
    for (int j = 0; j < 4; ++j) { const int n = (lane >> 3) + 8 * j; const LAS float* s = scr + (8 * c) * 33 + n;
        u32x4 o; o.x = pk2(s[0 * 33], s[1 * 33]); o.y = pk2(s[2 * 33], s[3 * 33]); o.z = pk2(s[4 * 33], s[5 * 33]); o.w = pk2(s[6 * 33], s[7 * 33]);
        *(GAS u32x4*)(WT + (size_t)(orow0 + n) * ldo + k0 + 8 * c) = o; }
    LDS_WAIT(); asm volatile("" ::: "memory");
}
template <bool I8>
__device__ __forceinline__ void transpose_item8(const float* W, int N, unsigned char* WT, int ldo, int k0, int n0, int orow0, float scl, LAS float* scr, int lane, int kdoff = 0) {
    float tv[32];
#pragma unroll
    for (int i = 0; i < 32; ++i) { const int kk = 2 * i + (lane >> 5); tv[i] = __builtin_nontemporal_load(W + (size_t)(k0 + kk) * N + n0 + (lane & 31)); }
#pragma unroll
    for (int i = 0; i < 32; ++i) { const int kk = 2 * i + (lane >> 5); scr[kk * 33 + (lane & 31)] = I8 ? tv[i] : tv[i] * scl; }
    LDS_WAIT(); asm volatile("" ::: "memory");
    const int c = lane & 7;
#pragma unroll
    for (int j = 0; j < 4; ++j) { const int n = (lane >> 3) + 8 * j; const LAS float* s = scr + (8 * c) * 33 + n;
        u32x2 o; if (I8) { o.x = pk4_i8(s[0 * 33], s[1 * 33], s[2 * 33], s[3 * 33], scl); o.y = pk4_i8(s[4 * 33], s[5 * 33], s[6 * 33], s[7 * 33], scl); }
        else { o.x = pk4_fp8(s[0 * 33], s[1 * 33], s[2 * 33], s[3 * 33]); o.y = pk4_fp8(s[4 * 33], s[5 * 33], s[6 * 33], s[7 * 33]); }
        *(GAS u32x2*)(WT + (size_t)(orow0 + n) * ldo + kdoff + k0 + 8 * c) = o; }
    LDS_WAIT(); asm volatile("" ::: "memory");
}
constexpr int CS_IN = 16 * 101, CS_UQ = 4 * 24, CS_UKV = 2 * 32, CS_OA = 8 * 32, CS_PAD = 96, CS_PAD2 = 256;
constexpr int CONV_NSTATIC = CS_IN + CS_UQ + CS_UKV + 2 * CS_OA + CS_PAD + CS_PAD2;
constexpr int CQ_OUT = 16 * 32, CQ_G = 16 * 16, CQ_D = 8 * 32;
constexpr int CONV_NQUEUE = CQ_OUT + 17 * 2 * CQ_G + 17 * CQ_D;
__device__ __forceinline__ void convert_static_item(const Ctx& C, int l, int it, LAS float* scr) {
    bf16* WB = (bf16*)(CWS + WS_W) + (size_t)l * WL_STRIDE;
    constexpr float WS8 = (float)(1 << FP8_WEXP), WI8 = (float)(1 << I8_WEXP);
    int r = it;
    if (r < CS_IN) { const int kb = r / 101, nb = r % 101; transpose_item8<true>(CIN(8) + (size_t)l * DM * INC, INC, (unsigned char*)(WB + WO_IN), 1024, 64 * kb, 32 * nb, (32 * nb < C_QB) ? 32 * nb : 32 * nb + 96, WI8, scr, C.lane); return; } r -= CS_IN;
    if (r < CS_UQ) { const int kb = r / 24, nb = r % 24; transpose_item(CIN(10) + (size_t)l * 256 * 768, 768, WB + WO_UQ, 256, 64 * kb, 32 * nb, 32 * nb, CIN(9) + l * 256, scr, C.lane); return; } r -= CS_UQ;
    if (r < CS_UKV) { const int kb = r / 32, nb = r % 32; transpose_item(CIN(12) + (size_t)l * 128 * 1024, 1024, WB + WO_UKV, 256, 64 * kb, 32 * nb, 32 * nb, CIN(11) + l * 128, scr, C.lane); return; } r -= CS_UKV;
    if (r < CS_OA) { const int kb = r / 32, nb = r % 32; transpose_item8<false>(CIN(17) + (size_t)l * 512 * DM, 1024, (unsigned char*)(WB + WO_OA), 1024, 64 * kb, 32 * nb, 32 * nb, WS8, scr, C.lane, 0); return; } r -= CS_OA;
    if (r < CS_OA) { const int kb = r / 32, nb = r % 32; transpose_item8<false>(CIN(18) + (size_t)l * 512 * DM, 1024, (unsigned char*)(WB + WO_OA), 1024, 64 * kb, 32 * nb, 32 * nb, WS8, scr, C.lane, 512); return; } r -= CS_OA;
    u32x4 zz = (u32x4){0u, 0u, 0u, 0u}; asm volatile("" : "+v"(zz));
    if (r < CS_PAD) { unsigned char* p = (unsigned char*)(WB + WO_IN) + (size_t)(C_QB + r) * 1024;
      *(GAS u32x4*)(p + C.lane * 16) = zz; return; } r -= CS_PAD;
    { const int row = r * 4 + (C.lane >> 4), ch = C.lane & 15;
      *(GAS u32x4*)(WB + WO_UKV + (size_t)row * 256 + 128 + ch * 8) = zz; }
}
__device__ __forceinline__ void convert_queue_item(const Ctx& C, int l, int it, LAS float* scr) {
    bf16* WB = (bf16*)(CWS + WS_W) + (size_t)l * WL_STRIDE;
    constexpr float WS8 = (float)(1 << FP8_WEXP), WI8 = (float)(1 << I8_WEXP);
    int r = it;
    if (r < CQ_OUT) { const int kb = r / 32, nb = r % 32; transpose_item8<false>(CIN(19) + (size_t)l * DM * DM, 1024, (unsigned char*)(WB + WO_OUT), 1024, 64 * kb, 32 * nb, 32 * nb, WS8, scr, C.lane); return; } r -= CQ_OUT;
    if (r < 17 * 2 * CQ_G) { const int e = r / (2 * CQ_G), q = r % (2 * CQ_G), up = q / CQ_G, sx = q % CQ_G, kb = sx / 16, nb = sx % 16;
        const float* src = (e < 16) ? ((up ? CIN(23) : CIN(22)) + ((size_t)l * NEXP + e) * DM * FF) : ((up ? CIN(26) : CIN(25)) + (size_t)l * DM * FF);
        const int n0 = 32 * nb, orow = (n0 >> 7) * 256 + up * 128 + (n0 & 127);
        transpose_item8<true>(src, FF, (unsigned char*)(WB + WO_GU) + (size_t)e * 1024 * 1024, 1024, 64 * kb, n0, orow, WI8, scr, C.lane); return; } r -= 17 * 2 * CQ_G;
    { const int e = r / CQ_D, sx = r % CQ_D, kb = sx / 32, nb = sx % 32;
        const float* src = (e < 16) ? (CIN(24) + ((size_t)l * NEXP + e) * FF * DM) : (CIN(27) + (size_t)l * FF * DM);
        transpose_item8<false>(src, 1024, (unsigned char*)(WB + WO_DN) + (size_t)e * 1024 * 512, 512, 64 * kb, 32 * nb, 32 * nb, WS8, scr, C.lane); }
}
__device__ __forceinline__ void convert_static(const Ctx& C, int l, int gw, int ngw) {
    LAS float* scr = (LAS float*)(C.lds + C.wave * 12288);
    for (int it = gw; it < CONV_NSTATIC; it += ngw) convert_static_item(C, l, it, scr);
}
__device__ __forceinline__ int convert_steal(const Ctx& C, int l, int limit, int max_grabs, bool precheck = false) {
    LAS float* scr = (LAS float*)(C.lds + C.wave * 12288);
    LAS int* sb = (LAS int*)(C.lds + LDSX_PFX + 128);
    unsigned* head = (unsigned*)(CWS + WS_CTL) + CW_STEAL + 64 * l;
    int g = 0;
    if (precheck) {
        __syncthreads();
        if (C.tid == 0) *sb = (int)__hip_atomic_load(head, __ATOMIC_RELAXED, __HIP_MEMORY_SCOPE_AGENT);
        __syncthreads();
        const int h0 = __builtin_amdgcn_readfirstlane(*sb);
        __syncthreads();
        if (h0 >= limit) return 0;
    }
    for (; g < max_grabs; ++g) {
        __syncthreads();
        if (C.tid == 0) *sb = (int)__hip_atomic_fetch_add(head, 16u, __ATOMIC_RELAXED, __HIP_MEMORY_SCOPE_AGENT);
        __syncthreads();
        const int base = __builtin_amdgcn_readfirstlane(*sb);
        if (base >= CONV_NQUEUE) break;
#pragma unroll 1
        for (int k = 0; k < 2; ++k) { const int it = base + C.wave * 2 + k; if (it < CONV_NQUEUE) convert_queue_item(C, l, it, scr); }
        if (base + 16 >= limit) { ++g; break; }
    }
    __syncthreads();
    return g;
}
__device__ __forceinline__ unsigned queue_head_early(const Ctx& C, int l) {
    unsigned h = 0u; if (C.tid == 0) h = __hip_atomic_load((unsigned*)(CWS + WS_CTL) + CW_STEAL + 64 * l, __ATOMIC_RELAXED, __HIP_MEMORY_SCOPE_AGENT); return h; }
__device__ __forceinline__ void sweep_late(const Ctx& C, int l, int limit, unsigned hq) {
    LAS int* sb = (LAS int*)(C.lds + LDSX_PFX + 128);
    __syncthreads();
    if (C.tid == 0) *sb = (int)hq;
    __syncthreads();
    const int h0 = __builtin_amdgcn_readfirstlane(*sb);
    __syncthreads();
    if (h0 < limit) (void)convert_steal(C, l, limit, 1 << 20);
}
__device__ __forceinline__ void mod_gemv(const Ctx& C, int unit) {
    const int l = unit / 24, jb = unit % 24, j = jb * 256 + 4 * C.lane;
    const float* wm = CIN(4) + (size_t)l * DM * 6144 + j; const float* cc = CIN(1); const float* cx = CIN(3);
    f32x4 acc[5];
#pragma unroll
    for (int w = 0; w < 5; ++w) acc[w] = (f32x4){0.f, 0.f, 0.f, 0.f};
#pragma unroll
    for (int dc = 0; dc < 2; ++dc) { const int d0 = C.wave * 128 + dc * 64;
        float s[5];
#pragma unroll
        for (int w = 0; w < 5; ++w) { const float v = (w < 4) ? cc[w * DM + d0 + C.lane] : cx[d0 + C.lane]; s[w] = v * sigmoidf_(v); }
#pragma unroll
        for (int db = 0; db < 64; db += 16) { f32x4 wv[16];
#pragma unroll
            for (int dd = 0; dd < 16; ++dd) wv[dd] = __builtin_nontemporal_load((const f32x4*)(wm + (size_t)(d0 + db + dd) * 6144));
#pragma unroll
            for (int dd = 0; dd < 16; ++dd) asm volatile("" : "+v"(wv[dd]));
#pragma unroll
            for (int dd = 0; dd < 16; ++dd)
#pragma unroll
                for (int w = 0; w < 5; ++w) acc[w] = acc[w] + wv[dd] * rlane(s[w], db + dd); } }
    LAS f32x4* part = (LAS f32x4*)C.lds;
#pragma unroll
    for (int w = 0; w < 5; ++w) part[(C.wave * 5 + w) * 64 + C.lane] = acc[w];
    __syncthreads();
    if (C.wave < 5) { f32x4 t = (f32x4){0.f, 0.f, 0.f, 0.f};
#pragma unroll
        for (int k = 0; k < 8; ++k) t = t + part[(k * 5 + C.wave) * 64 + C.lane];
        float* mv = (float*)(CWS + WS_MISC + MO_MODV) + (size_t)l * 5 * 6144; *(f32x4*)(mv + C.wave * 6144 + j) = t + *(const f32x4*)(CIN(5) + l * 6144 + j); }
    __syncthreads();
}
__device__ __forceinline__ void make_tables(const Ctx& C) {
    float* ta = (float*)(CWS + WS_MISC + MO_TABA); float* tb = (float*)(CWS + WS_MISC + MO_TABB);
    for (int i = C.lane; i < 64 * 8; i += 64) { const int pos = i >> 3, f = i & 7; const float inv = exp2f(-13.287712379549449f * (float)(2 * f) / 16.0f); const float a = (float)pos * inv; ta[2 * i] = cosf(a); ta[2 * i + 1] = sinf(a); }
    for (int i = C.lane; i < 64 * 16; i += 64) { const int pos = i >> 4, f = i & 15; const float inv = exp2f(-13.287712379549449f * (float)(2 * f) / 32.0f); const float a = (float)pos * inv; tb[2 * i] = cosf(a); tb[2 * i + 1] = sinf(a); }
    float* cb = (float*)(CWS + WS_MISC + MO_CB);
    for (int l = 0; l < NLAYER; ++l) {
        float ma = 0.f, mb = 0.f, mc = 0.f, md = 0.f;
        for (int i = C.lane; i < 96; i += 64) { ma = fmaxf(ma, fabsf(CIN(13)[l * 96 + i])); mb = fmaxf(mb, fabsf(CIN(14)[l * 96 + i])); }
        { const int i = C.lane; mc = fabsf(CIN(15)[l * 64 + i]); md = fabsf(CIN(16)[l * 64 + i]); }
#pragma unroll
        for (int o = 1; o < 64; o <<= 1) { ma = fmaxf(ma, shx(ma, C.lane, o)); mb = fmaxf(mb, shx(mb, C.lane, o)); mc = fmaxf(mc, shx(mc, C.lane, o)); md = fmaxf(md, shx(md, C.lane, o)); }
        if (C.lane == 0) { cb[l * 2 + 0] = -(SCA * 96.0f * ma * mb * 1.02f + 0.5f); cb[l * 2 + 1] = -(SCB * 64.0f * mc * md * 1.02f + 0.5f); }
    }
}
__device__ __forceinline__ const float* stream_in(const Ctx& C, int l, int r) { return (r < TC) ? CIN(2) + (size_t)r * DM : CIN(0) + (size_t)(r - TC) * DM; }
__device__ __forceinline__ void xs_load(const bf16* row, int lane, f32x4 (&v)[4]) {
#pragma unroll
    for (int j = 0; j < 4; ++j) { const u32x2 w = *(const u32x2*)(row + j * 256 + 4 * lane); v[j] = (f32x4){bflo(w.x), bfhi(w.x), bflo(w.y), bfhi(w.y)}; }
}
__device__ __forceinline__ void xs_store(bf16* row, int lane, const f32x4 (&v)[4]) {
#pragma unroll
    for (int j = 0; j < 4; ++j) { u32x2 w; w.x = pk2(v[j].x, v[j].y); w.y = pk2(v[j].z, v[j].w); *(u32x2*)(row + j * 256 + 4 * lane) = w; }
}
__device__ __forceinline__ void expert_prefix(const unsigned* cnt, int srow0, LAS int* pfx, int tid) {
    if (tid == 0) { int s = 0;
#pragma unroll
        for (int e = 0; e < 16; ++e) { pfx[e] = s; s += ((int)cnt[64 * e] + 255) >> 8; }
        pfx[16] = s; s += (T - srow0) >> 8; pfx[17] = s; }
    __syncthreads();
}
__device__ __forceinline__ void wave_rows(int gw, int NGW, int lo, int hi, int& rb, int& re) { const int n = hi - lo, q = n / NGW, rem = n % NGW; rb = lo + gw * q + (gw < rem ? gw : rem); re = rb + q + (gw < rem ? 1 : 0); }
struct CombIdx { size_t r0, r1, r2; };
__device__ __forceinline__ CombIdx comb_idx(const Ctx& C, int r, const LAS int* pfx, int srow0) {
    const int* tp = (const int*)(CWS + WS_ROUTE + RO_TOKPOS) + 2 * r; const int t0 = tp[0], t1 = tp[1];
    CombIdx ci; ci.r0 = (size_t)pfx[16] * 256 + (r - srow0); ci.r1 = (size_t)pfx[t0 >> 20] * 256 + (t0 & 0xfffff); ci.r2 = (size_t)pfx[t1 >> 20] * 256 + (t1 & 0xfffff); return ci;
}
__device__ __forceinline__ void comb_load(const Ctx& C, const CombIdx& ci, unsigned (&y)[3][4]) {
    const unsigned char* YE = (const unsigned char*)(CWS + WS_R2);
#pragma unroll
    for (int j = 0; j < 4; ++j) { y[0][j] = __builtin_nontemporal_load((const unsigned*)(YE + ci.r0 * DM + j * 256 + 4 * C.lane)); y[1][j] = __builtin_nontemporal_load((const unsigned*)(YE + ci.r1 * DM + j * 256 + 4 * C.lane)); y[2][j] = __builtin_nontemporal_load((const unsigned*)(YE + ci.r2 * DM + j * 256 + 4 * C.lane)); }
}
__device__ __forceinline__ f32x4 fp8x4_to_f32(unsigned w) {
    const f32x2 lo = __builtin_amdgcn_cvt_pk_f32_fp8((int)w, false), hi = __builtin_amdgcn_cvt_pk_f32_fp8((int)w, true);
    return (f32x4){lo.x, lo.y, hi.x, hi.y};
}
__device__ __forceinline__ void comb_apply(const Ctx& C, const LAS float* gt2, const unsigned (&y)[3][4], f32x4 (&v)[4]) {
    constexpr float us = 1.0f / (float)(1 << FP8_AEXP);
#pragma unroll
    for (int j = 0; j < 4; ++j) { const f32x4 g = *(const LAS f32x4*)(gt2 + j * 256 + 4 * C.lane);
        const f32x4 t = (fp8x4_to_f32(y[0][j]) + fp8x4_to_f32(y[1][j]) + fp8x4_to_f32(y[2][j])) * us;
        v[j] = v[j] + g * t; }
}
__device__ __forceinline__ void mod_chunk_to_lds(LAS float* dst, const float* modv_layer, int chunk, int tid) {
#pragma unroll
    for (int q = 0; q < 10; ++q) { const int i = q * NTHR + tid, w = i >> 10, j = i & 1023; dst[i] = modv_layer[(size_t)(w * 6 + chunk) * DM + j]; }
}
__device__ __forceinline__ void norm_mod_row(const Ctx& C, const f32x4 (&v)[4], const f32x4 (&g)[4], const LAS float* sh, const LAS float* sc, unsigned char* orow, f32x4 (&f)[4]) {
    float s = 0.f;
#pragma unroll
    for (int j = 0; j < 4; ++j) s += (v[j].x * v[j].x + v[j].y * v[j].y) + (v[j].z * v[j].z + v[j].w * v[j].w);
    const float rstd = __builtin_amdgcn_rsqf(wave_sum(s, C.lane) * (1.0f / DM) + EPS);
#pragma unroll
    for (int j = 0; j < 4; ++j) { const int c = j * 256 + 4 * C.lane;
        const f32x4 a = *(const LAS f32x4*)(sc + c), b = *(const LAS f32x4*)(sh + c);
        f[j] = (v[j] * rstd) * g[j] * (a + 1.0f) + b;
        *(unsigned*)(orow + c) = pk4_i8(f[j].x, f[j].y, f[j].z, f[j].w, (float)(1 << I8_AEXP)); }
}

constexpr int NPHASE = 1 + NLAYER * 10 + 1;

__global__ void __launch_bounds__(NTHR, 2) fwd_kernel(Args args) {
    extern __shared__ __attribute__((aligned(16))) unsigned char lds_raw[];
    Ctx C;
    C.lds = (LAS unsigned char*)lds_raw;
    C.tid = threadIdx.x; C.lane = C.tid & 63; C.wave = __builtin_amdgcn_readfirstlane(C.tid >> 6);
    C.G = gridDim.x; { const int bx = blockIdx.x; C.vcu = (C.G % 8 == 0) ? (bx % 8) * (C.G / 8) + bx / 8 : bx; }
    C.gw = C.vcu * NWAVES + C.wave; C.NGW = C.G * NWAVES;
    C.ap = (ArgsP)__builtin_amdgcn_kernarg_segment_ptr();
    unsigned char* ws = C.ap->ws;
    unsigned* ctl = (unsigned*)(ws + WS_CTL);
    volatile LAS unsigned* bst = (volatile LAS unsigned*)(C.lds + LDSX_MISC);
    if (C.tid < 4) bst[C.tid] = 0u;
    __syncthreads();
    XcdBarrier bar = xcd_barrier_post(ctl + CW_BAR + C.ap->li * XCD_BAR_WORDS, bst);
    const int lo = C.ap->ph_lo, hi = C.ap->ph_hi;
#ifndef PHMASK
#define PHMASK 0xfff
#endif
#define EN(kind) (((PHMASK) >> (kind)) & 1)
#ifndef REPMASK
#define REPMASK 0
#endif
#define NREP(kind) (1 + (((REPMASK) >> (kind)) & 1))
#define IN(k) (lo <= (k) && (k) < hi)
#ifndef BARX
#define BARX 1
#endif
#define SEAM(k) do { if (IN(k) && IN((k) + 1)) { _Pragma("unroll 1") for (int bx_ = 0; bx_ < BARX; ++bx_) { XcdBarrier b_ = bar; asm volatile("" : "+s"(b_.x)); xcd_barrier(b_); } } } while (0)
    LAS int* gtab = (LAS int*)(C.lds + LDSX_GTAB);
    LAS int* pfxl = (LAS int*)(C.lds + LDSX_PFX);
#define PH() { ArgsP _ap = C.ap; asm volatile("" : "+s"(_ap)); C.ap = _ap; int t_ = threadIdx.x; asm volatile("" : "+v"(t_)); C.tid = t_; C.lane = t_ & 63; C.wave = __builtin_amdgcn_readfirstlane(t_ >> 6); C.gw = C.vcu * NWAVES + C.wave; } \
    unsigned char* ws = C.ap->ws; unsigned* ctl = (unsigned*)(ws + WS_CTL); (void)ctl; \
    float* MODV = (float*)(ws + WS_MISC + MO_MODV); (void)MODV; bf16* WB = (bf16*)(ws + WS_W) + (size_t)l * WL_STRIDE; (void)WB; \
    bf16* R1 = (bf16*)(ws + WS_R1); (void)R1; bf16* PROJ = (bf16*)(ws + WS_R2); (void)PROJ; bf16* UQ = (bf16*)(ws + WS_R4); (void)UQ; bf16* QA = UQ; (void)QA; bf16* XS = (bf16*)(ws + WS_R5); (void)XS; \
    unsigned char* KA = ws + WS_R3 + R3_KA; (void)KA; bf16* VA = (bf16*)(ws + WS_R3 + R3_VA); (void)VA; unsigned char* QB = ws + WS_R3 + R3_QB; (void)QB; \
    unsigned char* KB = ws + WS_R3 + R3_KB; (void)KB; bf16* VB = (bf16*)(ws + WS_R3 + R3_VB); (void)VB; unsigned char* QA8 = ws + WS_R3 + R3_QA; (void)QA8; \
    bf16* Y1 = (bf16*)(ws + WS_R3 + R3_Y1); (void)Y1; bf16* YY = (bf16*)(ws + WS_R3 + R3_Y); (void)YY; bf16* HH = (bf16*)(ws + WS_R3 + R3_HH); (void)HH; \
    const float* modl = MODV + (size_t)l * 5 * 6144; (void)modl;

    if (EN(0) && IN(0)) {
#pragma unroll 1
      for (int rep = 0; rep < NREP(0); ++rep) {
        { ArgsP _ap = C.ap; asm volatile("" : "+s"(_ap)); C.ap = _ap; }
        const bool big = (C.G >= 250); const bool gemv_wg = big && (C.vcu % 5 == 0) && (C.vcu < 240);
        if (!big) { for (int u = C.vcu; u < 48; u += C.G) mod_gemv(C, u); } else if (gemv_wg) mod_gemv(C, C.vcu / 5);
        if (C.wave == 1 && C.vcu == 241 % C.G) make_tables(C);
        if (!big) convert_static(C, 0, C.gw, C.NGW); else if (!gemv_wg) { const int v3 = (C.vcu < 240) ? C.vcu - C.vcu / 5 - 1 : C.vcu - 48; convert_static(C, 0, v3 * NWAVES + C.wave, (C.G - 48) * NWAVES); }
        if (big && !gemv_wg) (void)convert_steal(C, 0, CONV_NQUEUE, 2);
        __syncthreads();
      }
    }
    SEAM(0);

    for (int l = 0; l < NLAYER; ++l) {
        const int P = 1 + l * 10;
        const bool lastl = (l == NLAYER - 1);
        const int mrow0 = lastl ? TC : 0;

        if (EN(1) && IN(P + 0)) {
#pragma unroll 1
          for (int rep = 0; rep < (NREP(1) > 1 && l == 0 ? 2 : 1); ++rep) {
            PH();
            if (l > 0 && !IN(P - 2)) expert_prefix(ctl + CW_CNT + (l - 1) * 1024, 0, pfxl, C.tid);
            LAS float* mt = (LAS float*)C.lds;
            mod_chunk_to_lds(mt, modl, 0, C.tid); mod_chunk_to_lds(mt + 5 * DM, modl, 1, C.tid);
            if (l > 0) mod_chunk_to_lds(mt + 10 * DM, MODV + (size_t)(l - 1) * 5 * 6144, 5, C.tid);
            f32x4 gv[4];
#pragma unroll
            for (int j = 0; j < 4; ++j) gv[j] = *(const f32x4*)(CIN(6) + l * DM + j * 256 + 4 * C.lane);
            __syncthreads();
            int rb, re; wave_rows(C.gw, C.NGW, 0, T, rb, re);
            if (l == 0) {
                for (int r0 = rb; r0 < re; r0 += 4) {
                    f32x4 v[4][4], f[4];
#pragma unroll
                    for (int k = 0; k < 4; ++k) { const int r = (r0 + k < re) ? r0 + k : re - 1; const float* src = stream_in(C, 0, r);
#pragma unroll
                        for (int j = 0; j < 4; ++j) v[k][j] = __builtin_nontemporal_load((const f32x4*)(src + j * 256 + 4 * C.lane)); }
#pragma unroll
                    for (int k = 0; k < 4; ++k) if (r0 + k < re) { const int r = r0 + k, which = (r < TC) ? 4 : ((r - TC) >> 12);
                        xs_store(XS + (size_t)r * DM, C.lane, v[k]);
                        norm_mod_row(C, v[k], gv, mt + which * DM, mt + (5 + which) * DM, (unsigned char*)R1 + (size_t)r * DM, f); }
                }
            } else {
                constexpr int NB = 4;
                CombIdx cn[NB];
#pragma unroll
                for (int k = 0; k < NB; ++k) { const int r = (rb + k < re) ? rb + k : re - 1; cn[k] = comb_idx(C, r, pfxl, 0); }
                for (int r0 = rb; r0 < re; r0 += NB) {
                    f32x4 v[NB][4], f[4]; unsigned y[NB][3][4]; CombIdx ci[NB];
#pragma unroll
                    for (int k = 0; k < NB; ++k) { const int r = (r0 + k < re) ? r0 + k : re - 1; ci[k] = cn[k]; xs_load(XS + (size_t)r * DM, C.lane, v[k]); }
#pragma unroll
                    for (int k = 0; k < NB; ++k) comb_load(C, ci[k], y[k]);
#pragma unroll
                    for (int k = 0; k < NB; ++k) { const int r = (r0 + NB + k < re) ? r0 + NB + k : re - 1; cn[k] = comb_idx(C, r, pfxl, 0); }
#pragma unroll
                    for (int k = 0; k < NB; ++k) if (r0 + k < re) { const int r = r0 + k, which = (r < TC) ? 4 : ((r - TC) >> 12);
                        comb_apply(C, mt + (10 + which) * DM, y[k], v[k]); xs_store(XS + (size_t)r * DM, C.lane, v[k]);
                        norm_mod_row(C, v[k], gv, mt + which * DM, mt + (5 + which) * DM, (unsigned char*)R1 + (size_t)r * DM, f); }
                }
            }
            __syncthreads();
            if (l > 0) convert_static(C, l, C.gw, C.NGW);
          }
        }
        SEAM(P + 0);

        if (EN(2) && IN(P + 1)) {
#pragma unroll 1
          for (int rep = 0; rep < NREP(2); ++rep) {
            PH();
            constexpr int SW = 0x01010101 * (127 - FP8_WEXP), SA0 = 0x7f7f7f7f;
            pg8::StaticOrder S; S.init(T, INCP, C.G, (int)blockIdx.x, DM / 2, DM / 2);
            pg8::EpiProj E{PROJ};
            pg8::gemm_phase<pg8::EpiProj, pg8::StaticOrder, false, 2>(C.lds, R1, DM / 2, WB + WO_IN, DM / 2, S, E, gtab, SW, SA0, 1.0f / (float)(1 << (I8_AEXP + I8_WEXP)));
            if ((S.nwg + C.G - 1 - S.c) / C.G < (S.nwg + C.G - 1) / C.G) (void)convert_steal(C, l, CONV_NQUEUE, 2);
          }
        }
        SEAM(P + 1);

        if (EN(3) && IN(P + 2)) {
#pragma unroll 1
          for (int rep = 0; rep < NREP(3); ++rep) {
            PH();
            { pg8::StaticOrder S; S.init(T, 768, C.G, (int)blockIdx.x, INCP, 256);
              pg8::EpiF8 E{(unsigned char*)UQ, 768};
              pg8::gemm_phase<pg8::EpiF8, pg8::StaticOrder, false>(C.lds, PROJ + C_CQ, INCP, WB + WO_UQ, 256, S, E, gtab); }
            __builtin_amdgcn_sched_barrier(0); asm volatile("" ::: "memory");
            { pg8::StaticOrder S; S.init(T, 1024, C.G, (int)((blockIdx.x + 52) % C.G), INCP, 256);
              pg8::EpiF8 E{(unsigned char*)R1, 1024};
              pg8::gemm_phase<pg8::EpiF8, pg8::StaticOrder, false>(C.lds, PROJ + C_CKV, INCP, WB + WO_UKV, 256, S, E, gtab); }
          }
        }
        SEAM(P + 2);

        if (EN(4) && IN(P + 3)) {
#pragma unroll 1
          for (int rep = 0; rep < (NREP(4) > 1 ? 2 : 1); ++rep) {
            PH();
            const unsigned hq = queue_head_early(C, l);
            const float* g_qa = CIN(13) + l * 96; const float* g_ka = CIN(14) + l * 96; const float* g_qb = CIN(15) + l * 64; const float* g_kb = CIN(16) + l * 64;
            const float* tabA = (const float*)(ws + WS_MISC + MO_TABA); const float* tabB = (const float*)(ws + WS_MISC + MO_TABB);
            const int h = C.lane >> 3, j = C.lane & 7, ax = j >> 2, i0 = 2 * (j & 3);
            float gqa_n[8], gka_n[8], gqa_r[4], gka_r[4], gqb8[8], gkb8[8];
#pragma unroll
            for (int e = 0; e < 8; ++e) { gqa_n[e] = g_qa[8 * j + e]; gka_n[e] = g_ka[8 * j + e]; gqb8[e] = g_qb[8 * j + e]; gkb8[e] = g_kb[8 * j + e]; }
#pragma unroll
            for (int e = 0; e < 2; ++e) { gqa_r[e] = g_qa[64 + ax * 16 + i0 + e]; gqa_r[2 + e] = g_qa[64 + ax * 16 + 8 + i0 + e]; gka_r[e] = g_ka[64 + ax * 16 + i0 + e]; gka_r[2 + e] = g_ka[64 + ax * 16 + 8 + i0 + e]; }
            sweep_late(C, l, CQ_OUT, hq);
            int rb, re; wave_rows(C.gw, C.NGW, 0, T, rb, re);
            for (int r0 = rb; r0 < re; r0 += 2) {
                u32x2 i_cq[2]; unsigned i_ckv[2], i_q1[2], i_q2[2], i_k1[2], i_k2[2]; u32x2 i_uq[2], i_uk[2], i_uv[2], i_qb[2], i_kb[2], i_vb[2]; f32x4 t_a[2], t_b[2][4];
#pragma unroll
                for (int k = 0; k < 2; ++k) { const int r = (r0 + k < re) ? r0 + k : re - 1;
                    const bf16* pr = PROJ + (size_t)r * INCP; const unsigned char* uq = (const unsigned char*)UQ + (size_t)r * 768 + h * 96; const unsigned char* uk = (const unsigned char*)R1 + (size_t)r * 1024 + h * 128;
#define NTL(T_, p_) __builtin_nontemporal_load((const T_*)(p_))
                    i_cq[k] = NTL(u32x2, pr + C_CQ + 4 * C.lane); i_ckv[k] = NTL(unsigned, pr + C_CKV + 2 * C.lane);
                    i_uq[k] = NTL(u32x2, uq + 8 * j); i_q1[k] = NTL(unsigned short, uq + 64 + ax * 16 + i0); i_q2[k] = NTL(unsigned short, uq + 64 + ax * 16 + 8 + i0);
                    i_uk[k] = NTL(u32x2, uk + 8 * j); i_uv[k] = NTL(u32x2, uk + 64 + 8 * j);
                    i_k1[k] = NTL(unsigned, pr + C_KR + ax * 16 + i0); i_k2[k] = NTL(unsigned, pr + C_KR + ax * 16 + 8 + i0);
                    { const unsigned char* p8 = (const unsigned char*)pr; i_qb[k] = NTL(u32x2, p8 + PQ8 + h * 64 + 8 * j); i_kb[k] = NTL(u32x2, p8 + PK8 + (h & 1) * 64 + 8 * j); i_vb[k] = NTL(u32x2, p8 + PV8 + (C.lane & 15) * 8); }
#undef NTL
                    { const int n_ = (r < TC) ? 0 : ((r - TC) & 4095), pos = ax ? (n_ & 63) : (n_ >> 6);
                      t_a[k] = *(const f32x4*)(tabA + (pos * 8 + i0) * 2);
#pragma unroll
                      for (int q = 0; q < 4; ++q) t_b[k][q] = *(const f32x4*)(tabB + (pos * 16 + (j & 1) * 8 + 2 * q) * 2); } }
#pragma unroll
              for (int k = 0; k < 2; ++k) if (r0 + k < re) { const int r = r0 + k;
                const bool isctx = r < TC; const int b = isctx ? (r >> 8) : ((r - TC) >> 12); const int n = isctx ? (r & 255) : ((r - TC) & 4095);
                const int Lidx = isctx ? n : CTXL + n; const int prow = n >> 6, pcol = n & 63;
                const size_t krow = (size_t)b * LK + Lidx;
                float s1, s2;
                { const u32x2 a = i_cq[k]; const float a0 = bflo(a.x), a1 = bfhi(a.x), a2 = bflo(a.y), a3 = bfhi(a.y); s1 = (a0 * a0 + a1 * a1) + (a2 * a2 + a3 * a3);
                  const unsigned c = i_ckv[k]; const float c0 = bflo(c), c1 = bfhi(c); s2 = c0 * c0 + c1 * c1; }
                const float rs_cq = __builtin_amdgcn_rsqf(wave_sum(s1, C.lane) * (1.0f / 256.0f) + EPS), rs_ckv = __builtin_amdgcn_rsqf(wave_sum(s2, C.lane) * (1.0f / 128.0f) + EPS);
                { unsigned char* qa = QA8 + (size_t)r * 1024 + h * 128;
                  const u32x2 a = i_uq[k];
                  const f32x2 a0 = __builtin_amdgcn_cvt_pk_f32_fp8((int)a.x, false), a1 = __builtin_amdgcn_cvt_pk_f32_fp8((int)a.x, true), a2 = __builtin_amdgcn_cvt_pk_f32_fp8((int)a.y, false), a3 = __builtin_amdgcn_cvt_pk_f32_fp8((int)a.y, true);
                  const f32x2 y1 = __builtin_amdgcn_cvt_pk_f32_fp8((int)i_q1[k], false), y2 = __builtin_amdgcn_cvt_pk_f32_fp8((int)i_q2[k], false);
                  float v[8] = {a0[0], a0[1], a1[0], a1[1], a2[0], a2[1], a3[0], a3[1]}; float x1[2] = {y1[0], y1[1]}, x2[2] = {y2[0], y2[1]};
                  const float rsq_ = rs_cq * (1.0f / (float)(1 << FP8_AEXP));
                  float ss = 0.f;
#pragma unroll
                  for (int e = 0; e < 8; ++e) { v[e] *= rsq_; ss += v[e] * v[e]; }
#pragma unroll
                  for (int e = 0; e < 2; ++e) { x1[e] *= rsq_; x2[e] *= rsq_; ss += x1[e] * x1[e] + x2[e] * x2[e]; }
                  const float rn = SCA * __builtin_amdgcn_rsqf(sum8(ss, C.lane) * (1.0f / 96.0f) + EPS);
#pragma unroll
                  for (int e = 0; e < 8; ++e) v[e] *= rn * gqa_n[e];
                  float o1[2], o2[2];
#pragma unroll
                  for (int e = 0; e < 2; ++e) { const float a1 = x1[e] * rn * gqa_r[e], a2 = x2[e] * rn * gqa_r[2 + e];
                      if (isctx) { o1[e] = a1; o2[e] = a2; } else { const float cc_ = t_a[k][2 * e], ss_ = t_a[k][2 * e + 1]; o1[e] = a1 * cc_ - a2 * ss_; o2[e] = a1 * ss_ + a2 * cc_; } }
                  constexpr float qs = (float)(1 << att::QEXP);
                  u32x4 w; w.x = pk4_fp8(v[0] * qs, v[1] * qs, v[2] * qs, v[3] * qs); w.y = pk4_fp8(v[4] * qs, v[5] * qs, v[6] * qs, v[7] * qs); w.z = pk4_fp8(o1[0] * qs, o1[1] * qs, o2[0] * qs, o2[1] * qs); w.w = 0u;
                  *(u32x4*)(qa + 16 * j) = w; }
                { const u32x2 a = i_uk[k], vv = i_uv[k];
                  const unsigned x1w = i_k1[k], x2w = i_k2[k];
                  const f32x2 a0 = __builtin_amdgcn_cvt_pk_f32_fp8((int)a.x, false), a1 = __builtin_amdgcn_cvt_pk_f32_fp8((int)a.x, true), a2 = __builtin_amdgcn_cvt_pk_f32_fp8((int)a.y, false), a3 = __builtin_amdgcn_cvt_pk_f32_fp8((int)a.y, true);
                  float v[8] = {a0[0], a0[1], a1[0], a1[1], a2[0], a2[1], a3[0], a3[1]}; float x1[2] = {bflo(x1w), bfhi(x1w)}, x2[2] = {bflo(x2w), bfhi(x2w)};
                  const float rsk_ = rs_ckv * (1.0f / (float)(1 << FP8_AEXP));
                  float ss = 0.f;
#pragma unroll
                  for (int e = 0; e < 8; ++e) { v[e] *= rsk_; ss += v[e] * v[e]; }
#pragma unroll
                  for (int e = 0; e < 2; ++e) ss += x1[e] * x1[e] + x2[e] * x2[e];
                  const float rn = __builtin_amdgcn_rsqf(sum8(ss, C.lane) * (1.0f / 96.0f) + EPS);
#pragma unroll
                  for (int e = 0; e < 8; ++e) v[e] *= rn * gka_n[e];
                  float o1[2], o2[2];
#pragma unroll
                  for (int e = 0; e < 2; ++e) { const float a1 = x1[e] * rn * gka_r[e], a2 = x2[e] * rn * gka_r[2 + e];
                      if (isctx) { o1[e] = a1; o2[e] = a2; } else { const float cc_ = t_a[k][2 * e], ss_ = t_a[k][2 * e + 1]; o1[e] = a1 * cc_ - a2 * ss_; o2[e] = a1 * ss_ + a2 * cc_; } }
                  unsigned char* ka = KA + krow * 1024 + h * 128;
                  u32x4 w; w.x = pk4_fp8(v[0], v[1], v[2], v[3]); w.y = pk4_fp8(v[4], v[5], v[6], v[7]); w.z = pk4_fp8(o1[0], o1[1], o2[0], o2[1]); w.w = 0u;
                  *(u32x4*)(ka + 16 * j) = w;
                  const f32x2 q0 = __builtin_amdgcn_cvt_pk_f32_fp8((int)vv.x, false), q1 = __builtin_amdgcn_cvt_pk_f32_fp8((int)vv.x, true), q2 = __builtin_amdgcn_cvt_pk_f32_fp8((int)vv.y, false), q3 = __builtin_amdgcn_cvt_pk_f32_fp8((int)vv.y, true);
                  u32x4 wv; wv.x = pk2(q0[0] * rsk_, q0[1] * rsk_); wv.y = pk2(q1[0] * rsk_, q1[1] * rsk_); wv.z = pk2(q2[0] * rsk_, q2[1] * rsk_); wv.w = pk2(q3[0] * rsk_, q3[1] * rsk_);
                  *(u32x4*)(VA + krow * 512 + h * 64 + 8 * j) = wv; }
#pragma unroll
                for (int pass = 0; pass < 2; ++pass) {
                    const int hh = pass ? (h & 1) : h;
                    const u32x2 a = pass ? i_kb[k] : i_qb[k];
                    const f32x2 a0 = __builtin_amdgcn_cvt_pk_f32_fp8((int)a.x, false), a1 = __builtin_amdgcn_cvt_pk_f32_fp8((int)a.x, true), a2 = __builtin_amdgcn_cvt_pk_f32_fp8((int)a.y, false), a3 = __builtin_amdgcn_cvt_pk_f32_fp8((int)a.y, true);
                    constexpr float u8_ = 1.0f / (float)(1 << FP8_AEXP);
                    float v[8] = {a0[0] * u8_, a0[1] * u8_, a1[0] * u8_, a1[1] * u8_, a2[0] * u8_, a2[1] * u8_, a3[0] * u8_, a3[1] * u8_};
                    float ss = 0.f;
#pragma unroll
                    for (int e = 0; e < 8; ++e) ss += v[e] * v[e];
                    const float rn = (pass ? 1.0f : SCB) * __builtin_amdgcn_rsqf(sum8(ss, C.lane) * (1.0f / 64.0f) + EPS);
#pragma unroll
                    for (int e = 0; e < 8; ++e) v[e] *= rn * (pass ? gkb8[e] : gqb8[e]);
                    float o[8];
#pragma unroll
                    for (int e = 0; e < 8; ++e) { const float px = dppf<DPP_X2>(v[e]);
                        if (isctx) o[e] = v[e];
                        else { const float cc_ = t_b[k][e >> 1][2 * (e & 1)], ss_ = t_b[k][e >> 1][2 * (e & 1) + 1]; o[e] = (j & 2) ? (px * ss_ + v[e] * cc_) : (v[e] * cc_ - px * ss_); } }
                    const float qs = pass ? 1.0f : (float)(1 << att::QEXP);
                    u32x2 w; w.x = pk4_fp8(o[0] * qs, o[1] * qs, o[2] * qs, o[3] * qs); w.y = pk4_fp8(o[4] * qs, o[5] * qs, o[6] * qs, o[7] * qs);
                    if (!pass) *(u32x2*)(QB + (size_t)r * 512 + h * 64 + 8 * j) = w;
                    else if (C.lane < 16) *(u32x2*)(KB + krow * 128 + hh * 64 + 8 * j) = w;
                }
                if (C.lane >= 16 && C.lane < 32) { const u32x2 a = i_vb[k]; constexpr float u8_ = 1.0f / (float)(1 << FP8_AEXP);
                    const f32x2 a0 = __builtin_amdgcn_cvt_pk_f32_fp8((int)a.x, false), a1 = __builtin_amdgcn_cvt_pk_f32_fp8((int)a.x, true), a2 = __builtin_amdgcn_cvt_pk_f32_fp8((int)a.y, false), a3 = __builtin_amdgcn_cvt_pk_f32_fp8((int)a.y, true);
                    u32x4 wv; wv.x = pk2(a0[0] * u8_, a0[1] * u8_); wv.y = pk2(a1[0] * u8_, a1[1] * u8_); wv.z = pk2(a2[0] * u8_, a2[1] * u8_); wv.w = pk2(a3[0] * u8_, a3[1] * u8_);
                    *(u32x4*)(VB + krow * 128 + (C.lane - 16) * 8) = wv; }
              }
            }
          }
        }
        SEAM(P + 3);

        if (EN(5) && IN(P + 4)) {
#pragma unroll 1
          for (int rep = 0; rep < NREP(5); ++rep) {
            PH();
            const float* cb = (const float*)(ws + WS_MISC + MO_CB) + l * 2;
            const float negA = cb[0], negB = cb[1];
            unsigned char* O = (unsigned char*)R1;
            const int NU = 1024 + (lastl ? 0 : 64);
            for (int u = C.vcu; u < NU; u += C.G) {
                int kind, b, hd, NT; size_t r0;
                if (u < 1024) { const int i = u >> 8, v = u & 255, idx = 2 * v + (i >> 1); kind = i & 1; NT = LK / 64;
                    if (kind == 0) { const int bh = idx >> 4, qb = idx & 15; b = bh >> 3; hd = bh & 7; r0 = (size_t)TC + (size_t)b * SEQ + qb * 256 + C.wave * 32; }
                    else { const int bk = idx >> 6, jj = idx & 63, qb = jj >> 2, g = jj & 3; b = bk >> 1; hd = (bk & 1) * 4 + g; r0 = (size_t)TC + (size_t)b * SEQ + qb * 256 + C.wave * 32; } }
                else { const int w = u - 1024, bh = w & 31; kind = w >> 5; b = bh >> 3; hd = bh & 7; NT = CTXL / 64; r0 = (size_t)b * CTXL + C.wave * 32; }
                if (kind == 0) att::attn_unit<96>(QA8 + r0 * 1024 + hd * 128, 1024, KA + (size_t)b * LK * 1024 + hd * 128, 1024, VA + (size_t)b * LK * 512 + hd * 64, 512, O + r0 * DM + hd * 64, NT, negA, C.lds);
                else att::attn_unit<64>(QB + r0 * 512 + hd * 64, 512, KB + (size_t)b * LK * 128 + (hd >> 2) * 64, 128, VB + (size_t)b * LK * 128 + (hd >> 2) * 64, 128, O + r0 * DM + 512 + hd * 64, NT, negB, C.lds);
            }
            if (!lastl && C.vcu + 1024 >= NU) { __syncthreads();
                const int g0 = convert_steal(C, l, CONV_NQUEUE, 1); if (g0 < 1 && l + 1 < NLAYER) (void)convert_steal(C, l + 1, CONV_NQUEUE, 1); }
          }
        }
        SEAM(P + 4);

        if (EN(6) && IN(P + 5)) {
#pragma unroll 1
          for (int rep = 0; rep < NREP(6); ++rep) {
            PH();
            const int M = T - TC; const unsigned char* O = (const unsigned char*)R1 + (size_t)TC * DM;
            constexpr int SW = 0x01010101 * (127 - FP8_WEXP), SA = 0x01010101 * (127 - FP8_AEXP);
            pg8::StaticOrder S; S.init(M, DM, C.G, (int)blockIdx.x, DM / 2, DM / 2);
            pg8::EpiGateF E{(unsigned char*)YY + (size_t)TC * DM, (const unsigned char*)PROJ + (size_t)TC * PROW};
            pg8::gemm_phase<pg8::EpiGateF, pg8::StaticOrder, false, 1, true>(C.lds, (const bf16*)O, DM / 2, WB + WO_OA, DM / 2, S, E, gtab, SW, SA);
            if (mrow0 == 0) ctx_mini_gemm<true>(C, (const unsigned char*)R1, (const unsigned char*)(WB + WO_OA), SW, SA, (unsigned char*)YY, (const unsigned char*)PROJ, nullptr, nullptr, nullptr);
            if ((S.nwg + C.G - 1 - S.c) / C.G < (S.nwg + C.G - 1) / C.G) { const int g0 = convert_steal(C, l, CONV_NQUEUE, 4); if (g0 < 4 && l + 1 < NLAYER) (void)convert_steal(C, l + 1, CONV_NQUEUE, 4 - g0); }
          }
        }
        SEAM(P + 5);

        if (EN(7) && IN(P + 6)) {
#pragma unroll 1
          for (int rep = 0; rep < (NREP(7) > 1 && l == 0 ? 2 : 1); ++rep) {
            PH();
            const int M = T - TC;
            constexpr int SW = 0x01010101 * (127 - FP8_WEXP), SA = 0x01010101 * (127 - FP8_AEXP);
            pg8::StaticOrder S; S.init(M, DM, C.G, (int)blockIdx.x, DM / 2, DM / 2);
            pg8::EpiRes E{XS, modl, TC, 2};
            pg8::gemm_phase<pg8::EpiRes, pg8::StaticOrder, false, 1>(C.lds, (const bf16*)((const unsigned char*)YY + (size_t)TC * DM), DM / 2, WB + WO_OUT, DM / 2, S, E, gtab, SW, SA);
            if (mrow0 == 0) ctx_mini_gemm<false>(C, (const unsigned char*)YY, (const unsigned char*)(WB + WO_OUT), SW, SA, nullptr, nullptr, nullptr, XS, modl + (size_t)(4 * 6 + 2) * DM);
            if ((S.nwg + C.G - 1 - S.c) / C.G < (S.nwg + C.G - 1) / C.G) { const int g0 = convert_steal(C, l, CONV_NQUEUE, 4); if (g0 < 4 && l + 1 < NLAYER) (void)convert_steal(C, l + 1, CONV_NQUEUE, 4 - g0); }
          }
        }
        SEAM(P + 6);

        if (EN(8) && IN(P + 7)) {
#pragma unroll 1
          for (int rep = 0; rep < NREP(8); ++rep) {
            PH();
            const unsigned hq = queue_head_early(C, l);
            float mA[10], mB[10]; f32x4 gv[4];
            LAS float* wT = (LAS float*)C.lds;
            { const f32x4* wsrc = (const f32x4*)CIN(20); f32x4 wq[8];
#pragma unroll
              for (int q = 0; q < 8; ++q) wq[q] = wsrc[q * NTHR + C.tid];
#pragma unroll
              for (int q = 0; q < 10; ++q) { const int i = q * NTHR + C.tid, w = i >> 10, j = i & 1023; mA[q] = modl[(size_t)(w * 6 + 3) * DM + j]; mB[q] = modl[(size_t)(w * 6 + 4) * DM + j]; }
#pragma unroll
              for (int j = 0; j < 4; ++j) gv[j] = *(const f32x4*)(CIN(7) + l * DM + j * 256 + 4 * C.lane);
              sweep_late(C, l, CONV_NQUEUE, hq);
#pragma unroll
              for (int q = 0; q < 8; ++q) { const int i4 = q * NTHR + C.tid, d = i4 >> 2, e0 = (i4 & 3) * 4;
#pragma unroll
                  for (int k = 0; k < 4; ++k) wT[(e0 + k) * DM + d] = wq[q][k]; } }
            LAS int* lcnt = (LAS int*)(C.lds + 65536);
            LAS int* rt_row = lcnt + 32; LAS int* rt_e = rt_row + 256; LAS int* rt_lp = rt_e + 512; LAS float* rt_w = (LAS float*)(rt_lp + 512);
            if (C.tid < 32) lcnt[C.tid] = 0;
            __syncthreads();
            const float* brt = CIN(21);
            LAS float* mt = (LAS float*)(C.lds + 80 * 1024);
#pragma unroll
            for (int q = 0; q < 10; ++q) { const int i = q * NTHR + C.tid; mt[i] = mA[q]; mt[5 * DM + i] = mB[q]; }
            __syncthreads();
            unsigned* cnt = ctl + CW_CNT + l * 1024 + ((rep + 1 < NREP(8)) ? 2048 : 0);
            int* liste = (int*)(ws + WS_ROUTE + RO_LISTE); float* roww = (float*)(ws + WS_ROUTE + RO_ROWW); int* tokpos = (int*)(ws + WS_ROUTE + RO_TOKPOS);
            int rb, re; wave_rows(C.gw, C.NGW, mrow0, T, rb, re);
            const int lb3 = (C.lane >> 3) & 1, lb2 = (C.lane >> 2) & 1, lb1 = (C.lane >> 1) & 1, lb0 = C.lane & 1;
            const float brl = brt[C.lane & 15];
            for (int r0 = rb; r0 < re; r0 += 3) {
                f32x4 v[3][4], f[3][4];
#pragma unroll
                for (int k = 0; k < 3; ++k) { const int r = (r0 + k < re) ? r0 + k : re - 1; xs_load(XS + (size_t)r * DM, C.lane, v[k]); }
#pragma unroll
                for (int k = 0; k < 3; ++k) { const int r = (r0 + k < re) ? r0 + k : re - 1, which = (r < TC) ? 4 : ((r - TC) >> 12);
                    norm_mod_row(C, v[k], gv, mt + which * DM, mt + (5 + which) * DM, (unsigned char*)R1 + (size_t)r * DM, f[k]); }
                float a[3][16];
#pragma unroll
                for (int e = 0; e < 16; ++e) { f32x4 w[4];
#pragma unroll
                    for (int j = 0; j < 4; ++j) w[j] = *(const LAS f32x4*)(wT + e * DM + j * 256 + 4 * C.lane);
#pragma unroll
                    for (int k = 0; k < 3; ++k) { f32x4 a4 = f[k][0] * w[0];
#pragma unroll
                        for (int j = 1; j < 4; ++j) a4 = f[k][j] * w[j] + a4;
                        float t = (a4.x + a4.y) + (a4.z + a4.w);
                        asm volatile("" : "+v"(t)); a[k][e] = t; }
                    if (e & 1) __builtin_amdgcn_sched_barrier(0); }
#pragma unroll
                for (int k = 0; k < 3; ++k) {
                    float b8[8], b4[4], b2[2], b1;
#pragma unroll
                    for (int i = 0; i < 8; ++i) { const float snd = lb3 ? a[k][i] : a[k][i + 8], kp = lb3 ? a[k][i + 8] : a[k][i]; b8[i] = kp + dppf<DPP_RM>(snd); }
#pragma unroll
                    for (int i = 0; i < 4; ++i) { const float snd = lb2 ? b8[i] : b8[i + 4], kp = lb2 ? b8[i + 4] : b8[i]; b4[i] = kp + dppf<DPP_HM>(snd); }
#pragma unroll
                    for (int i = 0; i < 2; ++i) { const float snd = lb1 ? b4[i] : b4[i + 2], kp = lb1 ? b4[i + 2] : b4[i]; b2[i] = kp + dppf<DPP_X2>(snd); }
                    { const float snd = lb0 ? b2[0] : b2[1], kp = lb0 ? b2[1] : b2[0]; b1 = kp + dppf<DPP_X1>(snd); }
                    b1 += shx(b1, C.lane, 16); b1 += shx(b1, C.lane, 32);
                    const float scl = sigmoidf_(b1), sel = scl + brl;
                    const float x1 = dppf<DPP_X1>(sel), x2 = dppf<DPP_X2>(sel), x3 = dppf<0x1B>(sel);
                    const float gsum = fmaxf(fmaxf(fmaxf(sel + x1, sel + x2), fmaxf(sel + x3, x1 + x2)), fmaxf(x1 + x3, x2 + x3));
                    float best = rlane(gsum, 0); int bg = 0;
#pragma unroll
                    for (int g = 1; g < 4; ++g) { const float gs = rlane(gsum, 4 * g); if (gs > best) { best = gs; bg = g; } }
                    float m1 = -1e30f, m2 = -1e30f, w1 = 0.f, w2 = 0.f; int e1 = 0, e2 = 0;
#pragma unroll
                    for (int q = 0; q < 4; ++q) { const int e = 4 * bg + q; const float x = rlane(sel, e), sv = rlane(scl, e);
                        if (x > m1) { m2 = m1; e2 = e1; w2 = w1; m1 = x; e1 = e; w1 = sv; } else if (x > m2) { m2 = x; e2 = e; w2 = sv; } }
                    if (r0 + k < re && C.lane == 0) { const int r = r0 + k, slot = C.wave * 32 + (r - rb); const float inv = 1.0f / (w1 + w2);
                        const int lp1 = __hip_atomic_fetch_add(lcnt + e1, 1, __ATOMIC_RELAXED, __HIP_MEMORY_SCOPE_WORKGROUP), lp2 = __hip_atomic_fetch_add(lcnt + e2, 1, __ATOMIC_RELAXED, __HIP_MEMORY_SCOPE_WORKGROUP);
                        rt_row[slot] = r; rt_e[2 * slot] = e1; rt_e[2 * slot + 1] = e2; rt_lp[2 * slot] = lp1; rt_lp[2 * slot + 1] = lp2; rt_w[2 * slot] = w1 * inv; rt_w[2 * slot + 1] = w2 * inv; }
                }
            }
            __syncthreads();
            if (C.tid < 16) { const int n = lcnt[C.tid]; lcnt[16 + C.tid] = (n > 0) ? (int)__hip_atomic_fetch_add(cnt + 64 * C.tid, (unsigned)n, __ATOMIC_RELAXED, __HIP_MEMORY_SCOPE_AGENT) : 0; }
            __syncthreads();
            if (C.lane < re - rb) { const int slot = C.wave * 32 + C.lane, r = rt_row[slot];
#pragma unroll
                for (int q = 0; q < 2; ++q) { const int e = rt_e[2 * slot + q], p = lcnt[16 + e] + rt_lp[2 * slot + q];
                    liste[(size_t)e * T + p] = r; roww[(size_t)e * T + p] = rt_w[2 * slot + q]; tokpos[2 * r + q] = (e << 20) | p; } }
            __syncthreads();
          }
        }
        SEAM(P + 7);

        if (EN(9) && IN(P + 8)) {
#pragma unroll 1
          for (int rep = 0; rep < NREP(9); ++rep) {
            PH();
            expert_prefix(ctl + CW_CNT + l * 1024, mrow0, pfxl, C.tid);
            constexpr int SW = 0x01010101 * (127 - FP8_WEXP), SA0 = 0x7f7f7f7f;
            pg8::GroupedOrder S{pfxl, C.G, C.vcu, DM / 2, (size_t)1024 * 1024, 0};
            { const int* liste = (const int*)(ws + WS_ROUTE + RO_LISTE); const unsigned* cnt = ctl + CW_CNT + l * 1024; pg8::Unit u;
#pragma unroll 1
              for (int i = 0; i < 8 && S.next(i, u); ++i) if (C.tid < 256) { const int idx = u.lt * 256 + C.tid;
                  gtab[i * 256 + C.tid] = (u.e == 16) ? (mrow0 + idx) : ((idx < (int)cnt[64 * u.e]) ? liste[(size_t)u.e * T + idx] : mrow0); } }
            __syncthreads();
            pg8::EpiGlu E{HH};
            pg8::gemm_phase<pg8::EpiGlu, pg8::GroupedOrder, true, 2>(C.lds, R1, DM / 2, WB + WO_GU, DM / 2, S, E, gtab, SW, SA0, 1.0f / (float)(1 << (I8_AEXP + I8_WEXP)));
            if (l + 1 < NLAYER) { const int nu = 4 * __builtin_amdgcn_readfirstlane(pfxl[17]); if ((nu + C.G - 1 - C.vcu) / C.G < (nu + C.G - 1) / C.G) (void)convert_steal(C, l + 1, CONV_NQUEUE, 2); }
          }
        }
        SEAM(P + 8);

        if (EN(10) && IN(P + 9)) {
#pragma unroll 1
          for (int rep = 0; rep < NREP(10); ++rep) {
            PH();
            if (!IN(P + 8)) expert_prefix(ctl + CW_CNT + l * 1024, mrow0, pfxl, C.tid);
            constexpr int SW = 0x01010101 * (127 - FP8_WEXP), SA = 0x01010101 * (127 - FP8_AEXP);
            pg8::GroupedOrder S{pfxl, C.G, C.vcu, FF / 2, (size_t)1024 * 512, (size_t)256 * FF};
            pg8::EpiDown E{(unsigned char*)PROJ, (const float*)(ws + WS_ROUTE + RO_ROWW)};
            pg8::gemm_phase<pg8::EpiDown, pg8::GroupedOrder, false, 1>(C.lds, HH, FF / 2, WB + WO_DN, FF / 2, S, E, gtab, SW, SA);
            if (l + 1 < NLAYER) { const int nu = 4 * __builtin_amdgcn_readfirstlane(pfxl[17]); if ((nu + C.G - 1 - C.vcu) / C.G < (nu + C.G - 1) / C.G) (void)convert_steal(C, l + 1, CONV_NQUEUE, 2); }
          }
        }
        SEAM(P + 9);
    }

    if (EN(11) && IN(NPHASE - 1)) {
#pragma unroll 1
      for (int rep = 0; rep < NREP(11); ++rep) {
        const int l = NLAYER - 1; PH();
        if (!IN(NPHASE - 3)) expert_prefix(ctl + CW_CNT + (NLAYER - 1) * 1024, TC, pfxl, C.tid);
        LAS float* mt = (LAS float*)C.lds; mod_chunk_to_lds(mt, modl, 5, C.tid); __syncthreads();
        int rb, re; wave_rows(C.gw, C.NGW, TC, T, rb, re);
        constexpr int NB = 4;
        CombIdx cn[NB];
#pragma unroll
        for (int k = 0; k < NB; ++k) { const int r = (rb + k < re) ? rb + k : re - 1; cn[k] = comb_idx(C, r, pfxl, TC); }
        for (int r0 = rb; r0 < re; r0 += NB) {
            f32x4 v[NB][4]; unsigned y[NB][3][4]; CombIdx ci[NB];
#pragma unroll
            for (int k = 0; k < NB; ++k) { const int r = (r0 + k < re) ? r0 + k : re - 1; ci[k] = cn[k]; xs_load(XS + (size_t)r * DM, C.lane, v[k]); }
#pragma unroll
            for (int k = 0; k < NB; ++k) comb_load(C, ci[k], y[k]);
#pragma unroll
            for (int k = 0; k < NB; ++k) { const int r = (r0 + NB + k < re) ? r0 + NB + k : re - 1; cn[k] = comb_idx(C, r, pfxl, TC); }
#pragma unroll
            for (int k = 0; k < NB; ++k) if (r0 + k < re) { const int r = r0 + k, which = (r - TC) >> 12; comb_apply(C, mt + which * DM, y[k], v[k]); float* dst = COUT + (size_t)(r - TC) * DM;
#pragma unroll
                for (int j = 0; j < 4; ++j) *(f32x4*)(dst + j * 256 + 4 * C.lane) = v[k][j]; }
        }
      }
    }
#undef IN
#undef SEAM
}

#ifndef MK_PER_PHASE
#define MK_PER_PHASE 0
#endif
extern "C" void kernel_launch(void* const* d_in, const int* in_sizes, int n_in, void* d_out, int out_size, void* d_ws, size_t ws_size, hipStream_t stream) {
    static int grid = 0;
    if (grid == 0) {
        if (n_in != 28 || out_size != TL * DM || ws_size < WS_END) { fprintf(stderr, "kernel_launch: unexpected shapes (n_in %d, out %d, ws %zu)\n", n_in, out_size, ws_size); grid = -1; return; }
        int dev = 0, cus = 0, per_cu = 0;
        if (hipGetDevice(&dev) != hipSuccess || hipDeviceGetAttribute(&cus, hipDeviceAttributeMultiprocessorCount, dev) != hipSuccess) { grid = -1; return; }
        if (hipFuncSetAttribute((const void*)fwd_kernel, hipFuncAttributeMaxDynamicSharedMemorySize, LDS_BYTES) != hipSuccess) { fprintf(stderr, "kernel_launch: hipFuncSetAttribute failed\n"); grid = -1; return; }
        if (hipOccupancyMaxActiveBlocksPerMultiprocessor(&per_cu, (const void*)fwd_kernel, NTHR, LDS_BYTES) != hipSuccess || per_cu < 1) { fprintf(stderr, "kernel_launch: occupancy query says %d\n", per_cu); }
        (void)hipGetLastError();
        grid = cus;
    }
    if (grid < 0) return;
    (void)hipMemsetAsync((char*)d_ws + WS_CTL, 0, CTL_ZERO_BYTES, stream);
    Args a{};
    for (int i = 0; i < 28; ++i) a.in[i] = (const float*)d_in[i];
    a.out = (float*)d_out; a.ws = (unsigned char*)d_ws;
#if MK_PER_PHASE
    for (int p = 0; p < NPHASE; ++p) { a.ph_lo = p; a.ph_hi = p + 1; a.li = p; hipLaunchKernelGGL(fwd_kernel, dim3(grid), dim3(NTHR), LDS_BYTES, stream, a); }
#else
    a.ph_lo = 0; a.ph_hi = NPHASE; a.li = 0;
    hipLaunchKernelGGL(fwd_kernel, dim3(grid), dim3(NTHR), LDS_BYTES, stream, a);
#endif
}
```

```cpp
#define REPMASK 0x00
#define BARX 1
#include <hip/hip_runtime.h>
#ifdef MK_PER_PHASE
#define MK_PER_PHASE_ MK_PER_PHASE
#else
#define MK_PER_PHASE_ 0
#endif
#include <cstdio>
#include <cstdint>

#define GAS __attribute__((address_space(1)))
#define LAS __attribute__((address_space(3)))
typedef unsigned short bf16;
typedef short bf16x8 __attribute__((ext_vector_type(8)));
typedef short s16x4 __attribute__((ext_vector_type(4)));
typedef float f32x2 __attribute__((ext_vector_type(2)));
typedef float f32x4 __attribute__((ext_vector_type(4)));
typedef float f32x16 __attribute__((ext_vector_type(16)));
typedef unsigned u32x2 __attribute__((ext_vector_type(2)));
typedef unsigned u32x4 __attribute__((ext_vector_type(4)));

constexpr int DM = 1024, NB = 4, SEQ = 4096, CTXL = 256, NLAYER = 2;
constexpr int TC = NB * CTXL;
constexpr int TL = NB * SEQ;
constexpr int T = TC + TL;
constexpr int LK = CTXL + SEQ;
constexpr int INC = 3232, INCP = 3328;
constexpr int C_CQ = 0, C_CKV = 256, C_KR = 384, C_QB = 416, C_KB = 928, C_VB = 1056, C_GA = 1184, C_GB = 2208;
constexpr int PQ8 = 1024, PK8 = 1536, PV8 = 1664;
constexpr int PROW = INCP * 2, GA8 = 2560, GB8 = 3584;
constexpr int NEXP = 16, FF = 512;
constexpr float EPS = 1e-6f;
constexpr float LOG2E = 1.4426950408889634f;
constexpr float SCA = 0.10206207261596575f * LOG2E;
constexpr float SCB = 0.125f * LOG2E;
constexpr int NWAVES = 8, NTHR = 512;

constexpr size_t MiB = 1u << 20;
constexpr size_t WS_CTL = 0, CTL_ZERO_BYTES = (MK_PER_PHASE_ ? 1024 : 64) * 1024;
constexpr size_t WS_MISC = 1 * MiB;
constexpr size_t WS_CTXS = 2 * MiB;
constexpr size_t WS_ROUTE = 6 * MiB;
constexpr size_t WS_W = 9 * MiB;
constexpr size_t WS_R1 = 73 * MiB;
constexpr size_t WS_R2 = 107 * MiB;
constexpr size_t WS_R3 = 218 * MiB;
constexpr size_t WS_R4 = 286 * MiB;
constexpr size_t WS_R5 = 312 * MiB;
constexpr size_t WS_END = 346 * MiB;
constexpr size_t MO_MODV = 0;
constexpr size_t MO_TABA = 256 * 1024;
constexpr size_t MO_TABB = MO_TABA + 4096;
constexpr size_t MO_CB = MO_TABB + 8192;
constexpr size_t RO_LISTE = 0;
constexpr size_t RO_ROWW = (size_t)NEXP * T * 4;
constexpr size_t RO_TOKPOS = 2 * RO_ROWW;
constexpr size_t WO_IN = 0;
constexpr size_t WO_UQ = WO_IN + (size_t)INCP * 1024 / 2;
constexpr size_t WO_UKV = WO_UQ + 768 * 256;
constexpr size_t WO_OA = WO_UKV + 1024 * 256;
constexpr size_t WO_OUT = WO_OA + 1024 * 1024 / 2;
constexpr size_t WO_GU = WO_OUT + 1024 * 1024 / 2;
constexpr size_t WO_DN = WO_GU + (size_t)17 * 1024 * 1024 / 2;
constexpr size_t WO_END = WO_DN + (size_t)17 * 1024 * 512 / 2;
constexpr size_t WL_STRIDE = 16 * MiB;
static_assert(WO_END <= WL_STRIDE && WS_W + 2 * WL_STRIDE * 2 <= WS_R1, "weights region");
constexpr size_t R3_KA = 0, R3_VA = (size_t)T * 1024, R3_QB = R3_VA + (size_t)T * 512 * 2, R3_KB = R3_QB + (size_t)T * 512, R3_VB = R3_KB + (size_t)T * 128, R3_QA = R3_VB + (size_t)T * 128 * 2;
constexpr size_t R3_Y1 = 0, R3_Y = (size_t)T * 1024 * 2, R3_HH = 0;
constexpr int HHROWS = 3 * T + 17 * 256;
static_assert(R3_QA + (size_t)T * 1024 <= 68 * MiB && (size_t)HHROWS * 512 * 2 <= 68 * MiB && (size_t)HHROWS * 1024 * 2 <= 111 * MiB, "regions");
constexpr int CW_STEAL = 512;
constexpr int CW_CNT = 1024;
constexpr int CW_BAR = 4096;

constexpr int RING_BYTES = 131072;
constexpr int LDSX_OFF = RING_BYTES;
constexpr int LDSX_GTAB = LDSX_OFF;
constexpr int LDSX_PFX = LDSX_OFF + 8192;
constexpr int LDSX_MISC = LDSX_OFF + 8192 + 256;
constexpr int LDS_BYTES = 147456;

__device__ __forceinline__ unsigned f2bf(float f) { unsigned u = __builtin_bit_cast(unsigned, f); return (u + 0x7fffu + ((u >> 16) & 1u)) >> 16; }
typedef __bf16 bf16x2_hw __attribute__((ext_vector_type(2)));
__device__ __forceinline__ unsigned pk2(float lo, float hi) { const f32x2 v = {lo, hi}; return __builtin_bit_cast(unsigned, __builtin_convertvector(v, bf16x2_hw)); }
__device__ __forceinline__ unsigned pk4_fp8(float a, float b, float c, float d) { int w = 0; w = __builtin_amdgcn_cvt_pk_fp8_f32(a, b, w, false); w = __builtin_amdgcn_cvt_pk_fp8_f32(c, d, w, true); return (unsigned)w; }
constexpr int I8_AEXP = 4, I8_WEXP = 9;
__device__ __forceinline__ unsigned pk4_i8(float a, float b, float c, float d, float scl) {
    const float M = 12582912.0f;
    const unsigned qa = __builtin_bit_cast(unsigned, __builtin_amdgcn_fmed3f(a * scl, -127.f, 127.f) + M), qb = __builtin_bit_cast(unsigned, __builtin_amdgcn_fmed3f(b * scl, -127.f, 127.f) + M);
    const unsigned qc = __builtin_bit_cast(unsigned, __builtin_amdgcn_fmed3f(c * scl, -127.f, 127.f) + M), qd = __builtin_bit_cast(unsigned, __builtin_amdgcn_fmed3f(d * scl, -127.f, 127.f) + M);
    const unsigned lo = __builtin_amdgcn_perm(qb, qa, 0x0c0c0400u), hi = __builtin_amdgcn_perm(qd, qc, 0x0c0c0400u);
    return __builtin_amdgcn_perm(hi, lo, 0x05040100u);
}
__device__ __forceinline__ unsigned pk4_fp8_sat(float a, float b, float c, float d) {
    return pk4_fp8(__builtin_amdgcn_fmed3f(a, -448.f, 448.f), __builtin_amdgcn_fmed3f(b, -448.f, 448.f), __builtin_amdgcn_fmed3f(c, -448.f, 448.f), __builtin_amdgcn_fmed3f(d, -448.f, 448.f)); }
constexpr int FP8_WEXP = 5;
constexpr int FP8_AEXP = 3;
__device__ __forceinline__ float bflo(unsigned w) { return __builtin_bit_cast(float, w << 16); }
__device__ __forceinline__ float bfhi(unsigned w) { return __builtin_bit_cast(float, w & 0xffff0000u); }
template <int CTRL> __device__ __forceinline__ float dppf(float v) { return __builtin_bit_cast(float, __builtin_amdgcn_update_dpp(0, __builtin_bit_cast(int, v), CTRL, 0xF, 0xF, true)); }
#define DPP_X1 0xB1
#define DPP_X2 0x4E
#define DPP_HM 0x141
#define DPP_RM 0x140
__device__ __forceinline__ float rlane(float v, int l) { return __builtin_bit_cast(float, __builtin_amdgcn_readlane(__builtin_bit_cast(int, v), l)); }
__device__ __forceinline__ float row_sum16(float v) { v += dppf<DPP_X1>(v); v += dppf<DPP_X2>(v); v += dppf<DPP_HM>(v); v += dppf<DPP_RM>(v); return v; }
__device__ __forceinline__ float wave_sum(float v, int) { v = row_sum16(v); return (rlane(v, 0) + rlane(v, 16)) + (rlane(v, 32) + rlane(v, 48)); }
__device__ __forceinline__ float sum8(float v, int) { v += dppf<DPP_X1>(v); v += dppf<DPP_X2>(v); v += dppf<DPP_HM>(v); return v; }
__device__ __forceinline__ float shx(float v, int lane, int o) { return __builtin_bit_cast(float, __builtin_amdgcn_ds_bpermute((lane ^ o) << 2, __builtin_bit_cast(int, v))); }
__device__ __forceinline__ float sigmoidf_(float x) { return __builtin_amdgcn_rcpf(1.0f + __builtin_amdgcn_exp2f(-x * LOG2E)); }
__device__ __forceinline__ f32x4 sigmoid4(f32x4 x) {
    const f32x4 t = x * (-LOG2E); f32x4 e; e.x = __builtin_amdgcn_exp2f(t.x); e.y = __builtin_amdgcn_exp2f(t.y); e.z = __builtin_amdgcn_exp2f(t.z); e.w = __builtin_amdgcn_exp2f(t.w);
    const f32x4 d = e + 1.0f; f32x4 r; r.x = __builtin_amdgcn_rcpf(d.x); r.y = __builtin_amdgcn_rcpf(d.y); r.z = __builtin_amdgcn_rcpf(d.z); r.w = __builtin_amdgcn_rcpf(d.w); return r;
}
#define LDS_WAIT() asm volatile("s_waitcnt lgkmcnt(0)" ::: "memory")
#define VM_WAIT() asm volatile("s_waitcnt vmcnt(0)" ::: "memory")

namespace pg8 {
constexpr int BM = 256, BK = 64, HALF = 128, HTB = HALF * BK * 2, STAGE_BYTES = 8 * HTB, NXCD = 8, WGM = 8;
__device__ __forceinline__ int lds_byte(int r, int c) { const int st = (r >> 4) * 2 + (c >> 5), rr = r & 15, cc = c & 31, ob = rr * 64 + cc * 2; return st * 1024 + (ob ^ (((ob >> 9) & 1) << 5)); }
__device__ __forceinline__ void stage_rc(int b, int& R, int& C) { const int st = b / 1024, sb = b % 1024, swz = sb ^ (((sb >> 9) & 1) << 5); R = (st >> 1) * 16 + swz / 64; C = (st & 1) * 32 + (swz % 64) / 2; }
__device__ __forceinline__ int perm32(int rho) { const int n = rho >> 4, i = rho & 15; return 8 * (i >> 2) + 4 * n + (i & 3); }

struct Unit { int pm, pn, e, lt; };

struct StaticOrder {
    int nM, nN, nwg, G, c, lda, K;
    __device__ __forceinline__ void init(int M, int N, int G_, int c_, int lda_, int K_) { nM = M / BM; nN = N / BM; nwg = nM * nN; G = G_; c = c_; lda = lda_; K = K_; }
    __device__ __forceinline__ bool next(int i, Unit& u) const {
        const long L = (long)i * G + c; if (L >= nwg) return false;
        int wgid = (int)L; { const int q = nwg / NXCD, r = nwg % NXCD, xcd = wgid % NXCD, off = wgid / NXCD; wgid = (xcd < r ? xcd * (q + 1) : r * (q + 1) + (xcd - r) * q) + off; }
        const int nig = WGM * nN, gid = wgid / nig, fm = gid * WGM, gsz = (nM - fm) < WGM ? (nM - fm) : WGM;
        u.pm = fm + ((wgid % nig) % gsz); u.pn = (wgid % nig) / gsz; u.e = 0; u.lt = 0; return true;
    }
    __device__ __forceinline__ size_t a_off(const Unit& u) const { return (size_t)u.pm * BM * lda * 2; }
    __device__ __forceinline__ size_t b_off(const Unit& u) const { return (size_t)u.pn * BM * K * 2; }
};
struct GroupedOrder {
    const LAS int* pfx; int G, vcu, K; size_t estride;
    size_t a_stride;
    __device__ __forceinline__ bool next(int i, Unit& u) const {
        const int U = i * G + vcu, ntl = __builtin_amdgcn_readfirstlane(pfx[17]);
        if (U >= ntl * 4) return false;
        const int rt = U >> 2; int e = 0;
#pragma unroll
        for (int k = 1; k < 17; ++k) e += (rt >= __builtin_amdgcn_readfirstlane(pfx[k])) ? 1 : 0;
        u.pm = rt; u.pn = U & 3; u.e = e; u.lt = rt - __builtin_amdgcn_readfirstlane(pfx[e]); return true;
    }
    __device__ __forceinline__ size_t a_off(const Unit& u) const { return (size_t)u.pm * a_stride; }
    __device__ __forceinline__ size_t b_off(const Unit& u) const { return (size_t)u.e * estride + (size_t)u.pn * BM * K * 2; }
};

__device__ __forceinline__ unsigned cvt_pk_bf16(float lo, float hi) { unsigned r; asm volatile("v_cvt_pk_bf16_f32 %0, %1, %2" : "=v"(r) : "v"(lo), "v"(hi)); return r; }

#define OPAQ(x) asm volatile("" : "+v"(x))
struct EpiBf16 {
    static constexpr bool PERM = true, WIDE = false; static constexpr int NPRE = 0;
    bf16* O; int ldc;
    __device__ __forceinline__ void operator()(const f32x4 (&acc)[2][2][4][2], const Unit& u, int wr, int wc, int fr, int fq) const {
        char* base = (char*)(O + (size_t)u.pm * BM * ldc + u.pn * BM);
        unsigned off = (unsigned)((wr * 64 + fr) * ldc + wc * 32 + 8 * fq) * 2u; OPAQ(off);
#pragma unroll
        for (int ai = 0; ai < 2; ++ai)
#pragma unroll
          for (int m = 0; m < 4; ++m) {
#pragma unroll
            for (int bj = 0; bj < 2; ++bj) { const f32x4 v0 = acc[ai][bj][m][0], v1 = acc[ai][bj][m][1];
                u32x4 w; w.x = cvt_pk_bf16(v0[0], v0[1]); w.y = cvt_pk_bf16(v0[2], v0[3]); w.z = cvt_pk_bf16(v1[0], v1[1]); w.w = cvt_pk_bf16(v1[2], v1[3]);
                *(u32x4*)(base + off + bj * HALF * 2) = w; }
            off += (unsigned)((m == 3 ? 80 : 16) * ldc) * 2u; OPAQ(off); }
    }
};
struct EpiF8 {
    static constexpr bool PERM = true, WIDE = true; static constexpr int NPRE = 0;
    unsigned char* O; int ldc;
    __device__ __forceinline__ void operator()(const f32x4 (&acc)[2][2][4][2], const Unit& u, int wr, int wc, int fr, int fq) const {
        char* base = (char*)O + (size_t)u.pm * BM * ldc + u.pn * BM;
        unsigned off = (unsigned)((wr * 64 + fr) * ldc + wc * 64 + 16 * fq); OPAQ(off);
        constexpr float sa = (float)(1 << FP8_AEXP);
#pragma unroll
        for (int ai = 0; ai < 2; ++ai)
#pragma unroll
          for (int m = 0; m < 4; ++m) {
            const f32x4 v0 = acc[ai][0][m][0] * sa, v1 = acc[ai][0][m][1] * sa, v2 = acc[ai][1][m][0] * sa, v3 = acc[ai][1][m][1] * sa;
            u32x4 w; w.x = pk4_fp8_sat(v0[0], v0[1], v0[2], v0[3]); w.y = pk4_fp8_sat(v1[0], v1[1], v1[2], v1[3]); w.z = pk4_fp8_sat(v2[0], v2[1], v2[2], v2[3]); w.w = pk4_fp8_sat(v3[0], v3[1], v3[2], v3[3]);
            *(u32x4*)(base + off) = w;
            off += (unsigned)((m == 3 ? 80 : 16) * ldc); OPAQ(off); }
    }
};
struct EpiProj {
    static constexpr bool PERM = true, WIDE = false; static constexpr int NPRE = 0;
    bf16* O;
    __device__ __forceinline__ void operator()(const f32x4 (&acc)[2][2][4][2], const Unit& u, int wr, int wc, int fr, int fq) const {
        if (u.pn >= 2 && u.pn < 5) {
            char* base = (char*)O + (size_t)u.pm * BM * PROW + PQ8 + (u.pn - 2) * BM;
            unsigned off = (unsigned)((wr * 64 + fr) * PROW + wc * 32 + 8 * fq); OPAQ(off);
            constexpr float sa = (float)(1 << FP8_AEXP);
#pragma unroll
            for (int ai = 0; ai < 2; ++ai)
#pragma unroll
              for (int m = 0; m < 4; ++m) {
#pragma unroll
                for (int bj = 0; bj < 2; ++bj) { const f32x4 v0 = acc[ai][bj][m][0] * sa, v1 = acc[ai][bj][m][1] * sa;
                    u32x2 w; w.x = pk4_fp8_sat(v0[0], v0[1], v0[2], v0[3]); w.y = pk4_fp8_sat(v1[0], v1[1], v1[2], v1[3]);
                    *(u32x2*)(base + off + bj * HALF) = w; }
                off += (unsigned)((m == 3 ? 80 : 16) * PROW); OPAQ(off); }
        } else if (u.pn < 2) {
            char* base = (char*)(O + (size_t)u.pm * BM * INCP + u.pn * BM);
            unsigned off = (unsigned)((wr * 64 + fr) * INCP + wc * 32 + 8 * fq) * 2u; OPAQ(off);
#pragma unroll
            for (int ai = 0; ai < 2; ++ai)
#pragma unroll
              for (int m = 0; m < 4; ++m) {
#pragma unroll
                for (int bj = 0; bj < 2; ++bj) { const f32x4 v0 = acc[ai][bj][m][0], v1 = acc[ai][bj][m][1];
                    u32x4 w; w.x = cvt_pk_bf16(v0[0], v0[1]); w.y = cvt_pk_bf16(v0[2], v0[3]); w.z = cvt_pk_bf16(v1[0], v1[1]); w.w = cvt_pk_bf16(v1[2], v1[3]);
                    *(u32x4*)(base + off + bj * HALF * 2) = w; }
                off += (unsigned)((m == 3 ? 80 : 16) * INCP) * 2u; OPAQ(off); }
        } else {
            char* base = (char*)O + (size_t)u.pm * BM * PROW + GA8 + (u.pn - 5) * BM;
            unsigned off = (unsigned)((wr * 64 + fr) * PROW + wc * 32 + 8 * fq); OPAQ(off);
#pragma unroll
            for (int ai = 0; ai < 2; ++ai)
#pragma unroll
              for (int m = 0; m < 4; ++m) {
#pragma unroll
                for (int bj = 0; bj < 2; ++bj) { u32x2 w;
#pragma unroll
                    for (int n = 0; n < 2; ++n) { const f32x4 y = sigmoid4(acc[ai][bj][m][n]) * 255.0f + 0.5f;
                        const unsigned pk = (unsigned)y.x | ((unsigned)y.y << 8) | ((unsigned)y.z << 16) | ((unsigned)y.w << 24); if (n == 0) w.x = pk; else w.y = pk; }
                    *(u32x2*)(base + off + bj * HALF) = w; }
                off += (unsigned)((m == 3 ? 80 : 16) * PROW); OPAQ(off); }
        }
    }
};
template <bool SECOND> struct EpiGate {
    static constexpr bool PERM = true, WIDE = false; static constexpr int NPRE = 0;
    bf16* O; const bf16* Gt; const bf16* Y1;
    __device__ __forceinline__ void operator()(const f32x4 (&acc)[2][2][4][2], const Unit& u, int wr, int wc, int fr, int fq) const {
        char* obase = SECOND ? (char*)O + (size_t)u.pm * BM * DM + u.pn * BM : (char*)(O + (size_t)u.pm * BM * DM + u.pn * BM); const char* ybase = (const char*)(Y1 + (size_t)u.pm * BM * DM + u.pn * BM);
        const char* gbase = (const char*)(Gt + (size_t)u.pm * BM * INCP + u.pn * BM);
        unsigned off = (unsigned)((wr * 64 + fr) * DM + wc * 32 + 8 * fq) * 2u, goff = (unsigned)((wr * 64 + fr) * INCP + wc * 32 + 8 * fq) * 2u; OPAQ(off); OPAQ(goff);
#pragma unroll
        for (int ai = 0; ai < 2; ++ai)
#pragma unroll
          for (int m = 0; m < 4; ++m) {
#pragma unroll
            for (int bj = 0; bj < 2; ++bj) { const f32x4 v0 = acc[ai][bj][m][0], v1 = acc[ai][bj][m][1];
                const u32x4 g = *(const u32x4*)(gbase + goff + bj * HALF * 2);
                float r[8];
                r[0] = v0[0] * sigmoidf_(bflo(g.x)); r[1] = v0[1] * sigmoidf_(bfhi(g.x)); r[2] = v0[2] * sigmoidf_(bflo(g.y)); r[3] = v0[3] * sigmoidf_(bfhi(g.y));
                r[4] = v1[0] * sigmoidf_(bflo(g.z)); r[5] = v1[1] * sigmoidf_(bfhi(g.z)); r[6] = v1[2] * sigmoidf_(bflo(g.w)); r[7] = v1[3] * sigmoidf_(bfhi(g.w));
                if (SECOND) { const u32x4 y = *(const u32x4*)(ybase + off + bj * HALF * 2);
                    r[0] += bflo(y.x); r[1] += bfhi(y.x); r[2] += bflo(y.y); r[3] += bfhi(y.y); r[4] += bflo(y.z); r[5] += bfhi(y.z); r[6] += bflo(y.w); r[7] += bfhi(y.w); }
                if (SECOND) { constexpr float sa = (float)(1 << FP8_AEXP); u32x2 w; w.x = pk4_fp8(r[0] * sa, r[1] * sa, r[2] * sa, r[3] * sa); w.y = pk4_fp8(r[4] * sa, r[5] * sa, r[6] * sa, r[7] * sa);
                    *(u32x2*)(obase + (off >> 1) + bj * HALF) = w; }
                else { u32x4 w; w.x = cvt_pk_bf16(r[0], r[1]); w.y = cvt_pk_bf16(r[2], r[3]); w.z = cvt_pk_bf16(r[4], r[5]); w.w = cvt_pk_bf16(r[6], r[7]);
                    *(u32x4*)(obase + off + bj * HALF * 2) = w; } }
            off += (unsigned)((m == 3 ? 80 : 16) * DM) * 2u; goff += (unsigned)((m == 3 ? 80 : 16) * INCP) * 2u; OPAQ(off); OPAQ(goff); }
    }
};
struct EpiGateF {
    static constexpr bool PERM = true, WIDE = true; static constexpr int NPRE = 0;
    unsigned char* O; const unsigned char* G;
    __device__ __forceinline__ static float ub(unsigned w, int i) { return (float)((w >> (8 * i)) & 0xffu); }
    __device__ __forceinline__ void mid(f32x4 (&acc)[2][2][4][2], const Unit& u, int wr, int wc, int fr, int fq) const {
        const char* gbase = (const char*)G + (size_t)u.pm * BM * PROW + u.pn * BM;
        unsigned gl = (unsigned)((wr * 64 + fr) * PROW + wc * 64 + 16 * fq); OPAQ(gl);
        u32x4 ra[8], rb[8];
#pragma unroll
        for (int g = 0; g < 8; ++g) { ra[g] = *(const u32x4*)(gbase + GA8 + gl); rb[g] = *(const u32x4*)(gbase + GB8 + gl);
            gl += (unsigned)(((g & 3) == 3 ? 80 : 16) * PROW); OPAQ(gl); }
#pragma unroll
        for (int g = 0; g < 8; ++g) { const int ai = g >> 2, m = g & 3;
            const u32x4 a = ra[g], b = rb[g];
#pragma unroll
            for (int bj = 0; bj < 2; ++bj)
#pragma unroll
                for (int n = 0; n < 2; ++n) { const unsigned wa = a[2 * bj + n], wb = b[2 * bj + n];
#pragma unroll
                    for (int k = 0; k < 4; ++k) acc[ai][bj][m][n][k] *= ub(wa, k) * __builtin_amdgcn_rcpf(fmaxf(ub(wb, k), 1.0f)); } }
    }
    __device__ __forceinline__ void operator()(const f32x4 (&acc)[2][2][4][2], const Unit& u, int wr, int wc, int fr, int fq) const {
        char* obase = (char*)O + (size_t)u.pm * BM * DM + u.pn * BM; const char* gbase = (const char*)G + (size_t)u.pm * BM * PROW + GB8 + u.pn * BM;
        unsigned off = (unsigned)((wr * 64 + fr) * DM + wc * 64 + 16 * fq), gl = (unsigned)((wr * 64 + fr) * PROW + wc * 64 + 16 * fq); OPAQ(off); OPAQ(gl);
        constexpr float sa = (float)(1 << FP8_AEXP) / 255.0f;
        u32x4 rb[8];
#pragma unroll
        for (int g = 0; g < 8; ++g) { rb[g] = *(const u32x4*)(gbase + gl); gl += (unsigned)(((g & 3) == 3 ? 80 : 16) * PROW); OPAQ(gl); }
#pragma unroll
        for (int g = 0; g < 8; ++g) { const int ai = g >> 2, m = g & 3;
            const u32x4 b = rb[g]; u32x4 w4;
#pragma unroll
            for (int bj = 0; bj < 2; ++bj)
#pragma unroll
                for (int n = 0; n < 2; ++n) { const unsigned wb = b[2 * bj + n]; const f32x4 v = acc[ai][bj][m][n];
                    w4[2 * bj + n] = pk4_fp8_sat(v[0] * sa * fmaxf(ub(wb, 0), 1.0f), v[1] * sa * fmaxf(ub(wb, 1), 1.0f), v[2] * sa * fmaxf(ub(wb, 2), 1.0f), v[3] * sa * fmaxf(ub(wb, 3), 1.0f)); }
            *(u32x4*)(obase + off) = w4;
            off += (unsigned)((m == 3 ? 80 : 16) * DM); OPAQ(off); }
    }
};
struct EpiRes {
    static constexpr bool PERM = true, WIDE = false; static constexpr int NPRE = 0;
    bf16* xs; const float* gtv;
    int rowbase, gch;
    __device__ __forceinline__ void operator()(const f32x4 (&acc)[2][2][4][2], const Unit& u, int wr, int wc, int fr, int fq) const {
        const int lrow = rowbase + u.pm * BM;
        const int which = (lrow < TC) ? 4 : ((lrow - TC) >> 12);
        const char* gt = (const char*)(gtv + ((size_t)which * 6 + gch) * DM + u.pn * BM);
        char* ob = (char*)(xs + (size_t)lrow * DM + u.pn * BM);
        unsigned off = (unsigned)((wr * 64 + fr) * DM + wc * 32 + 8 * fq) * 2u; const unsigned goff = (unsigned)(wc * 32 + 8 * fq) * 4u; OPAQ(off);
        f32x4 gv[2][2];
#pragma unroll
        for (int bj = 0; bj < 2; ++bj)
#pragma unroll
            for (int n = 0; n < 2; ++n) gv[bj][n] = *(const f32x4*)(gt + goff + (bj * HALF + n * 4) * 4);
        u32x4 rr[8][2]; unsigned ol = off;
#pragma unroll
        for (int g = 0; g < 8; ++g) {
#pragma unroll
            for (int bj = 0; bj < 2; ++bj) rr[g][bj] = *(const u32x4*)(ob + ol + bj * HALF * 2);
            ol += (unsigned)(((g & 3) == 3 ? 80 : 16) * DM) * 2u; OPAQ(ol); }
#pragma unroll
        for (int g = 0; g < 8; ++g) { const int ai = g >> 2, m = g & 3;
#pragma unroll
            for (int bj = 0; bj < 2; ++bj) { const u32x4 w_ = rr[g][bj];
                const f32x4 c0 = (f32x4){bflo(w_.x), bfhi(w_.x), bflo(w_.y), bfhi(w_.y)}, c1 = (f32x4){bflo(w_.z), bfhi(w_.z), bflo(w_.w), bfhi(w_.w)};
                const f32x4 o0 = c0 + gv[bj][0] * acc[ai][bj][m][0], o1 = c1 + gv[bj][1] * acc[ai][bj][m][1];
                u32x4 w; w.x = cvt_pk_bf16(o0[0], o0[1]); w.y = cvt_pk_bf16(o0[2], o0[3]); w.z = cvt_pk_bf16(o1[0], o1[1]); w.w = cvt_pk_bf16(o1[2], o1[3]); *(u32x4*)(ob + off + bj * HALF * 2) = w; }
            off += (unsigned)((m == 3 ? 80 : 16) * DM) * 2u; OPAQ(off); }
    }
};
struct EpiGlu {
    static constexpr bool PERM = true, WIDE = false; static constexpr int NPRE = 0;
    bf16* HH;
    __device__ __forceinline__ void operator()(const f32x4 (&acc)[2][2][4][2], const Unit& u, int wr, int wc, int fr, int fq) const {
        char* base = (char*)HH + (size_t)u.pm * BM * FF + u.pn * HALF;
        unsigned off = (unsigned)((wr * 64 + fr) * FF + wc * 32 + 8 * fq); OPAQ(off);
#pragma unroll
        for (int ai = 0; ai < 2; ++ai)
#pragma unroll
          for (int m = 0; m < 4; ++m) {
            constexpr float sa = (float)(1 << FP8_AEXP);
            const f32x4 g0 = acc[ai][0][m][0], g1 = acc[ai][0][m][1];
            const f32x4 r0 = (g0 * sigmoid4(g0)) * (acc[ai][1][m][0] * sa), r1 = (g1 * sigmoid4(g1)) * (acc[ai][1][m][1] * sa);
            u32x2 w; w.x = pk4_fp8_sat(r0.x, r0.y, r0.z, r0.w); w.y = pk4_fp8_sat(r1.x, r1.y, r1.z, r1.w);
            *(u32x2*)(base + off) = w;
            off += (unsigned)((m == 3 ? 80 : 16) * FF); OPAQ(off); }
    }
};
struct EpiDown {
    static constexpr bool PERM = true, WIDE = true; static constexpr int NPRE = 1;
    unsigned char* YE; const float* roww;
    __device__ __forceinline__ void pre(const Unit& u, int wr, int wid, int lane, LAS unsigned char* lds) const {
        if (u.e == 16) return;
        const float* rw = roww + (size_t)(u.e & 15) * T + u.lt * BM + wr * 64 + lane;
        LAS unsigned* dst = (LAS unsigned*)(lds + LDSX_OFF + 12288) + wid * 128;
        __builtin_amdgcn_global_load_lds((const unsigned*)rw, dst, 4, 0, 0);
        __builtin_amdgcn_global_load_lds((const unsigned*)(rw + HALF), dst + 64, 4, 0, 0);
    }
    __device__ __forceinline__ void operator()(const f32x4 (&acc)[2][2][4][2], const Unit& u, int wr, int wc, int fr, int fq, int wid, LAS unsigned char* lds) const {
        char* base = (char*)YE + (size_t)u.pm * BM * DM + u.pn * BM;
        unsigned off = (unsigned)((wr * 64 + fr) * DM + wc * 64 + 16 * fq); OPAQ(off);
        const LAS float* wl = (const LAS float*)(lds + LDSX_OFF + 12288) + wid * 128 + fr;
        float wts[8];
        asm volatile("" ::: "memory");
#pragma unroll
        for (int g = 0; g < 8; ++g) wts[g] = (u.e == 16) ? 1.0f : *(const volatile LAS float*)(wl + (g >> 2) * 64 + (g & 3) * 16);
#pragma unroll
        for (int ai = 0; ai < 2; ++ai)
#pragma unroll
          for (int m = 0; m < 4; ++m) {
            const float wt = wts[ai * 4 + m] * (float)(1 << FP8_AEXP);
            { const f32x4 v0 = acc[ai][0][m][0] * wt, v1 = acc[ai][0][m][1] * wt, v2 = acc[ai][1][m][0] * wt, v3 = acc[ai][1][m][1] * wt;
                u32x4 w; w.x = pk4_fp8_sat(v0[0], v0[1], v0[2], v0[3]); w.y = pk4_fp8_sat(v1[0], v1[1], v1[2], v1[3]); w.z = pk4_fp8_sat(v2[0], v2[1], v2[2], v2[3]); w.w = pk4_fp8_sat(v3[0], v3[1], v3[2], v3[3]);
                *(u32x4*)(base + off) = w; }
            off += (unsigned)((m == 3 ? 80 : 16) * DM); OPAQ(off); }
    }
};

typedef int i32x4v __attribute__((ext_vector_type(4)));
typedef int i32x8v __attribute__((ext_vector_type(8)));
template <class Epi, class Sched, bool GATHER, int MODE = 0, bool MIDK = false>
__device__ __forceinline__ void gemm_phase(LAS unsigned char* lds, const bf16* A, int lda, const bf16* Bt, int K, const Sched& S, const Epi& E, const LAS int* gtab, int sclW = 0x7f7f7f7f, int sclA = 0x7f7f7f7f, float deq = 1.0f) {
    constexpr bool FP8 = (MODE == 1), I8 = (MODE == 2);
    int tid_ = threadIdx.x; asm volatile("" : "+v"(tid_));
    const int tid = tid_, wid = __builtin_amdgcn_readfirstlane(tid >> 6), lane = tid & 63, wr = wid >> 2, wc = wid & 3, fr = lane & 15, fq = lane >> 4;
    const int nt = K / BK;
    int RA[2], CA[2];
    unsigned voffA[2][2], voffB[2];
#pragma unroll
    for (int i = 0; i < 2; ++i) { int R, C; stage_rc(tid * 16 + i * 8192, R, C); const int Rb = Epi::WIDE ? (64 * (R >> 5) + 16 * ((R & 15) >> 2) + 4 * ((R >> 4) & 1) + (R & 3)) : (Epi::PERM ? ((R & ~31) + perm32(R & 31)) : R);
        RA[i] = R; CA[i] = C; voffB[i] = (unsigned)(Rb * K + C) * 2u;
        voffA[0][i] = (unsigned)(R * lda + C) * 2u; voffA[1][i] = 0u; }
    const size_t kstep = (size_t)(BK * 2);
    const size_t hstepB = Epi::WIDE ? (size_t)8 * K * 2 : (size_t)HALF * K * 2;
    const size_t hstepA = GATHER ? (size_t)0 : (size_t)HALF * lda * 2;
    const unsigned ldsw = (unsigned)wid * 1024u;
    const int aoff = lds_byte(wr * 64 + fr, fq * 8), boff = lds_byte(wc * 32 + fr, fq * 8);
#define PG8_SA(b, h) (((b) * 2 + (h)) * HTB)
#define PG8_SB(b, h) ((4 + (b) * 2 + (h)) * HTB)
#define PG8_STA(b, h, gbase) do { _Pragma("unroll") for (int _i = 0; _i < 2; ++_i) \
        __builtin_amdgcn_global_load_lds((const unsigned*)((const char*)(gbase) + (h) * hstepA + voffA[GATHER ? (h) : 0][_i]), (LAS unsigned*)(lds + PG8_SA(b, h) + ldsw + _i * 8192), 16, 0, 0); } while (0)
#define PG8_STB(b, h, gbase) do { _Pragma("unroll") for (int _i = 0; _i < 2; ++_i) \
        __builtin_amdgcn_global_load_lds((const unsigned*)((const char*)(gbase) + (h) * hstepB + voffB[_i]), (LAS unsigned*)(lds + PG8_SB(b, h) + ldsw + _i * 8192), 16, 0, 0); } while (0)
#define PG8_LDA(dst, b, h) do { _Pragma("unroll") for (int m = 0; m < 4; ++m) _Pragma("unroll") for (int k = 0; k < 2; ++k) dst[m][k] = *(const LAS bf16x8*)(lds + PG8_SA(b, h) + aoff + m * 2048 + k * 1024); } while (0)
#define PG8_LDB(dst, b, h) do { _Pragma("unroll") for (int n = 0; n < 2; ++n) _Pragma("unroll") for (int k = 0; k < 2; ++k) dst[n][k] = *(const LAS bf16x8*)(lds + PG8_SB(b, h) + boff + n * 2048 + k * 1024); } while (0)
#define PG8_CAT(x) __builtin_shufflevector(__builtin_bit_cast(i32x4v, x[0]), __builtin_bit_cast(i32x4v, x[1]), 0, 1, 2, 3, 4, 5, 6, 7)
#define PG8_MMA(ai, bj, At, Bt_) do { __builtin_amdgcn_s_setprio(1); _Pragma("unroll") for (int m = 0; m < 4; ++m) _Pragma("unroll") for (int n = 0; n < 2; ++n) { \
        if constexpr (FP8) { const i32x8v a8_ = PG8_CAT(Bt_[n]), b8_ = PG8_CAT(At[m]);   \
            asm volatile("v_mfma_scale_f32_16x16x128_f8f6f4 %0, %1, %2, %0, %3, %4 op_sel_hi:[0,0,0]" : "+v"(acc[ai][bj][m][n]) : "v"(a8_), "v"(b8_), "v"(sclW), "v"(sclA)); } \
        else if constexpr (I8) { _Pragma("unroll") for (int k = 0; k < 2; ++k) acc[ai][bj][m][n] = __builtin_bit_cast(f32x4, __builtin_amdgcn_mfma_i32_16x16x64_i8(__builtin_bit_cast(i32x4v, Bt_[n][k]), __builtin_bit_cast(i32x4v, At[m][k]), __builtin_bit_cast(i32x4v, acc[ai][bj][m][n]), 0, 0, 0)); } \
        else { _Pragma("unroll") for (int k = 0; k < 2; ++k) acc[ai][bj][m][n] = __builtin_amdgcn_mfma_f32_16x16x32_bf16(Bt_[n][k], At[m][k], acc[ai][bj][m][n], 0, 0, 0); } } \
        __builtin_amdgcn_s_setprio(0); } while (0)
#define PG8_WAIT_V(n) asm volatile("s_waitcnt vmcnt(" #n ")" ::: "memory")
#define PG8_WAIT_L(n) asm volatile("s_waitcnt lgkmcnt(" #n ")" ::: "memory")
#define PG8_BAR __builtin_amdgcn_s_barrier()
#define PG8_SCHED __builtin_amdgcn_sched_barrier(0)
#define PG8_GLOAD(ui_) do { _Pragma("unroll") for (int _h = 0; _h < 2; ++_h) _Pragma("unroll") for (int _i = 0; _i < 2; ++_i) \
        voffA[_h][_i] = (unsigned)(gtab[(ui_) * 256 + _h * HALF + RA[_i]] * lda + CA[_i]) * 2u; } while (0)
    Unit cur, nxt; int ui = 0;
    if (!S.next(0, cur)) return;
    f32x4 acc[2][2][4][2];
#pragma unroll
    for (int a = 0; a < 2; ++a)
#pragma unroll
        for (int b = 0; b < 2; ++b)
#pragma unroll
            for (int m = 0; m < 4; ++m)
#pragma unroll
                for (int n = 0; n < 2; ++n) acc[a][b][m][n] = (f32x4){0.f, 0.f, 0.f, 0.f};
    bf16x8 At[4][2], B0[2][2], B1[2][2];
    if constexpr (GATHER) { PG8_GLOAD(0); }
    const char* cA = (const char*)A + S.a_off(cur); const char* cB = (const char*)Bt + S.b_off(cur);
    PG8_STB(0, 0, cB); PG8_STB(0, 1, cB); PG8_STA(0, 0, cA); PG8_STA(0, 1, cA);
    if (wr == 1) PG8_BAR;
    PG8_WAIT_V(2); PG8_BAR;
    PG8_STB(1, 0, cB + kstep); PG8_STA(1, 0, cA + kstep); PG8_STB(1, 1, cB + kstep);
    PG8_WAIT_V(6); PG8_BAR;
    for (;;) {
        const bool has_next = S.next(ui + 1, nxt);
        const char* nA = has_next ? (const char*)A + S.a_off(nxt) : cA; const char* nB = has_next ? (const char*)Bt + S.b_off(nxt) : cB;
#pragma unroll 1
        for (int t = 0; t < nt; t += 2) {
            const bool last = (t == nt - 2);
            if constexpr (MIDK) { if (t == nt / 2) { if constexpr (FP8) asm volatile("s_nop 15\n\ts_nop 15\n\ts_nop 15\n\ts_nop 15" ::: "memory"); E.mid(acc, cur, wr, wc, fr, fq); } }
            if constexpr (Epi::NPRE > 0) { if (last) E.pre(cur, wr, wid, lane, lds); }
            const char* a1 = cA + (size_t)(t + 1) * kstep;
            const char* a2 = last ? nA : cA + (size_t)(t + 2) * kstep; const char* b2 = last ? nB : cB + (size_t)(t + 2) * kstep;
            const char* a3 = a2 + kstep; const char* b3 = b2 + kstep;
            PG8_LDB(B0, 0, 0); PG8_LDB(B1, 0, 1); PG8_SCHED; PG8_LDA(At, 0, 0); PG8_STA(1, 1, a1);
            if constexpr (GATHER) { if (last && has_next) { PG8_GLOAD(ui + 1); } }
            PG8_WAIT_V(8); PG8_WAIT_L(0); PG8_BAR; PG8_MMA(0, 0, At, B0); PG8_MMA(0, 1, At, B1); PG8_BAR; PG8_SCHED;
            PG8_LDA(At, 0, 1); PG8_STB(0, 0, b2); PG8_STB(0, 1, b2); PG8_STA(0, 0, a2);
            PG8_WAIT_V(8); PG8_WAIT_L(0); PG8_BAR; PG8_MMA(1, 0, At, B0); PG8_MMA(1, 1, At, B1); PG8_BAR; PG8_SCHED;
            PG8_LDB(B0, 1, 0); PG8_LDB(B1, 1, 1); PG8_SCHED; PG8_LDA(At, 1, 0); PG8_STA(0, 1, a2);
            PG8_WAIT_V(8); PG8_WAIT_L(0); PG8_BAR; PG8_MMA(0, 0, At, B0); PG8_MMA(0, 1, At, B1); PG8_BAR; PG8_SCHED;
            PG8_LDA(At, 1, 1); PG8_STB(1, 0, b3); PG8_STB(1, 1, b3); PG8_STA(1, 0, a3);
            PG8_WAIT_V(8); PG8_WAIT_L(0); PG8_BAR; PG8_MMA(1, 0, At, B0); PG8_MMA(1, 1, At, B1); PG8_BAR; PG8_SCHED;
        }
        if (wr == 0) PG8_BAR;
        if constexpr (FP8) asm volatile("s_nop 15\n\ts_nop 15\n\ts_nop 15\n\ts_nop 15" ::: "memory");
        if constexpr (I8) {
#pragma unroll
            for (int a = 0; a < 2; ++a)
#pragma unroll
                for (int b = 0; b < 2; ++b)
#pragma unroll
                    for (int m = 0; m < 4; ++m)
#pragma unroll
                        for (int n = 0; n < 2; ++n) { const i32x4v q = __builtin_bit_cast(i32x4v, acc[a][b][m][n]); acc[a][b][m][n] = (f32x4){(float)q[0] * deq, (float)q[1] * deq, (float)q[2] * deq, (float)q[3] * deq}; } }
        if constexpr (Epi::NPRE > 0) E(acc, cur, wr, wc, fr, fq, wid, lds); else E(acc, cur, wr, wc, fr, fq);
        if (!has_next) break;
#pragma unroll
        for (int a = 0; a < 2; ++a)
#pragma unroll
            for (int b = 0; b < 2; ++b)
#pragma unroll
                for (int m = 0; m < 4; ++m)
#pragma unroll
                    for (int n = 0; n < 2; ++n) acc[a][b][m][n] = (f32x4){0.f, 0.f, 0.f, 0.f};
        cur = nxt; cA = nA; cB = nB; ++ui;
        if (wr == 1) PG8_BAR;
    }
    PG8_WAIT_V(0);
    PG8_BAR;
#undef PG8_SA
#undef PG8_SB
#undef PG8_STA
#undef PG8_STB
#undef PG8_LDA
#undef PG8_LDB
#undef PG8_MMA
#undef PG8_CAT
#undef PG8_WAIT_V
#undef PG8_WAIT_L
#undef PG8_BAR
#undef PG8_SCHED
#undef PG8_GLOAD
}
}

namespace att {
constexpr int KSLOT = 8192, VSLOT = 8192, NSLOT = 3;
constexpr int L_K = 0, L_V = NSLOT * KSLOT, L_OST = L_V + NSLOT * VSLOT, L_BYTES = L_OST + NWAVES * 2048;
constexpr int QEXP = 3;
static_assert(L_BYTES <= RING_BYTES, "attention LDS");
#define SBAR() __builtin_amdgcn_sched_barrier(0)
typedef int i32x4a __attribute__((ext_vector_type(4)));
typedef int i32x8a __attribute__((ext_vector_type(8)));
__device__ __forceinline__ int crow(int r, int hi) { return (r & 3) + 8 * (r >> 2) + 4 * hi; }
__device__ __forceinline__ void glds16(const void* gsrc, unsigned lds_dst) { unsigned keep;
    asm volatile("s_mov_b32 %0, m0\n\ts_mov_b32 m0, %2\n\ts_nop 0\n\tglobal_load_lds_dwordx4 %1, off\n\ts_mov_b32 m0, %0" : "=&s"(keep) : "v"(gsrc), "s"(lds_dst) : "memory"); }
typedef float f32x2_t __attribute__((ext_vector_type(2))); typedef __bf16 bf16x2_t __attribute__((ext_vector_type(2)));
__device__ __forceinline__ unsigned cvtpk_s(float lo, float hi) { f32x2_t v = {lo, hi}; bf16x2_t b = __builtin_convertvector(v, bf16x2_t); return __builtin_bit_cast(unsigned, b); }
typedef __attribute__((address_space(3))) const char* lds_cptr;
typedef short v4i16_t __attribute__((ext_vector_type(4)));
__device__ __forceinline__ s16x4 vtr(lds_cptr p) { return __builtin_bit_cast(s16x4, __builtin_amdgcn_ds_read_tr16_b64_v4i16((LAS v4i16_t*)p)); }
__device__ __forceinline__ i32x8a kfrag(lds_cptr kp, int idx) {
    const i32x4a a = *(const LAS i32x4a*)(kp + (idx >> 1) * 4096 + (idx & 1) * 512), b = *(const LAS i32x4a*)(kp + (idx >> 1) * 4096 + (idx & 1) * 512 + 1024);
    return __builtin_shufflevector(a, b, 0, 1, 2, 3, 4, 5, 6, 7);
}
template <int DQK>
__device__ __forceinline__ void attn_unit(const unsigned char* Qw, int qpitch, const unsigned char* Kh, int kpitch, const bf16* Vh, int vpitch, unsigned char* Ow, int NT, float negc, LAS unsigned char* shm) {
    constexpr int NG = (DQK == 96) ? 2 : 1;
    int tid_ = threadIdx.x; asm volatile("" : "+v"(tid_));
    const int tid = tid_, lane = tid & 63, r32 = lane & 31, hi = lane >> 5; const int wid = __builtin_amdgcn_readfirstlane(tid >> 6);
    const unsigned lds0 = (unsigned)(uintptr_t)shm;
    i32x8a qr8[NG];
#pragma unroll
    for (int g = 0; g < NG; ++g) { const unsigned char* qp = Qw + (size_t)r32 * qpitch + g * 64 + hi * 32;
        const i32x4a a = *(const i32x4a*)qp, b = *(const i32x4a*)(qp + 16); qr8[g] = __builtin_shufflevector(a, b, 0, 1, 2, 3, 4, 5, 6, 7); }
    const bool kw = (NG == 2) || (wid < 4);
    const unsigned char* ksrc = Kh + (size_t)lane * kpitch + wid * 16;
    const bf16* vsrc = Vh + (size_t)(16 * (wid & 3) + (lane >> 2)) * vpitch + (wid >> 2) * 32 + (lane & 3) * 8;
    const unsigned kdst = lds0 + L_K + wid * 1024, vdst = lds0 + L_V + wid * 1024;
#define DMA_K(t, ks) do { if (kw) glds16(ksrc + (size_t)(t) * 64 * kpitch, (unsigned)__builtin_amdgcn_readfirstlane(kdst + (ks))); } while (0)
#define DMA_V(t, vs) glds16(vsrc + (size_t)(t) * 64 * vpitch, (unsigned)__builtin_amdgcn_readfirstlane(vdst + (vs)))
#define WAIT_BAR(NV, NK) do { if (kw) asm volatile("s_waitcnt vmcnt(%0) lgkmcnt(0)\n\ts_barrier" :: "n"((NV) + (NK)) : "memory"); \
                              else    asm volatile("s_waitcnt vmcnt(%0) lgkmcnt(0)\n\ts_barrier" :: "n"(NV) : "memory"); } while (0)
    DMA_K(0, 0); DMA_V(0, 0); DMA_K(1, KSLOT); DMA_K(2, 2 * KSLOT);
    f32x16 o[2]; o[0] = f32x16{}; o[1] = f32x16{}; f32x4 o2 = (f32x4){0.f, 0.f, 0.f, 0.f};
    f32x16 negm;
#pragma unroll
    for (int r = 0; r < 16; ++r) negm[r] = negc;
    if constexpr (NG == 1) asm volatile("" : "+v"(negm));
    int sclK = 0x7f7f7f7f, sclQ = 0x01010101 * (127 - QEXP); asm volatile("" : "+v"(sclK), "+v"(sclQ));
    const short ind1 = ((((lane & 15) == 0) && (((lane >> 4) & 1) == 0)) || (((lane & 15) == 1) && (((lane >> 4) & 1) == 1))) ? (short)0x3F80 : (short)0;
    const bf16x8 ones = (bf16x8){ind1, ind1, ind1, ind1, ind1, ind1, ind1, ind1};
#define MFSUM(a, c) __builtin_amdgcn_mfma_f32_16x16x32_bf16(a, ones, c, 0, 0, 0)
    const lds_cptr shm3 = (lds_cptr)shm; const lds_cptr kp0 = shm3 + L_K + (2 * hi) * 1024 + r32 * 16;
    const lds_cptr vp0 = shm3 + L_V + ((lane >> 4) & 1) * 32 + (lane & 3) * 8 + (4 * hi + ((lane & 15) >> 2)) * 64;
    f32x16 pA0, pA1, pB0, pB1; i32x8a kf[2 * NG];
    int kprev = 0, kcur = 0, knext = KSLOT, vprev = 0, vcur = 0, vnext = VSLOT;
#define ROT() do { kprev = kcur; kcur = knext; knext = (knext == 2 * KSLOT) ? 0 : knext + KSLOT; vprev = vcur; vcur = vnext; vnext = (vnext == 2 * VSLOT) ? 0 : vnext + VSLOT; } while (0)
#define MF32(a, b, c) __builtin_amdgcn_mfma_f32_32x32x16_bf16(a, b, c, 0, 0, 0)
#define QK_FIRST(D, A, B) do { if constexpr (NG == 1) D = __builtin_amdgcn_mfma_scale_f32_32x32x64_f8f6f4(A, B, negm, 0, 0, 0, sclK, 0, sclQ); \
                               else D = __builtin_amdgcn_mfma_scale_f32_32x32x64_f8f6f4(A, B, f32x16{}, 0, 0, 0, sclK, 0, sclQ); } while (0)
#define QK_ACC(D, A, B) D = __builtin_amdgcn_mfma_scale_f32_32x32x64_f8f6f4(A, B, D, 0, 0, 0, sclK, 0, sclQ)
#define QK_SETTLE(X, Y) do { PIN(X); PIN(Y); } while (0)
#define KEEP(x) asm volatile("" :: "v"(x))
    WAIT_BAR(1, 2);
#pragma unroll
    for (int i = 0; i < 2 * NG; ++i) kf[i] = kfrag(kp0, i);
    QK_FIRST(pA0, kf[0], qr8[0]); QK_FIRST(pA1, kf[1], qr8[0]);
    if constexpr (NG == 2) { QK_ACC(pA0, kf[2], qr8[1]); QK_ACC(pA1, kf[3], qr8[1]); }
#pragma unroll
    for (int r = 0; r < 16; ++r) { pA0[r] = __builtin_amdgcn_exp2f(pA0[r]); pA1[r] = __builtin_amdgcn_exp2f(pA1[r]); }
    WAIT_BAR(0, 0);
    DMA_K(3, 0); DMA_V(1, VSLOT);
    ROT();
#pragma unroll
    for (int i = 0; i < 2 * NG; ++i) kf[i] = kfrag(kp0 + kcur, i);
    WAIT_BAR(1, 1);
    s16x4 vlo[8], vhi[8]; u32x4 pw0, pw1, pw2, pw3;
#define PKW(P, B) cvtpk_s(P[B], P[B + 1])
#define PAF(k) __builtin_bit_cast(bf16x8, pw##k)
#define VFR(i) (bf16x8){vlo[i][0], vlo[i][1], vlo[i][2], vlo[i][3], vhi[i][0], vhi[i][1], vhi[i][2], vhi[i][3]}
#define PIN(x) asm volatile("" : "+v"(x))
#define EX(v) __builtin_amdgcn_exp2f(v)
#define VRD(i) do { vlo[i] = vtr(vp_ + (((i) >> 2) * 4096 + ((i) & 3) * 1024)); vhi[i] = vtr(vp_ + (((i) >> 2) * 4096 + ((i) & 3) * 1024 + 512)); } while (0)
#define PACK4(PW, P, B) do { PW[0] = PKW(P, B); PW[1] = PKW(P, (B) + 2); PW[2] = PKW(P, (B) + 4); PW[3] = PKW(P, (B) + 6); PIN(PW); } while (0)
#define KRD(G, i) do { if (G) { kf[i] = kfrag(kp0 + knext, i); SBAR(); } } while (0)
#define EXI(C0, C1, i) do { if ((i) < 16) C0[(i) & 15] = EX(C0[(i) & 15]); else C1[(i) & 15] = EX(C1[(i) & 15]); } while (0)
#define GAPB3(MF, C0, C1, I0) do { MF; EXI(C0, C1, I0); EXI(C0, C1, (I0) + 1); EXI(C0, C1, (I0) + 2); PIN(C0); PIN(C1); SBAR(); } while (0)
#define GAPB2(MF, C0, C1, I0) do { MF; EXI(C0, C1, I0); EXI(C0, C1, (I0) + 1); PIN(C0); PIN(C1); SBAR(); } while (0)
#define STEP(C0, C1, P0, P1, t, GK, GV, GL) do { SBAR(); \
    const lds_cptr vp_ = vp0 + vprev; \
      \
    VRD(0); VRD(4); SBAR(); \
    QK_FIRST(C0, kf[0], qr8[0]); PACK4(pw0, P0, 0); VRD(1); VRD(5); SBAR(); \
    QK_FIRST(C1, kf[1], qr8[0]); KEEP(kf[0]); PACK4(pw1, P0, 8); VRD(2); VRD(6); SBAR(); \
    if constexpr (NG == 2) { QK_ACC(C0, kf[2], qr8[1]); KEEP(kf[1]); PACK4(pw2, P1, 0); VRD(3); VRD(7); SBAR(); \
                             QK_ACC(C1, kf[3], qr8[1]); KEEP(kf[2]); PACK4(pw3, P1, 8); SBAR(); } \
    else { PACK4(pw2, P1, 0); VRD(3); VRD(7); PACK4(pw3, P1, 8); SBAR(); } \
    if (GK) { DMA_K((t) + 3, kcur); } if (GV) { DMA_V((t) + 1, vnext); } \
    QK_SETTLE(C0, C1); KEEP(kf[2 * NG - 1]); SBAR(); \
      \
    GAPB3(o[0] = MF32(PAF(0), VFR(0), o[0]), C0, C1, 0); \
    KRD(GL, 0); GAPB3(o[1] = MF32(PAF(0), VFR(4), o[1]), C0, C1, 3); \
    KRD(GL, 1); GAPB3(o2 = MFSUM(PAF(0), o2), C0, C1, 6); \
    KRD(GL && NG == 2, 2); GAPB3(o[0] = MF32(PAF(1), VFR(1), o[0]), C0, C1, 9); \
    KRD(GL && NG == 2, 3); GAPB3(o[1] = MF32(PAF(1), VFR(5), o[1]), C0, C1, 12); \
    GAPB3(o2 = MFSUM(PAF(1), o2), C0, C1, 15); \
    GAPB3(o[0] = MF32(PAF(2), VFR(2), o[0]), C0, C1, 18); \
    GAPB3(o[1] = MF32(PAF(2), VFR(6), o[1]), C0, C1, 21); \
    GAPB2(o2 = MFSUM(PAF(2), o2), C0, C1, 24); \
    GAPB2(o[0] = MF32(PAF(3), VFR(3), o[0]), C0, C1, 26); \
    GAPB2(o[1] = MF32(PAF(3), VFR(7), o[1]), C0, C1, 28); \
    GAPB2(o2 = MFSUM(PAF(3), o2), C0, C1, 30); \
    } while (0)
#define ENDW(tt) do { if ((tt) + 3 < NT) { WAIT_BAR(1, 1); } else if ((tt) + 2 < NT) { WAIT_BAR(1, 0); } else { WAIT_BAR(0, 0); } } while (0)
    int t = 1;
    for (; t + 5 < NT; t += 2) {
        STEP(pB0, pB1, pA0, pA1, t, true, true, true);     WAIT_BAR(1, 1); ROT();
        STEP(pA0, pA1, pB0, pB1, t + 1, true, true, true); WAIT_BAR(1, 1); ROT();
    }
    for (; t + 1 < NT; t += 2) {
        STEP(pB0, pB1, pA0, pA1, t, (t + 3 < NT), (t + 1 < NT), (t + 1 < NT));         ENDW(t);     ROT();
        STEP(pA0, pA1, pB0, pB1, t + 1, (t + 4 < NT), (t + 2 < NT), (t + 2 < NT));     ENDW(t + 1); ROT();
    }
    STEP(pB0, pB1, pA0, pA1, NT - 1, false, false, false);
    { PACK4(pw0, pB0, 0); PACK4(pw1, pB0, 8); PACK4(pw2, pB1, 0); PACK4(pw3, pB1, 8);
      const lds_cptr vp_ = vp0 + vcur;
      VRD(0); VRD(1); VRD(2); VRD(3); VRD(4); VRD(5); VRD(6); VRD(7);
      o[0] = MF32(PAF(0), VFR(0), o[0]); o[1] = MF32(PAF(0), VFR(4), o[1]); o2 = MFSUM(PAF(0), o2);
      o[0] = MF32(PAF(1), VFR(1), o[0]); o[1] = MF32(PAF(1), VFR(5), o[1]); o2 = MFSUM(PAF(1), o2);
      o[0] = MF32(PAF(2), VFR(2), o[0]); o[1] = MF32(PAF(2), VFR(6), o[1]); o2 = MFSUM(PAF(2), o2);
      o[0] = MF32(PAF(3), VFR(3), o[0]); o[1] = MF32(PAF(3), VFR(7), o[1]); o2 = MFSUM(PAF(3), o2); }
#undef DMA_K
#undef DMA_V
#undef WAIT_BAR
#undef ROT
#undef MF32
#undef MFSUM
#undef QK_FIRST
#undef QK_ACC
#undef QK_SETTLE
#undef KEEP
#undef PKW
#undef PAF
#undef VFR
#undef PIN
#undef EX
#undef VRD
#undef PACK4
#undef KRD
#undef EXI
#undef GAPB3
#undef GAPB2
#undef STEP
#undef ENDW
    { LAS unsigned char* stg = (LAS unsigned char*)(shm + L_OST) + wid * 2048;
      LAS float* lq = (LAS float*)stg;
      if ((lane & 15) < 2) { const int q0 = 16 * (lane & 15) + 4 * (lane >> 4);
#pragma unroll
          for (int k = 0; k < 4; ++k) lq[q0 + k] = o2[k]; }
      asm volatile("s_waitcnt lgkmcnt(0)" ::: "memory");
      float rl[16];
#pragma unroll
      for (int r = 0; r < 16; ++r) rl[r] = lq[crow(r, hi)];
      asm volatile("s_waitcnt lgkmcnt(0)" ::: "memory");
      constexpr float sa = (float)(1 << FP8_AEXP);
#pragma unroll
      for (int r = 0; r < 16; ++r) { const int orow = crow(r, hi); const float sc = __builtin_amdgcn_rcpf(rl[r]) * sa;
#pragma unroll
        for (int d0 = 0; d0 < 2; ++d0) stg[orow * 64 + d0 * 32 + r32] = (unsigned char)(pk4_fp8(__builtin_amdgcn_fmed3f(o[d0][r] * sc, -448.f, 448.f), 0.f, 0.f, 0.f) & 0xffu); }
      asm volatile("s_waitcnt lgkmcnt(0)" ::: "memory");
#pragma unroll
      for (int i = 0; i < 2; ++i) { const int row = i * 16 + (lane >> 2), ch = lane & 3; const u32x4 v = *(const LAS u32x4*)(stg + row * 64 + ch * 16); *(u32x4*)(Ow + (size_t)row * DM + ch * 16) = v; } }
    asm volatile("s_waitcnt lgkmcnt(0)\n\ts_barrier" ::: "memory");
}
#undef SBAR
}

#define XB_TMO      128
#define XB_XCNT(j)  (256  + 64 * (j))
#define XB_XSUB(j)  (1280 + 64 * (j))
#define XB_XGEN(j)  (2304 + 64 * (j))
#define XB_TOP      3328
#define XB_TOPGEN   3392
#define XCD_BAR_WORDS 3456
#define XB_SPIN_CAP (1u << 18)
__device__ __forceinline__ unsigned xb_ld(unsigned* p)              { return __hip_atomic_load(p, __ATOMIC_RELAXED, __HIP_MEMORY_SCOPE_AGENT); }
__device__ __forceinline__ unsigned xb_add(unsigned* p, unsigned v) { return __hip_atomic_fetch_add(p, v, __ATOMIC_RELAXED, __HIP_MEMORY_SCOPE_AGENT); }
__device__ __forceinline__ unsigned xb_xcc_id() { return (unsigned)__builtin_amdgcn_s_getreg((3 << 11) | 20) & 0xFu; }
#define XB_SPIN(cond, bar) do { unsigned _sp = 0; while (cond) { __builtin_amdgcn_s_sleep(1); \
    if ((++_sp & 255u) == 0u) { if (xb_ld(&(bar)[XB_TMO])) break; if (_sp > XB_SPIN_CAP) { atomicAdd(&(bar)[XB_TMO], 1u); break; } } } } while (0)
struct XcdBarrier { unsigned* bar; unsigned x; volatile LAS unsigned* st; };
__device__ __forceinline__ XcdBarrier xcd_barrier_post(unsigned* bar, volatile LAS unsigned* st) {
    XcdBarrier b; b.bar = bar; b.x = xb_xcc_id(); b.st = st;
    if (threadIdx.x == 0) (void)xb_add(&bar[XB_XCNT(b.x)], 1u);
    return b;
}
__device__ __forceinline__ void xcd_barrier_complete(unsigned* bar, unsigned x, unsigned& nloc, unsigned& nx) {
    const unsigned G = gridDim.x * gridDim.y * gridDim.z;
    unsigned sum, cnt, mine, sp = 0u;
    for (;;) {
        sum = 0u; cnt = 0u; mine = 0u;
#pragma unroll
        for (unsigned j = 0; j < 16; ++j) { const unsigned c = xb_ld(&bar[XB_XCNT(j)]); sum += c; cnt += (c > 0u) ? 1u : 0u; mine = (j == x) ? c : mine; }
        if (sum == G) break;
        __builtin_amdgcn_s_sleep(1);
        if ((++sp & 255u) == 0u) { if (xb_ld(&bar[XB_TMO])) break; if (sp > XB_SPIN_CAP) { atomicAdd(&bar[XB_TMO], 1u); break; } }
    }
    nloc = mine > 0u ? mine : 1u; nx = cnt > 0u ? cnt : 1u;
}
__device__ __forceinline__ void xcd_barrier(const XcdBarrier& b) {
    asm volatile("s_waitcnt vmcnt(0)" ::: "memory");
    __syncthreads();
    if (threadIdx.x == 0) {
        unsigned* bar = b.bar;
        __builtin_amdgcn_s_waitcnt(0);
        unsigned nloc = b.st[0], nx = b.st[1];
        if (nloc == 0u) { xcd_barrier_complete(bar, b.x, nloc, nx); b.st[0] = nloc; b.st[1] = nx; }
        const unsigned old = xb_add(&bar[XB_XSUB(b.x)], 1u);
        const unsigned gen = old / nloc;
        if (old + 1u == (gen + 1u) * nloc) {
            __builtin_amdgcn_fence(__ATOMIC_RELEASE, "agent");
            asm volatile("s_waitcnt vmcnt(0)" ::: "memory");
            const unsigned og = xb_add(&bar[XB_TOP], 1u);
            const unsigned tg = og / nx;
            if (og + 1u == (tg + 1u) * nx) xb_add(&bar[XB_TOPGEN], 1u);
            else XB_SPIN(xb_ld(&bar[XB_TOPGEN]) == tg, bar);
            __builtin_amdgcn_fence(__ATOMIC_ACQUIRE, "agent");
            xb_add(&bar[XB_XGEN(b.x)], 1u);
            asm volatile("s_waitcnt vmcnt(0)" ::: "memory");
        } else {
            XB_SPIN(xb_ld(&bar[XB_XGEN(b.x)]) == gen, bar);
            __builtin_amdgcn_fence(__ATOMIC_ACQUIRE, "agent");
            asm volatile("s_waitcnt vmcnt(0)" ::: "memory");
        }
    }
    __syncthreads();
}

struct Args { const float* in[28]; float* out; unsigned char* ws; int ph_lo, ph_hi, li, pad; };
typedef const __attribute__((address_space(4))) Args* ArgsP;
struct Ctx {
    LAS unsigned char* lds; int tid, lane, wave, vcu, G, gw, NGW;
    ArgsP ap;
};
#define CIN(k) (C.ap->in[k])
#define CWS (C.ap->ws)
#define COUT (C.ap->out)
template <bool MERGE>
__device__ __forceinline__ void ctx_mini_gemm(const Ctx& C, const unsigned char* A8, const unsigned char* W8, int sclW, int sclA,
                                              unsigned char* Y8, const unsigned char* G8, const float* xin, bf16* xs, const float* gt) {
    const int fr = C.lane & 15, fq = C.lane >> 4;
#pragma unroll 1
    for (int t = C.vcu; t < 256; t += C.G) {
        const int m = (t >> 4) * 64 + (C.wave & 3) * 16 + fr, n0 = (t & 15) * 64 + (C.wave >> 2) * 32;
        const unsigned char* ap = A8 + (size_t)m * DM + fq * 32;
        const unsigned char* bp = W8 + (size_t)(n0 + fr) * DM + fq * 32;
        const int nc = n0 + 4 * fq;
        unsigned ga[2], gb[2]; f32x4 xv[2], gv[2];
        if (MERGE) {
#pragma unroll
            for (int nb = 0; nb < 2; ++nb) { ga[nb] = *(const unsigned*)(G8 + (size_t)m * PROW + GA8 + nc + nb * 16); gb[nb] = *(const unsigned*)(G8 + (size_t)m * PROW + GB8 + nc + nb * 16); }
        } else {
#pragma unroll
            for (int nb = 0; nb < 2; ++nb) { const u32x2 w_ = *(const u32x2*)(xs + (size_t)m * DM + nc + nb * 16); xv[nb] = (f32x4){bflo(w_.x), bfhi(w_.x), bflo(w_.y), bfhi(w_.y)}; gv[nb] = *(const f32x4*)(gt + nc + nb * 16); }
        }
        f32x4 acc[2] = {(f32x4){0.f, 0.f, 0.f, 0.f}, (f32x4){0.f, 0.f, 0.f, 0.f}};
#pragma unroll
        for (int h = 0; h < 2; ++h) {
            u32x4 av[4][2], b0[4][2], b1[4][2];
#pragma unroll
            for (int k = 0; k < 4; ++k) { const int kb = (h * 4 + k) * 128;
                av[k][0] = *(const u32x4*)(ap + kb); av[k][1] = *(const u32x4*)(ap + kb + 16);
                b0[k][0] = *(const u32x4*)(bp + kb); b0[k][1] = *(const u32x4*)(bp + kb + 16);
                b1[k][0] = *(const u32x4*)(bp + 16 * DM + kb); b1[k][1] = *(const u32x4*)(bp + 16 * DM + kb + 16); }
#pragma unroll
            for (int k = 0; k < 4; ++k) {
                const pg8::i32x8v a8 = {(int)av[k][0].x, (int)av[k][0].y, (int)av[k][0].z, (int)av[k][0].w, (int)av[k][1].x, (int)av[k][1].y, (int)av[k][1].z, (int)av[k][1].w};
                const pg8::i32x8v w0 = {(int)b0[k][0].x, (int)b0[k][0].y, (int)b0[k][0].z, (int)b0[k][0].w, (int)b0[k][1].x, (int)b0[k][1].y, (int)b0[k][1].z, (int)b0[k][1].w};
                const pg8::i32x8v w1 = {(int)b1[k][0].x, (int)b1[k][0].y, (int)b1[k][0].z, (int)b1[k][0].w, (int)b1[k][1].x, (int)b1[k][1].y, (int)b1[k][1].z, (int)b1[k][1].w};
                acc[0] = __builtin_amdgcn_mfma_scale_f32_16x16x128_f8f6f4(w0, a8, acc[0], 0, 0, 0, sclW, 0, sclA);
                acc[1] = __builtin_amdgcn_mfma_scale_f32_16x16x128_f8f6f4(w1, a8, acc[1], 0, 0, 0, sclW, 0, sclA); }
            if (MERGE && h == 0) {
#pragma unroll
                for (int nb = 0; nb < 2; ++nb)
#pragma unroll
                    for (int k = 0; k < 4; ++k) acc[nb][k] *= pg8::EpiGateF::ub(ga[nb], k) * __builtin_amdgcn_rcpf(fmaxf(pg8::EpiGateF::ub(gb[nb], k), 1.0f));
            }
        }
        if (MERGE) { constexpr float sa = (float)(1 << FP8_AEXP) / 255.0f;
#pragma unroll
            for (int nb = 0; nb < 2; ++nb) { const f32x4 v = acc[nb]; const unsigned wb = gb[nb];
                *(unsigned*)(Y8 + (size_t)m * DM + nc + nb * 16) = pk4_fp8_sat(v[0] * sa * fmaxf(pg8::EpiGateF::ub(wb, 0), 1.0f), v[1] * sa * fmaxf(pg8::EpiGateF::ub(wb, 1), 1.0f), v[2] * sa * fmaxf(pg8::EpiGateF::ub(wb, 2), 1.0f), v[3] * sa * fmaxf(pg8::EpiGateF::ub(wb, 3), 1.0f)); }
        } else {
#pragma unroll
            for (int nb = 0; nb < 2; ++nb) { const f32x4 o = xv[nb] + gv[nb] * acc[nb];
                u32x2 w; w.x = pg8::cvt_pk_bf16(o[0], o[1]); w.y = pg8::cvt_pk_bf16(o[2], o[3]); *(u32x2*)(xs + (size_t)m * DM + nc + nb * 16) = w; }
        }
    }
}
__device__ __forceinline__ void transpose_item(const float* W, int N, bf16* WT, int ldo, int k0, int n0, int orow0, const float* gain, LAS float* scr, int lane) {
    float tv[32];
#pragma unroll
    for (int i = 0; i < 32; ++i) { const int kk = 2 * i + (lane >> 5); tv[i] = __builtin_nontemporal_load(W + (size_t)(k0 + kk) * N + n0 + (lane & 31)); }
#pragma unroll
    for (int i = 0; i < 32; ++i) { const int kk = 2 * i + (lane >> 5); float v = tv[i]; if (gain) v *= gain[k0 + kk]; scr[kk * 33 + (lane & 31)] = v; }
    LDS_WAIT(); asm volatile("" ::: "memory");
    const int c = lane & 7;
#pragma unroll
    for (int j = 0; j < 4; ++j) { const int n = (lane >> 3) + 8 * j; const LAS float* s = scr + (8 * c) * 33 + n;
        u32x4 o; o.x = pk2(s[0 * 33], s[1 * 33]); o.y = pk2(s[2 * 33], s[3 * 33]); o.z = pk2(s[4 * 33], s[5 * 33]); o.w = pk2(s[6 * 33], s[7 * 33]);
        __builtin_nontemporal_store(o, (GAS u32x4*)(WT + (size_t)(orow0 + n) * ldo + k0 + 8 * c)); }
    LDS_WAIT(); asm volatile("" ::: "memory");
}
template <bool I8>
__device__ __forceinline__ void transpose_item8(const float* W, int N, unsigned char* WT, int ldo, int k0, int n0, int orow0, float scl, LAS float* scr, int lane, int kdoff = 0) {
    float tv[32];
#pragma unroll
    for (int i = 0; i < 32; ++i) { const int kk = 2 * i + (lane >> 5); tv[i] = __builtin_nontemporal_load(W + (size_t)(k0 + kk) * N + n0 + (lane & 31)); }
#pragma unroll
    for (int i = 0; i < 32; ++i) { const int kk = 2 * i + (lane >> 5); scr[kk * 33 + (lane & 31)] = I8 ? tv[i] : tv[i] * scl; }
    LDS_WAIT(); asm volatile("" ::: "memory");
    const int c = lane & 7;
#pragma unroll
    for (int j = 0; j < 4; ++j) { const int n = (lane >> 3) + 8 * j; const LAS float* s = scr + (8 * c) * 33 + n;
        u32x2 o; if (I8) { o.x = pk4_i8(s[0 * 33], s[1 * 33], s[2 * 33], s[3 * 33], scl); o.y = pk4_i8(s[4 * 33], s[5 * 33], s[6 * 33], s[7 * 33], scl); }
        else { o.x = pk4_fp8(s[0 * 33], s[1 * 33], s[2 * 33], s[3 * 33]); o.y = pk4_fp8(s[4 * 33], s[5 * 33], s[6 * 33], s[7 * 33]); }
        __builtin_nontemporal_store(o, (GAS u32x2*)(WT + (size_t)(orow0 + n) * ldo + kdoff + k0 + 8 * c)); }
    LDS_WAIT(); asm volatile("" ::: "memory");
}
constexpr int CS_IN = 16 * 101, CS_UQ = 4 * 24, CS_UKV = 2 * 32, CS_OA = 8 * 32, CS_PAD = 96, CS_PAD2 = 256;
constexpr int CONV_NSTATIC = CS_IN + CS_UQ + CS_UKV + 2 * CS_OA + CS_PAD + CS_PAD2;
constexpr int CQ_OUT = 16 * 32, CQ_G = 16 * 16, CQ_D = 8 * 32;
constexpr int CONV_NQUEUE = CQ_OUT + 17 * 2 * CQ_G + 17 * CQ_D;
__device__ __forceinline__ void convert_static_item(const Ctx& C, int l, int it, LAS float* scr) {
    bf16* WB = (bf16*)(CWS + WS_W) + (size_t)l * WL_STRIDE;
    constexpr float WS8 = (float)(1 << FP8_WEXP), WI8 = (float)(1 << I8_WEXP);
    int r = it;
    if (r < CS_IN) { const int kb = r / 101, nb = r % 101; transpose_item8<true>(CIN(8) + (size_t)l * DM * INC, INC, (unsigned char*)(WB + WO_IN), 1024, 64 * kb, 32 * nb, (32 * nb < C_QB) ? 32 * nb : 32 * nb + 96, WI8, scr, C.lane); return; } r -= CS_IN;
    if (r < CS_UQ) { const int kb = r / 24, nb = r % 24; transpose_item(CIN(10) + (size_t)l * 256 * 768, 768, WB + WO_UQ, 256, 64 * kb, 32 * nb, 32 * nb, CIN(9) + l * 256, scr, C.lane); return; } r -= CS_UQ;
    if (r < CS_UKV) { const int kb = r / 32, nb = r % 32; transpose_item(CIN(12) + (size_t)l * 128 * 1024, 1024, WB + WO_UKV, 256, 64 * kb, 32 * nb, 32 * nb, CIN(11) + l * 128, scr, C.lane); return; } r -= CS_UKV;
    if (r < CS_OA) { const int kb = r / 32, nb = r % 32; transpose_item8<false>(CIN(17) + (size_t)l * 512 * DM, 1024, (unsigned char*)(WB + WO_OA), 1024, 64 * kb, 32 * nb, 32 * nb, WS8, scr, C.lane, 0); return; } r -= CS_OA;
    if (r < CS_OA) { const int kb = r / 32, nb = r % 32; transpose_item8<false>(CIN(18) + (size_t)l * 512 * DM, 1024, (unsigned char*)(WB + WO_OA), 1024, 64 * kb, 32 * nb, 32 * nb, WS8, scr, C.lane, 512); return; } r -= CS_OA;
    u32x4 zz = (u32x4){0u, 0u, 0u, 0u}; asm volatile("" : "+v"(zz));
    if (r < CS_PAD) { unsigned char* p = (unsigned char*)(WB + WO_IN) + (size_t)(C_QB + r) * 1024;
      *(GAS u32x4*)(p + C.lane * 16) = zz; return; } r -= CS_PAD;
    { const int row = r * 4 + (C.lane >> 4), ch = C.lane & 15;
      *(GAS u32x4*)(WB + WO_UKV + (size_t)row * 256 + 128 + ch * 8) = zz; }
}
__device__ __forceinline__ void convert_queue_item(const Ctx& C, int l, int it, LAS float* scr) {
    bf16* WB = (bf16*)(CWS + WS_W) + (size_t)l * WL_STRIDE;
    constexpr float WS8 = (float)(1 << FP8_WEXP), WI8 = (float)(1 << I8_WEXP);
    int r = it;
    if (r < CQ_OUT) { const int kb = r / 32, nb = r % 32; transpose_item8<false>(CIN(19) + (size_t)l * DM * DM, 1024, (unsigned char*)(WB + WO_OUT), 1024, 64 * kb, 32 * nb, 32 * nb, WS8, scr, C.lane); return; } r -= CQ_OUT;
    if (r < 17 * 2 * CQ_G) { const int e = r / (2 * CQ_G), q = r % (2 * CQ_G), up = q / CQ_G, sx = q % CQ_G, kb = sx / 16, nb = sx % 16;
        const float* src = (e < 16) ? ((up ? CIN(23) : CIN(22)) + ((size_t)l * NEXP + e) * DM * FF) : ((up ? CIN(26) : CIN(25)) + (size_t)l * DM * FF);
        const int n0 = 32 * nb, orow = (n0 >> 7) * 256 + up * 128 + (n0 & 127);
        transpose_item8<true>(src, FF, (unsigned char*)(WB + WO_GU) + (size_t)e * 1024 * 1024, 1024, 64 * kb, n0, orow, WI8, scr, C.lane); return; } r -= 17 * 2 * CQ_G;
    { const int e = r / CQ_D, sx = r % CQ_D, kb = sx / 32, nb = sx % 32;
        const float* src = (e < 16) ? (CIN(24) + ((size_t)l * NEXP + e) * FF * DM) : (CIN(27) + (size_t)l * FF * DM);
        transpose_item8<false>(src, 1024, (unsigned char*)(WB + WO_DN) + (size_t)e * 1024 * 512, 512, 64 * kb, 32 * nb, 32 * nb, WS8, scr, C.lane); }
}
__device__ __forceinline__ void convert_static(const Ctx& C, int l, int gw, int ngw) {
    LAS float* scr = (LAS float*)(C.lds + C.wave * 12288);
    for (int it = gw; it < CONV_NSTATIC; it += ngw) convert_static_item(C, l, it, scr);
}
__device__ __forceinline__ int convert_steal(const Ctx& C, int l, int limit, int max_grabs, bool precheck = false) {
    LAS float* scr = (LAS float*)(C.lds + C.wave * 12288);
    LAS int* sb = (LAS int*)(C.lds + LDSX_PFX + 128);
    unsigned* head = (unsigned*)(CWS + WS_CTL) + CW_STEAL + 64 * l;
    int g = 0;
    if (precheck) {
        __syncthreads();
        if (C.tid == 0) *sb = (int)__hip_atomic_load(head, __ATOMIC_RELAXED, __HIP_MEMORY_SCOPE_AGENT);
        __syncthreads();
        const int h0 = __builtin_amdgcn_readfirstlane(*sb);
        __syncthreads();
        if (h0 >= limit) return 0;
    }
    for (; g < max_grabs; ++g) {
        __syncthreads();
        if (C.tid == 0) *sb = (int)__hip_atomic_fetch_add(head, 16u, __ATOMIC_RELAXED, __HIP_MEMORY_SCOPE_AGENT);
        __syncthreads();
        const int base = __builtin_amdgcn_readfirstlane(*sb);
        if (base >= CONV_NQUEUE) break;
#pragma unroll 1
        for (int k = 0; k < 2; ++k) { const int it = base + C.wave * 2 + k; if (it < CONV_NQUEUE) convert_queue_item(C, l, it, scr); }
        if (base + 16 >= limit) { ++g; break; }
    }
    __syncthreads();
    return g;
}
__device__ __forceinline__ unsigned queue_head_early(const Ctx& C, int l) {
    unsigned h = 0u; if (C.tid == 0) h = __hip_atomic_load((unsigned*)(CWS + WS_CTL) + CW_STEAL + 64 * l, __ATOMIC_RELAXED, __HIP_MEMORY_SCOPE_AGENT); return h; }
__device__ __forceinline__ void sweep_late(const Ctx& C, int l, int limit, unsigned hq) {
    LAS int* sb = (LAS int*)(C.lds + LDSX_PFX + 128);
    __syncthreads();
    if (C.tid == 0) *sb = (int)hq;
    __syncthreads();
    const int h0 = __builtin_amdgcn_readfirstlane(*sb);
    __syncthreads();
    if (h0 < limit) (void)convert_steal(C, l, limit, 1 << 20);
}
__device__ __forceinline__ void mod_gemv(const Ctx& C, int unit) {
    const int l = unit / 24, jb = unit % 24, j = jb * 256 + 4 * C.lane;
    const float* wm = CIN(4) + (size_t)l * DM * 6144 + j; const float* cc = CIN(1); const float* cx = CIN(3);
    f32x4 acc[5];
#pragma unroll
    for (int w = 0; w < 5; ++w) acc[w] = (f32x4){0.f, 0.f, 0.f, 0.f};
#pragma unroll
    for (int dc = 0; dc < 2; ++dc) { const int d0 = C.wave * 128 + dc * 64;
        float s[5];
#pragma unroll
        for (int w = 0; w < 5; ++w) { const float v = (w < 4) ? cc[w * DM + d0 + C.lane] : cx[d0 + C.lane]; s[w] = v * sigmoidf_(v); }
#pragma unroll
        for (int db = 0; db < 64; db += 16) { f32x4 wv[16];
#pragma unroll
            for (int dd = 0; dd < 16; ++dd) wv[dd] = __builtin_nontemporal_load((const f32x4*)(wm + (size_t)(d0 + db + dd) * 6144));
#pragma unroll
            for (int dd = 0; dd < 16; ++dd) asm volatile("" : "+v"(wv[dd]));
#pragma unroll
            for (int dd = 0; dd < 16; ++dd)
#pragma unroll
                for (int w = 0; w < 5; ++w) acc[w] = acc[w] + wv[dd] * rlane(s[w], db + dd); } }
    LAS f32x4* part = (LAS f32x4*)C.lds;
#pragma unroll
    for (int w = 0; w < 5; ++w) part[(C.wave * 5 + w) * 64 + C.lane] = acc[w];
    __syncthreads();
    if (C.wave < 5) { f32x4 t = (f32x4){0.f, 0.f, 0.f, 0.f};
#pragma unroll
        for (int k = 0; k < 8; ++k) t = t + part[(k * 5 + C.wave) * 64 + C.lane];
        float* mv = (float*)(CWS + WS_MISC + MO_MODV) + (size_t)l * 5 * 6144; *(f32x4*)(mv + C.wave * 6144 + j) = t + *(const f32x4*)(CIN(5) + l * 6144 + j); }
    __syncthreads();
}
__device__ __forceinline__ void make_tables(const Ctx& C) {
    float* ta = (float*)(CWS + WS_MISC + MO_TABA); float* tb = (float*)(CWS + WS_MISC + MO_TABB);
    for (int i = C.lane; i < 64 * 8; i += 64) { const int pos = i >> 3, f = i & 7; const float inv = exp2f(-13.287712379549449f * (float)(2 * f) / 16.0f); const float a = (float)pos * inv; ta[2 * i] = cosf(a); ta[2 * i + 1] = sinf(a); }
    for (int i = C.lane; i < 64 * 16; i += 64) { const int pos = i >> 4, f = i & 15; const float inv = exp2f(-13.287712379549449f * (float)(2 * f) / 32.0f); const float a = (float)pos * inv; tb[2 * i] = cosf(a); tb[2 * i + 1] = sinf(a); }
    float* cb = (float*)(CWS + WS_MISC + MO_CB);
    for (int l = 0; l < NLAYER; ++l) {
        float ma = 0.f, mb = 0.f, mc = 0.f, md = 0.f;
        for (int i = C.lane; i < 96; i += 64) { ma = fmaxf(ma, fabsf(CIN(13)[l * 96 + i])); mb = fmaxf(mb, fabsf(CIN(14)[l * 96 + i])); }
        { const int i = C.lane; mc = fabsf(CIN(15)[l * 64 + i]); md = fabsf(CIN(16)[l * 64 + i]); }
#pragma unroll
        for (int o = 1; o < 64; o <<= 1) { ma = fmaxf(ma, shx(ma, C.lane, o)); mb = fmaxf(mb, shx(mb, C.lane, o)); mc = fmaxf(mc, shx(mc, C.lane, o)); md = fmaxf(md, shx(md, C.lane, o)); }
        if (C.lane == 0) { cb[l * 2 + 0] = -(SCA * 96.0f * ma * mb * 1.02f + 0.5f); cb[l * 2 + 1] = -(SCB * 64.0f * mc * md * 1.02f + 0.5f); }
    }
}
__device__ __forceinline__ const float* stream_in(const Ctx& C, int l, int r) { return (r < TC) ? CIN(2) + (size_t)r * DM : CIN(0) + (size_t)(r - TC) * DM; }
__device__ __forceinline__ void xs_load(const bf16* row, int lane, f32x4 (&v)[4]) {
#pragma unroll
    for (int j = 0; j < 4; ++j) { const u32x2 w = *(const u32x2*)(row + j * 256 + 4 * lane); v[j] = (f32x4){bflo(w.x), bfhi(w.x), bflo(w.y), bfhi(w.y)}; }
}
__device__ __forceinline__ void xs_store(bf16* row, int lane, const f32x4 (&v)[4]) {
#pragma unroll
    for (int j = 0; j < 4; ++j) { u32x2 w; w.x = pk2(v[j].x, v[j].y); w.y = pk2(v[j].z, v[j].w); *(u32x2*)(row + j * 256 + 4 * lane) = w; }
}
__device__ __forceinline__ void expert_prefix(const unsigned* cnt, int srow0, LAS int* pfx, int tid) {
    if (tid == 0) { int s = 0;
#pragma unroll
        for (int e = 0; e < 16; ++e) { pfx[e] = s; s += ((int)cnt[64 * e] + 255) >> 8; }
        pfx[16] = s; s += (T - srow0) >> 8; pfx[17] = s; }
    __syncthreads();
}
__device__ __forceinline__ void wave_rows(int gw, int NGW, int lo, int hi, int& rb, int& re) { const int n = hi - lo, q = n / NGW, rem = n % NGW; rb = lo + gw * q + (gw < rem ? gw : rem); re = rb + q + (gw < rem ? 1 : 0); }
struct CombIdx { size_t r0, r1, r2; };
__device__ __forceinline__ CombIdx comb_idx(const Ctx& C, int r, const LAS int* pfx, int srow0) {
    const int* tp = (const int*)(CWS + WS_ROUTE + RO_TOKPOS) + 2 * r; const int t0 = tp[0], t1 = tp[1];
    CombIdx ci; ci.r0 = (size_t)pfx[16] * 256 + (r - srow0); ci.r1 = (size_t)pfx[t0 >> 20] * 256 + (t0 & 0xfffff); ci.r2 = (size_t)pfx[t1 >> 20] * 256 + (t1 & 0xfffff); return ci;
}
__device__ __forceinline__ void comb_load(const Ctx& C, const CombIdx& ci, unsigned (&y)[3][4]) {
    const unsigned char* YE = (const unsigned char*)(CWS + WS_R2);
#pragma unroll
    for (int j = 0; j < 4; ++j) { y[0][j] = __builtin_nontemporal_load((const unsigned*)(YE + ci.r0 * DM + j * 256 + 4 * C.lane)); y[1][j] = __builtin_nontemporal_load((const unsigned*)(YE + ci.r1 * DM + j * 256 + 4 * C.lane)); y[2][j] = __builtin_nontemporal_load((const unsigned*)(YE + ci.r2 * DM + j * 256 + 4 * C.lane)); }
}
__device__ __forceinline__ f32x4 fp8x4_to_f32(unsigned w) {
    const f32x2 lo = __builtin_amdgcn_cvt_pk_f32_fp8((int)w, false), hi = __builtin_amdgcn_cvt_pk_f32_fp8((int)w, true);
    return (f32x4){lo.x, lo.y, hi.x, hi.y};
}
__device__ __forceinline__ void comb_apply(const Ctx& C, const LAS float* gt2, const unsigned (&y)[3][4], f32x4 (&v)[4]) {
    constexpr float us = 1.0f / (float)(1 << FP8_AEXP);
#pragma unroll
    for (int j = 0; j < 4; ++j) { const f32x4 g = *(const LAS f32x4*)(gt2 + j * 256 + 4 * C.lane);
        const f32x4 t = (fp8x4_to_f32(y[0][j]) + fp8x4_to_f32(y[1][j]) + fp8x4_to_f32(y[2][j])) * us;
        v[j] = v[j] + g * t; }
}
__device__ __forceinline__ void mod_chunk_to_lds(LAS float* dst, const float* modv_layer, int chunk, int tid) {
#pragma unroll
    for (int q = 0; q < 10; ++q) { const int i = q * NTHR + tid, w = i >> 10, j = i & 1023; dst[i] = modv_layer[(size_t)(w * 6 + chunk) * DM + j]; }
}
__device__ __forceinline__ void norm_mod_row(const Ctx& C, const f32x4 (&v)[4], const f32x4 (&g)[4], const LAS float* sh, const LAS float* sc, unsigned char* orow, f32x4 (&f)[4]) {
    float s = 0.f;
#pragma unroll
    for (int j = 0; j < 4; ++j) s += (v[j].x * v[j].x + v[j].y * v[j].y) + (v[j].z * v[j].z + v[j].w * v[j].w);
    const float rstd = __builtin_amdgcn_rsqf(wave_sum(s, C.lane) * (1.0f / DM) + EPS);
#pragma unroll
    for (int j = 0; j < 4; ++j) { const int c = j * 256 + 4 * C.lane;
        const f32x4 a = *(const LAS f32x4*)(sc + c), b = *(const LAS f32x4*)(sh + c);
        f[j] = (v[j] * rstd) * g[j] * (a + 1.0f) + b;
        *(unsigned*)(orow + c) = pk4_i8(f[j].x, f[j].y, f[j].z, f[j].w, (float)(1 << I8_AEXP)); }
}

constexpr int NPHASE = 1 + NLAYER * 10 + 1;

__global__ void __launch_bounds__(NTHR, 2) fwd_kernel(Args args) {
    extern __shared__ __attribute__((aligned(16))) unsigned char lds_raw[];
    Ctx C;
    C.lds = (LAS unsigned char*)lds_raw;
    C.tid = threadIdx.x; C.lane = C.tid & 63; C.wave = __builtin_amdgcn_readfirstlane(C.tid >> 6);
    C.G = gridDim.x; { const int bx = blockIdx.x; C.vcu = (C.G % 8 == 0) ? (bx % 8) * (C.G / 8) + bx / 8 : bx; }
    C.gw = C.vcu * NWAVES + C.wave; C.NGW = C.G * NWAVES;
    C.ap = (ArgsP)__builtin_amdgcn_kernarg_segment_ptr();
    unsigned char* ws = C.ap->ws;
    unsigned* ctl = (unsigned*)(ws + WS_CTL);
    volatile LAS unsigned* bst = (volatile LAS unsigned*)(C.lds + LDSX_MISC);
    if (C.tid < 4) bst[C.tid] = 0u;
    __syncthreads();
    XcdBarrier bar = xcd_barrier_post(ctl + CW_BAR + C.ap->li * XCD_BAR_WORDS, bst);
    const int lo = C.ap->ph_lo, hi = C.ap->ph_hi;
#ifndef PHMASK
#define PHMASK 0xfff
#endif
#define EN(kind) (((PHMASK) >> (kind)) & 1)
#ifndef REPMASK
#define REPMASK 0
#endif
#define NREP(kind) (1 + (((REPMASK) >> (kind)) & 1))
#define IN(k) (lo <= (k) && (k) < hi)
#ifndef BARX
#define BARX 1
#endif
#define SEAM(k) do { if (IN(k) && IN((k) + 1)) { _Pragma("unroll 1") for (int bx_ = 0; bx_ < BARX; ++bx_) { XcdBarrier b_ = bar; asm volatile("" : "+s"(b_.x)); xcd_barrier(b_); } } } while (0)
    LAS int* gtab = (LAS int*)(C.lds + LDSX_GTAB);
    LAS int* pfxl = (LAS int*)(C.lds + LDSX_PFX);
#define PH() { ArgsP _ap = C.ap; asm volatile("" : "+s"(_ap)); C.ap = _ap; int t_ = threadIdx.x; asm volatile("" : "+v"(t_)); C.tid = t_; C.lane = t_ & 63; C.wave = __builtin_amdgcn_readfirstlane(t_ >> 6); C.gw = C.vcu * NWAVES + C.wave; } \
    unsigned char* ws = C.ap->ws; unsigned* ctl = (unsigned*)(ws + WS_CTL); (void)ctl; \
    float* MODV = (float*)(ws + WS_MISC + MO_MODV); (void)MODV; bf16* WB = (bf16*)(ws + WS_W) + (size_t)l * WL_STRIDE; (void)WB; \
    bf16* R1 = (bf16*)(ws + WS_R1); (void)R1; bf16* PROJ = (bf16*)(ws + WS_R2); (void)PROJ; bf16* UQ = (bf16*)(ws + WS_R4); (void)UQ; bf16* QA = UQ; (void)QA; bf16* XS = (bf16*)(ws + WS_R5); (void)XS; \
    unsigned char* KA = ws + WS_R3 + R3_KA; (void)KA; bf16* VA = (bf16*)(ws + WS_R3 + R3_VA); (void)VA; unsigned char* QB = ws + WS_R3 + R3_QB; (void)QB; \
    unsigned char* KB = ws + WS_R3 + R3_KB; (void)KB; bf16* VB = (bf16*)(ws + WS_R3 + R3_VB); (void)VB; unsigned char* QA8 = ws + WS_R3 + R3_QA; (void)QA8; \
    bf16* Y1 = (bf16*)(ws + WS_R3 + R3_Y1); (void)Y1; bf16* YY = (bf16*)(ws + WS_R3 + R3_Y); (void)YY; bf16* HH = (bf16*)(ws + WS_R3 + R3_HH); (void)HH; \
    const float* modl = MODV + (size_t)l * 5 * 6144; (void)modl;

    if (EN(0) && IN(0)) {
#pragma unroll 1
      for (int rep = 0; rep < NREP(0); ++rep) {
        { ArgsP _ap = C.ap; asm volatile("" : "+s"(_ap)); C.ap = _ap; }
        const bool big = (C.G >= 250); const bool gemv_wg = big && (C.vcu % 5 == 0) && (C.vcu < 240);
        if (!big) { for (int u = C.vcu; u < 48; u += C.G) mod_gemv(C, u); } else if (gemv_wg) mod_gemv(C, C.vcu / 5);
        if (C.wave == 1 && C.vcu == 241 % C.G) make_tables(C);
        if (!big) convert_static(C, 0, C.gw, C.NGW); else if (!gemv_wg) { const int v3 = (C.vcu < 240) ? C.vcu - C.vcu / 5 - 1 : C.vcu - 48; convert_static(C, 0, v3 * NWAVES + C.wave, (C.G - 48) * NWAVES); }
        if (big && !gemv_wg) (void)convert_steal(C, 0, CONV_NQUEUE, 2);
        __syncthreads();
      }
    }
    SEAM(0);

    for (int l = 0; l < NLAYER; ++l) {
        const int P = 1 + l * 10;
        const bool lastl = (l == NLAYER - 1);
        const int mrow0 = lastl ? TC : 0;

        if (EN(1) && IN(P + 0)) {
#pragma unroll 1
          for (int rep = 0; rep < (NREP(1) > 1 && l == 0 ? 2 : 1); ++rep) {
            PH();
            if (l > 0 && !IN(P - 2)) expert_prefix(ctl + CW_CNT + (l - 1) * 1024, 0, pfxl, C.tid);
            LAS float* mt = (LAS float*)C.lds;
            mod_chunk_to_lds(mt, modl, 0, C.tid); mod_chunk_to_lds(mt + 5 * DM, modl, 1, C.tid);
            if (l > 0) mod_chunk_to_lds(mt + 10 * DM, MODV + (size_t)(l - 1) * 5 * 6144, 5, C.tid);
            f32x4 gv[4];
#pragma unroll
            for (int j = 0; j < 4; ++j) gv[j] = *(const f32x4*)(CIN(6) + l * DM + j * 256 + 4 * C.lane);
            __syncthreads();
            int rb, re; wave_rows(C.gw, C.NGW, 0, T, rb, re);
            if (l == 0) {
                for (int r0 = rb; r0 < re; r0 += 4) {
                    f32x4 v[4][4], f[4];
#pragma unroll
                    for (int k = 0; k < 4; ++k) { const int r = (r0 + k < re) ? r0 + k : re - 1; const float* src = stream_in(C, 0, r);
#pragma unroll
                        for (int j = 0; j < 4; ++j) v[k][j] = __builtin_nontemporal_load((const f32x4*)(src + j * 256 + 4 * C.lane)); }
#pragma unroll
                    for (int k = 0; k < 4; ++k) if (r0 + k < re) { const int r = r0 + k, which = (r < TC) ? 4 : ((r - TC) >> 12);
                        xs_store(XS + (size_t)r * DM, C.lane, v[k]);
                        norm_mod_row(C, v[k], gv, mt + which * DM, mt + (5 + which) * DM, (unsigned char*)R1 + (size_t)r * DM, f); }
                }
            } else {
                constexpr int NB = 4;
                CombIdx cn[NB];
#pragma unroll
                for (int k = 0; k < NB; ++k) { const int r = (rb + k < re) ? rb + k : re - 1; cn[k] = comb_idx(C, r, pfxl, 0); }
                for (int r0 = rb; r0 < re; r0 += NB) {
                    f32x4 v[NB][4], f[4]; unsigned y[NB][3][4]; CombIdx ci[NB];
#pragma unroll
                    for (int k = 0; k < NB; ++k) { const int r = (r0 + k < re) ? r0 + k : re - 1; ci[k] = cn[k]; xs_load(XS + (size_t)r * DM, C.lane, v[k]); }
#pragma unroll
                    for (int k = 0; k < NB; ++k) comb_load(C, ci[k], y[k]);
#pragma unroll
                    for (int k = 0; k < NB; ++k) { const int r = (r0 + NB + k < re) ? r0 + NB + k : re - 1; cn[k] = comb_idx(C, r, pfxl, 0); }
#pragma unroll
                    for (int k = 0; k < NB; ++k) if (r0 + k < re) { const int r = r0 + k, which = (r < TC) ? 4 : ((r - TC) >> 12);
                        comb_apply(C, mt + (10 + which) * DM, y[k], v[k]); xs_store(XS + (size_t)r * DM, C.lane, v[k]);
                        norm_mod_row(C, v[k], gv, mt + which * DM, mt + (5 + which) * DM, (unsigned char*)R1 + (size_t)r * DM, f); }
                }
            }
            __syncthreads();
            if (l > 0) convert_static(C, l, C.gw, C.NGW);
          }
        }
        SEAM(P + 0);

        if (EN(2) && IN(P + 1)) {
#pragma unroll 1
          for (int rep = 0; rep < NREP(2); ++rep) {
            PH();
            constexpr int SW = 0x01010101 * (127 - FP8_WEXP), SA0 = 0x7f7f7f7f;
            pg8::StaticOrder S; S.init(T, INCP, C.G, (int)blockIdx.x, DM / 2, DM / 2);
            pg8::EpiProj E{PROJ};
            pg8::gemm_phase<pg8::EpiProj, pg8::StaticOrder, false, 2>(C.lds, R1, DM / 2, WB + WO_IN, DM / 2, S, E, gtab, SW, SA0, 1.0f / (float)(1 << (I8_AEXP + I8_WEXP)));
            if ((S.nwg + C.G - 1 - S.c) / C.G < (S.nwg + C.G - 1) / C.G) (void)convert_steal(C, l, CONV_NQUEUE, 2);
          }
        }
        SEAM(P + 1);

        if (EN(3) && IN(P + 2)) {
#pragma unroll 1
          for (int rep = 0; rep < NREP(3); ++rep) {
            PH();
            { pg8::StaticOrder S; S.init(T, 768, C.G, (int)blockIdx.x, INCP, 256);
              pg8::EpiF8 E{(unsigned char*)UQ, 768};
              pg8::gemm_phase<pg8::EpiF8, pg8::StaticOrder, false>(C.lds, PROJ + C_CQ, INCP, WB + WO_UQ, 256, S, E, gtab); }
            __builtin_amdgcn_sched_barrier(0); asm volatile("" ::: "memory");
            { pg8::StaticOrder S; S.init(T, 1024, C.G, (int)((blockIdx.x + 52) % C.G), INCP, 256);
              pg8::EpiF8 E{(unsigned char*)R1, 1024};
              pg8::gemm_phase<pg8::EpiF8, pg8::StaticOrder, false>(C.lds, PROJ + C_CKV, INCP, WB + WO_UKV, 256, S, E, gtab); }
          }
        }
        SEAM(P + 2);

        if (EN(4) && IN(P + 3)) {
#pragma unroll 1
          for (int rep = 0; rep < (NREP(4) > 1 ? 2 : 1); ++rep) {
            PH();
            const unsigned hq = queue_head_early(C, l);
            const float* g_qa = CIN(13) + l * 96; const float* g_ka = CIN(14) + l * 96; const float* g_qb = CIN(15) + l * 64; const float* g_kb = CIN(16) + l * 64;
            const float* tabA = (const float*)(ws + WS_MISC + MO_TABA); const float* tabB = (const float*)(ws + WS_MISC + MO_TABB);
            const int h = C.lane >> 3, j = C.lane & 7, ax = j >> 2, i0 = 2 * (j & 3);
            float gqa_n[8], gka_n[8], gqa_r[4], gka_r[4], gqb8[8], gkb8[8];
#pragma unroll
            for (int e = 0; e < 8; ++e) { gqa_n[e] = g_qa[8 * j + e]; gka_n[e] = g_ka[8 * j + e]; gqb8[e] = g_qb[8 * j + e]; gkb8[e] = g_kb[8 * j + e]; }
#pragma unroll
            for (int e = 0; e < 2; ++e) { gqa_r[e] = g_qa[64 + ax * 16 + i0 + e]; gqa_r[2 + e] = g_qa[64 + ax * 16 + 8 + i0 + e]; gka_r[e] = g_ka[64 + ax * 16 + i0 + e]; gka_r[2 + e] = g_ka[64 + ax * 16 + 8 + i0 + e]; }
            sweep_late(C, l, CQ_OUT, hq);
            int rb, re; wave_rows(C.gw, C.NGW, 0, T, rb, re);
            for (int r0 = rb; r0 < re; r0 += 2) {
                u32x2 i_cq[2]; unsigned i_ckv[2], i_q1[2], i_q2[2], i_k1[2], i_k2[2]; u32x2 i_uq[2], i_uk[2], i_uv[2], i_qb[2], i_kb[2], i_vb[2]; f32x4 t_a[2], t_b[2][4];
#pragma unroll
                for (int k = 0; k < 2; ++k) { const int r = (r0 + k < re) ? r0 + k : re - 1;
                    const bf16* pr = PROJ + (size_t)r * INCP; const unsigned char* uq = (const unsigned char*)UQ + (size_t)r * 768 + h * 96; const unsigned char* uk = (const unsigned char*)R1 + (size_t)r * 1024 + h * 128;
#define NTL(T_, p_) __builtin_nontemporal_load((const T_*)(p_))
                    i_cq[k] = NTL(u32x2, pr + C_CQ + 4 * C.lane); i_ckv[k] = NTL(unsigned, pr + C_CKV + 2 * C.lane);
                    i_uq[k] = NTL(u32x2, uq + 8 * j); i_q1[k] = NTL(unsigned short, uq + 64 + ax * 16 + i0); i_q2[k] = NTL(unsigned short, uq + 64 + ax * 16 + 8 + i0);
                    i_uk[k] = NTL(u32x2, uk + 8 * j); i_uv[k] = NTL(u32x2, uk + 64 + 8 * j);
                    i_k1[k] = NTL(unsigned, pr + C_KR + ax * 16 + i0); i_k2[k] = NTL(unsigned, pr + C_KR + ax * 16 + 8 + i0);
                    { const unsigned char* p8 = (const unsigned char*)pr; i_qb[k] = NTL(u32x2, p8 + PQ8 + h * 64 + 8 * j); i_kb[k] = NTL(u32x2, p8 + PK8 + (h & 1) * 64 + 8 * j); i_vb[k] = NTL(u32x2, p8 + PV8 + (C.lane & 15) * 8); }
#undef NTL
                    { const int n_ = (r < TC) ? 0 : ((r - TC) & 4095), pos = ax ? (n_ & 63) : (n_ >> 6);
                      t_a[k] = *(const f32x4*)(tabA + (pos * 8 + i0) * 2);
#pragma unroll
                      for (int q = 0; q < 4; ++q) t_b[k][q] = *(const f32x4*)(tabB + (pos * 16 + (j & 1) * 8 + 2 * q) * 2); } }
#pragma unroll
              for (int k = 0; k < 2; ++k) if (r0 + k < re) { const int r = r0 + k;
                const bool isctx = r < TC; const int b = isctx ? (r >> 8) : ((r - TC) >> 12); const int n = isctx ? (r & 255) : ((r - TC) & 4095);
                const int Lidx = isctx ? n : CTXL + n; const int prow = n >> 6, pcol = n & 63;
                const size_t krow = (size_t)b * LK + Lidx;
                float s1, s2;
                { const u32x2 a = i_cq[k]; const float a0 = bflo(a.x), a1 = bfhi(a.x), a2 = bflo(a.y), a3 = bfhi(a.y); s1 = (a0 * a0 + a1 * a1) + (a2 * a2 + a3 * a3);
                  const unsigned c = i_ckv[k]; const float c0 = bflo(c), c1 = bfhi(c); s2 = c0 * c0 + c1 * c1; }
                const float rs_cq = __builtin_amdgcn_rsqf(wave_sum(s1, C.lane) * (1.0f / 256.0f) + EPS), rs_ckv = __builtin_amdgcn_rsqf(wave_sum(s2, C.lane) * (1.0f / 128.0f) + EPS);
                { unsigned char* qa = QA8 + (size_t)r * 1024 + h * 128;
                  const u32x2 a = i_uq[k];
                  const f32x2 a0 = __builtin_amdgcn_cvt_pk_f32_fp8((int)a.x, false), a1 = __builtin_amdgcn_cvt_pk_f32_fp8((int)a.x, true), a2 = __builtin_amdgcn_cvt_pk_f32_fp8((int)a.y, false), a3 = __builtin_amdgcn_cvt_pk_f32_fp8((int)a.y, true);
                  const f32x2 y1 = __builtin_amdgcn_cvt_pk_f32_fp8((int)i_q1[k], false), y2 = __builtin_amdgcn_cvt_pk_f32_fp8((int)i_q2[k], false);
                  float v[8] = {a0[0], a0[1], a1[0], a1[1], a2[0], a2[1], a3[0], a3[1]}; float x1[2] = {y1[0], y1[1]}, x2[2] = {y2[0], y2[1]};
                  const float rsq_ = rs_cq * (1.0f / (float)(1 << FP8_AEXP));
                  float ss = 0.f;
#pragma unroll
                  for (int e = 0; e < 8; ++e) { v[e] *= rsq_; ss += v[e] * v[e]; }
#pragma unroll
                  for (int e = 0; e < 2; ++e) { x1[e] *= rsq_; x2[e] *= rsq_; ss += x1[e] * x1[e] + x2[e] * x2[e]; }
                  const float rn = SCA * __builtin_amdgcn_rsqf(sum8(ss, C.lane) * (1.0f / 96.0f) + EPS);
#pragma unroll
                  for (int e = 0; e < 8; ++e) v[e] *= rn * gqa_n[e];
                  float o1[2], o2[2];
#pragma unroll
                  for (int e = 0; e < 2; ++e) { const float a1 = x1[e] * rn * gqa_r[e], a2 = x2[e] * rn * gqa_r[2 + e];
                      if (isctx) { o1[e] = a1; o2[e] = a2; } else { const float cc_ = t_a[k][2 * e], ss_ = t_a[k][2 * e + 1]; o1[e] = a1 * cc_ - a2 * ss_; o2[e] = a1 * ss_ + a2 * cc_; } }
                  constexpr float qs = (float)(1 << att::QEXP);
                  u32x4 w; w.x = pk4_fp8(v[0] * qs, v[1] * qs, v[2] * qs, v[3] * qs); w.y = pk4_fp8(v[4] * qs, v[5] * qs, v[6] * qs, v[7] * qs); w.z = pk4_fp8(o1[0] * qs, o1[1] * qs, o2[0] * qs, o2[1] * qs); w.w = 0u;
                  *(u32x4*)(qa + 16 * j) = w; }
                { const u32x2 a = i_uk[k], vv = i_uv[k];
                  const unsigned x1w = i_k1[k], x2w = i_k2[k];
                  const f32x2 a0 = __builtin_amdgcn_cvt_pk_f32_fp8((int)a.x, false), a1 = __builtin_amdgcn_cvt_pk_f32_fp8((int)a.x, true), a2 = __builtin_amdgcn_cvt_pk_f32_fp8((int)a.y, false), a3 = __builtin_amdgcn_cvt_pk_f32_fp8((int)a.y, true);
                  float v[8] = {a0[0], a0[1], a1[0], a1[1], a2[0], a2[1], a3[0], a3[1]}; float x1[2] = {bflo(x1w), bfhi(x1w)}, x2[2] = {bflo(x2w), bfhi(x2w)};
                  const float rsk_ = rs_ckv * (1.0f / (float)(1 << FP8_AEXP));
                  float ss = 0.f;
#pragma unroll
                  for (int e = 0; e < 8; ++e) { v[e] *= rsk_; ss += v[e] * v[e]; }
#pragma unroll
                  for (int e = 0; e < 2; ++e) ss += x1[e] * x1[e] + x2[e] * x2[e];
                  const float rn = __builtin_amdgcn_rsqf(sum8(ss, C.lane) * (1.0f / 96.0f) + EPS);
#pragma unroll
                  for (int e = 0; e < 8; ++e) v[e] *= rn * gka_n[e];
                  float o1[2], o2[2];
#pragma unroll
                  for (int e = 0; e < 2; ++e) { const float a1 = x1[e] * rn * gka_r[e], a2 = x2[e] * rn * gka_r[2 + e];
                      if (isctx) { o1[e] = a1; o2[e] = a2; } else { const float cc_ = t_a[k][2 * e], ss_ = t_a[k][2 * e + 1]; o1[e] = a1 * cc_ - a2 * ss_; o2[e] = a1 * ss_ + a2 * cc_; } }
                  unsigned char* ka = KA + krow * 1024 + h * 128;
                  u32x4 w; w.x = pk4_fp8(v[0], v[1], v[2], v[3]); w.y = pk4_fp8(v[4], v[5], v[6], v[7]); w.z = pk4_fp8(o1[0], o1[1], o2[0], o2[1]); w.w = 0u;
                  *(u32x4*)(ka + 16 * j) = w;
                  const f32x2 q0 = __builtin_amdgcn_cvt_pk_f32_fp8((int)vv.x, false), q1 = __builtin_amdgcn_cvt_pk_f32_fp8((int)vv.x, true), q2 = __builtin_amdgcn_cvt_pk_f32_fp8((int)vv.y, false), q3 = __builtin_amdgcn_cvt_pk_f32_fp8((int)vv.y, true);
                  u32x4 wv; wv.x = pk2(q0[0] * rsk_, q0[1] * rsk_); wv.y = pk2(q1[0] * rsk_, q1[1] * rsk_); wv.z = pk2(q2[0] * rsk_, q2[1] * rsk_); wv.w = pk2(q3[0] * rsk_, q3[1] * rsk_);
                  *(u32x4*)(VA + krow * 512 + h * 64 + 8 * j) = wv; }
#pragma unroll
                for (int pass = 0; pass < 2; ++pass) {
                    const int hh = pass ? (h & 1) : h;
                    const u32x2 a = pass ? i_kb[k] : i_qb[k];
                    const f32x2 a0 = __builtin_amdgcn_cvt_pk_f32_fp8((int)a.x, false), a1 = __builtin_amdgcn_cvt_pk_f32_fp8((int)a.x, true), a2 = __builtin_amdgcn_cvt_pk_f32_fp8((int)a.y, false), a3 = __builtin_amdgcn_cvt_pk_f32_fp8((int)a.y, true);
                    constexpr float u8_ = 1.0f / (float)(1 << FP8_AEXP);
                    float v[8] = {a0[0] * u8_, a0[1] * u8_, a1[0] * u8_, a1[1] * u8_, a2[0] * u8_, a2[1] * u8_, a3[0] * u8_, a3[1] * u8_};
                    float ss = 0.f;
#pragma unroll
                    for (int e = 0; e < 8; ++e) ss += v[e] * v[e];
                    const float rn = (pass ? 1.0f : SCB) * __builtin_amdgcn_rsqf(sum8(ss, C.lane) * (1.0f / 64.0f) + EPS);
#pragma unroll
                    for (int e = 0; e < 8; ++e) v[e] *= rn * (pass ? gkb8[e] : gqb8[e]);
                    float o[8];
#pragma unroll
                    for (int e = 0; e < 8; ++e) { const float px = dppf<DPP_X2>(v[e]);
                        if (isctx) o[e] = v[e];
                        else { const float cc_ = t_b[k][e >> 1][2 * (e & 1)], ss_ = t_b[k][e >> 1][2 * (e & 1) + 1]; o[e] = (j & 2) ? (px * ss_ + v[e] * cc_) : (v[e] * cc_ - px * ss_); } }
                    const float qs = pass ? 1.0f : (float)(1 << att::QEXP);
                    u32x2 w; w.x = pk4_fp8(o[0] * qs, o[1] * qs, o[2] * qs, o[3] * qs); w.y = pk4_fp8(o[4] * qs, o[5] * qs, o[6] * qs, o[7] * qs);
                    if (!pass) *(u32x2*)(QB + (size_t)r * 512 + h * 64 + 8 * j) = w;
                    else if (C.lane < 16) *(u32x2*)(KB + krow * 128 + hh * 64 + 8 * j) = w;
                }
                if (C.lane >= 16 && C.lane < 32) { const u32x2 a = i_vb[k]; constexpr float u8_ = 1.0f / (float)(1 << FP8_AEXP);
                    const f32x2 a0 = __builtin_amdgcn_cvt_pk_f32_fp8((int)a.x, false), a1 = __builtin_amdgcn_cvt_pk_f32_fp8((int)a.x, true), a2 = __builtin_amdgcn_cvt_pk_f32_fp8((int)a.y, false), a3 = __builtin_amdgcn_cvt_pk_f32_fp8((int)a.y, true);
                    u32x4 wv; wv.x = pk2(a0[0] * u8_, a0[1] * u8_); wv.y = pk2(a1[0] * u8_, a1[1] * u8_); wv.z = pk2(a2[0] * u8_, a2[1] * u8_); wv.w = pk2(a3[0] * u8_, a3[1] * u8_);
                    *(u32x4*)(VB + krow * 128 + (C.lane - 16) * 8) = wv; }
              }
            }
          }
        }
        SEAM(P + 3);

        if (EN(5) && IN(P + 4)) {
#pragma unroll 1
          for (int rep = 0; rep < NREP(5); ++rep) {
            PH();
            const float* cb = (const float*)(ws + WS_MISC + MO_CB) + l * 2;
            const float negA = cb[0], negB = cb[1];
            unsigned char* O = (unsigned char*)R1;
            const int NU = 1024 + (lastl ? 0 : 64);
            for (int u = C.vcu; u < NU; u += C.G) {
                int kind, b, hd, NT; size_t r0;
                if (u < 1024) { const int i = u >> 8, v = u & 255, idx = 2 * v + (i >> 1); kind = i & 1; NT = LK / 64;
                    if (kind == 0) { const int bh = idx >> 4, qb = idx & 15; b = bh >> 3; hd = bh & 7; r0 = (size_t)TC + (size_t)b * SEQ + qb * 256 + C.wave * 32; }
                    else { const int bk = idx >> 6, jj = idx & 63, qb = jj >> 2, g = jj & 3; b = bk >> 1; hd = (bk & 1) * 4 + g; r0 = (size_t)TC + (size_t)b * SEQ + qb * 256 + C.wave * 32; } }
                else { const int w = u - 1024, bh = w & 31; kind = w >> 5; b = bh >> 3; hd = bh & 7; NT = CTXL / 64; r0 = (size_t)b * CTXL + C.wave * 32; }
                if (kind == 0) att::attn_unit<96>(QA8 + r0 * 1024 + hd * 128, 1024, KA + (size_t)b * LK * 1024 + hd * 128, 1024, VA + (size_t)b * LK * 512 + hd * 64, 512, O + r0 * DM + hd * 64, NT, negA, C.lds);
                else att::attn_unit<64>(QB + r0 * 512 + hd * 64, 512, KB + (size_t)b * LK * 128 + (hd >> 2) * 64, 128, VB + (size_t)b * LK * 128 + (hd >> 2) * 64, 128, O + r0 * DM + 512 + hd * 64, NT, negB, C.lds);
            }
            if (!lastl && C.vcu + 1024 >= NU) { __syncthreads();
                const int g0 = convert_steal(C, l, CONV_NQUEUE, 1); if (g0 < 1 && l + 1 < NLAYER) (void)convert_steal(C, l + 1, CONV_NQUEUE, 1); }
          }
        }
        SEAM(P + 4);

        if (EN(6) && IN(P + 5)) {
#pragma unroll 1
          for (int rep = 0; rep < NREP(6); ++rep) {
            PH();
            const int M = T - TC; const unsigned char* O = (const unsigned char*)R1 + (size_t)TC * DM;
            constexpr int SW = 0x01010101 * (127 - FP8_WEXP), SA = 0x01010101 * (127 - FP8_AEXP);
            pg8::StaticOrder S; S.init(M, DM, C.G, (int)blockIdx.x, DM / 2, DM / 2);
            pg8::EpiGateF E{(unsigned char*)YY + (size_t)TC * DM, (const unsigned char*)PROJ + (size_t)TC * PROW};
            pg8::gemm_phase<pg8::EpiGateF, pg8::StaticOrder, false, 1, true>(C.lds, (const bf16*)O, DM / 2, WB + WO_OA, DM / 2, S, E, gtab, SW, SA);
            if (mrow0 == 0) ctx_mini_gemm<true>(C, (const unsigned char*)R1, (const unsigned char*)(WB + WO_OA), SW, SA, (unsigned char*)YY, (const unsigned char*)PROJ, nullptr, nullptr, nullptr);
            if ((S.nwg + C.G - 1 - S.c) / C.G < (S.nwg + C.G - 1) / C.G) { const int g0 = convert_steal(C, l, CONV_NQUEUE, 4); if (g0 < 4 && l + 1 < NLAYER) (void)convert_steal(C, l + 1, CONV_NQUEUE, 4 - g0); }
          }
        }
        SEAM(P + 5);

        if (EN(7) && IN(P + 6)) {
#pragma unroll 1
          for (int rep = 0; rep < (NREP(7) > 1 && l == 0 ? 2 : 1); ++rep) {
            PH();
            const int M = T - TC;
            constexpr int SW = 0x01010101 * (127 - FP8_WEXP), SA = 0x01010101 * (127 - FP8_AEXP);
            pg8::StaticOrder S; S.init(M, DM, C.G, (int)blockIdx.x, DM / 2, DM / 2);
            pg8::EpiRes E{XS, modl, TC, 2};
            pg8::gemm_phase<pg8::EpiRes, pg8::StaticOrder, false, 1>(C.lds, (const bf16*)((const unsigned char*)YY + (size_t)TC * DM), DM / 2, WB + WO_OUT, DM / 2, S, E, gtab, SW, SA);
            if (mrow0 == 0) ctx_mini_gemm<false>(C, (const unsigned char*)YY, (const unsigned char*)(WB + WO_OUT), SW, SA, nullptr, nullptr, nullptr, XS, modl + (size_t)(4 * 6 + 2) * DM);
            if ((S.nwg + C.G - 1 - S.c) / C.G < (S.nwg + C.G - 1) / C.G) { const int g0 = convert_steal(C, l, CONV_NQUEUE, 4); if (g0 < 4 && l + 1 < NLAYER) (void)convert_steal(C, l + 1, CONV_NQUEUE, 4 - g0); }
          }
        }
        SEAM(P + 6);

        if (EN(8) && IN(P + 7)) {
#pragma unroll 1
          for (int rep = 0; rep < NREP(8); ++rep) {
            PH();
            const unsigned hq = queue_head_early(C, l);
            float mA[10], mB[10]; f32x4 gv[4];
            LAS float* wT = (LAS float*)C.lds;
            { const f32x4* wsrc = (const f32x4*)CIN(20); f32x4 wq[8];
#pragma unroll
              for (int q = 0; q < 8; ++q) wq[q] = wsrc[q * NTHR + C.tid];
#pragma unroll
              for (int q = 0; q < 10; ++q) { const int i = q * NTHR + C.tid, w = i >> 10, j = i & 1023; mA[q] = modl[(size_t)(w * 6 + 3) * DM + j]; mB[q] = modl[(size_t)(w * 6 + 4) * DM + j]; }
#pragma unroll
              for (int j = 0; j < 4; ++j) gv[j] = *(const f32x4*)(CIN(7) + l * DM + j * 256 + 4 * C.lane);
              sweep_late(C, l, CONV_NQUEUE, hq);
#pragma unroll
              for (int q = 0; q < 8; ++q) { const int i4 = q * NTHR + C.tid, d = i4 >> 2, e0 = (i4 & 3) * 4;
#pragma unroll
                  for (int k = 0; k < 4; ++k) wT[(e0 + k) * DM + d] = wq[q][k]; } }
            LAS int* lcnt = (LAS int*)(C.lds + 65536);
            LAS int* rt_row = lcnt + 32; LAS int* rt_e = rt_row + 256; LAS int* rt_lp = rt_e + 512; LAS float* rt_w = (LAS float*)(rt_lp + 512);
            if (C.tid < 32) lcnt[C.tid] = 0;
            __syncthreads();
            const float* brt = CIN(21);
            LAS float* mt = (LAS float*)(C.lds + 80 * 1024);
#pragma unroll
            for (int q = 0; q < 10; ++q) { const int i = q * NTHR + C.tid; mt[i] = mA[q]; mt[5 * DM + i] = mB[q]; }
            __syncthreads();
            unsigned* cnt = ctl + CW_CNT + l * 1024 + ((rep + 1 < NREP(8)) ? 2048 : 0);
            int* liste = (int*)(ws + WS_ROUTE + RO_LISTE); float* roww = (float*)(ws + WS_ROUTE + RO_ROWW); int* tokpos = (int*)(ws + WS_ROUTE + RO_TOKPOS);
            int rb, re; wave_rows(C.gw, C.NGW, mrow0, T, rb, re);
            const int lb3 = (C.lane >> 3) & 1, lb2 = (C.lane >> 2) & 1, lb1 = (C.lane >> 1) & 1, lb0 = C.lane & 1;
            const float brl = brt[C.lane & 15];
            for (int r0 = rb; r0 < re; r0 += 3) {
                f32x4 v[3][4], f[3][4];
#pragma unroll
                for (int k = 0; k < 3; ++k) { const int r = (r0 + k < re) ? r0 + k : re - 1; xs_load(XS + (size_t)r * DM, C.lane, v[k]); }
#pragma unroll
                for (int k = 0; k < 3; ++k) { const int r = (r0 + k < re) ? r0 + k : re - 1, which = (r < TC) ? 4 : ((r - TC) >> 12);
                    norm_mod_row(C, v[k], gv, mt + which * DM, mt + (5 + which) * DM, (unsigned char*)R1 + (size_t)r * DM, f[k]); }
                float a[3][16];
#pragma unroll
                for (int e = 0; e < 16; ++e) { f32x4 w[4];
#pragma unroll
                    for (int j = 0; j < 4; ++j) w[j] = *(const LAS f32x4*)(wT + e * DM + j * 256 + 4 * C.lane);
#pragma unroll
                    for (int k = 0; k < 3; ++k) { f32x4 a4 = f[k][0] * w[0];
#pragma unroll
                        for (int j = 1; j < 4; ++j) a4 = f[k][j] * w[j] + a4;
                        float t = (a4.x + a4.y) + (a4.z + a4.w);
                        asm volatile("" : "+v"(t)); a[k][e] = t; }
                    if (e & 1) __builtin_amdgcn_sched_barrier(0); }
#pragma unroll
                for (int k = 0; k < 3; ++k) {
                    float b8[8], b4[4], b2[2], b1;
#pragma unroll
                    for (int i = 0; i < 8; ++i) { const float snd = lb3 ? a[k][i] : a[k][i + 8], kp = lb3 ? a[k][i + 8] : a[k][i]; b8[i] = kp + dppf<DPP_RM>(snd); }
#pragma unroll
                    for (int i = 0; i < 4; ++i) { const float snd = lb2 ? b8[i] : b8[i + 4], kp = lb2 ? b8[i + 4] : b8[i]; b4[i] = kp + dppf<DPP_HM>(snd); }
#pragma unroll
                    for (int i = 0; i < 2; ++i) { const float snd = lb1 ? b4[i] : b4[i + 2], kp = lb1 ? b4[i + 2] : b4[i]; b2[i] = kp + dppf<DPP_X2>(snd); }
                    { const float snd = lb0 ? b2[0] : b2[1], kp = lb0 ? b2[1] : b2[0]; b1 = kp + dppf<DPP_X1>(snd); }
                    b1 += shx(b1, C.lane, 16); b1 += shx(b1, C.lane, 32);
                    const float scl = sigmoidf_(b1), sel = scl + brl;
                    const float x1 = dppf<DPP_X1>(sel), x2 = dppf<DPP_X2>(sel), x3 = dppf<0x1B>(sel);
                    const float gsum = fmaxf(fmaxf(fmaxf(sel + x1, sel + x2), fmaxf(sel + x3, x1 + x2)), fmaxf(x1 + x3, x2 + x3));
                    float best = rlane(gsum, 0); int bg = 0;
#pragma unroll
                    for (int g = 1; g < 4; ++g) { const float gs = rlane(gsum, 4 * g); if (gs > best) { best = gs; bg = g; } }
                    float m1 = -1e30f, m2 = -1e30f, w1 = 0.f, w2 = 0.f; int e1 = 0, e2 = 0;
#pragma unroll
                    for (int q = 0; q < 4; ++q) { const int e = 4 * bg + q; const float x = rlane(sel, e), sv = rlane(scl, e);
                        if (x > m1) { m2 = m1; e2 = e1; w2 = w1; m1 = x; e1 = e; w1 = sv; } else if (x > m2) { m2 = x; e2 = e; w2 = sv; } }
                    if (r0 + k < re && C.lane == 0) { const int r = r0 + k, slot = C.wave * 32 + (r - rb); const float inv = 1.0f / (w1 + w2);
                        const int lp1 = __hip_atomic_fetch_add(lcnt + e1, 1, __ATOMIC_RELAXED, __HIP_MEMORY_SCOPE_WORKGROUP), lp2 = __hip_atomic_fetch_add(lcnt + e2, 1, __ATOMIC_RELAXED, __HIP_MEMORY_SCOPE_WORKGROUP);
                        rt_row[slot] = r; rt_e[2 * slot] = e1; rt_e[2 * slot + 1] = e2; rt_lp[2 * slot] = lp1; rt_lp[2 * slot + 1] = lp2; rt_w[2 * slot] = w1 * inv; rt_w[2 * slot + 1] = w2 * inv; }
                }
            }
            __syncthreads();
            if (C.tid < 16) { const int n = lcnt[C.tid]; lcnt[16 + C.tid] = (n > 0) ? (int)__hip_atomic_fetch_add(cnt + 64 * C.tid, (unsigned)n, __ATOMIC_RELAXED, __HIP_MEMORY_SCOPE_AGENT) : 0; }
            __syncthreads();
            if (C.lane < re - rb) { const int slot = C.wave * 32 + C.lane, r = rt_row[slot];
#pragma unroll
                for (int q = 0; q < 2; ++q) { const int e = rt_e[2 * slot + q], p = lcnt[16 + e] + rt_lp[2 * slot + q];
                    liste[(size_t)e * T + p] = r; roww[(size_t)e * T + p] = rt_w[2 * slot + q]; tokpos[2 * r + q] = (e << 20) | p; } }
            __syncthreads();
          }
        }
        SEAM(P + 7);

        if (EN(9) && IN(P + 8)) {
#pragma unroll 1
          for (int rep = 0; rep < NREP(9); ++rep) {
            PH();
            expert_prefix(ctl + CW_CNT + l * 1024, mrow0, pfxl, C.tid);
            constexpr int SW = 0x01010101 * (127 - FP8_WEXP), SA0 = 0x7f7f7f7f;
            pg8::GroupedOrder S{pfxl, C.G, C.vcu, DM / 2, (size_t)1024 * 1024, 0};
            { const int* liste = (const int*)(ws + WS_ROUTE + RO_LISTE); const unsigned* cnt = ctl + CW_CNT + l * 1024; pg8::Unit u;
#pragma unroll 1
              for (int i = 0; i < 8 && S.next(i, u); ++i) if (C.tid < 256) { const int idx = u.lt * 256 + C.tid;
                  gtab[i * 256 + C.tid] = (u.e == 16) ? (mrow0 + idx) : ((idx < (int)cnt[64 * u.e]) ? liste[(size_t)u.e * T + idx] : mrow0); } }
            __syncthreads();
            pg8::EpiGlu E{HH};
            pg8::gemm_phase<pg8::EpiGlu, pg8::GroupedOrder, true, 2>(C.lds, R1, DM / 2, WB + WO_GU, DM / 2, S, E, gtab, SW, SA0, 1.0f / (float)(1 << (I8_AEXP + I8_WEXP)));
            if (l + 1 < NLAYER) { const int nu = 4 * __builtin_amdgcn_readfirstlane(pfxl[17]); if ((nu + C.G - 1 - C.vcu) / C.G < (nu + C.G - 1) / C.G) (void)convert_steal(C, l + 1, CONV_NQUEUE, 2); }
          }
        }
        SEAM(P + 8);

        if (EN(10) && IN(P + 9)) {
#pragma unroll 1
          for (int rep = 0; rep < NREP(10); ++rep) {
            PH();
            if (!IN(P + 8)) expert_prefix(ctl + CW_CNT + l * 1024, mrow0, pfxl, C.tid);
            constexpr int SW = 0x01010101 * (127 - FP8_WEXP), SA = 0x01010101 * (127 - FP8_AEXP);
            pg8::GroupedOrder S{pfxl, C.G, C.vcu, FF / 2, (size_t)1024 * 512, (size_t)256 * FF};
            pg8::EpiDown E{(unsigned char*)PROJ, (const float*)(ws + WS_ROUTE + RO_ROWW)};
            pg8::gemm_phase<pg8::EpiDown, pg8::GroupedOrder, false, 1>(C.lds, HH, FF / 2, WB + WO_DN, FF / 2, S, E, gtab, SW, SA);
            if (l + 1 < NLAYER) { const int nu = 4 * __builtin_amdgcn_readfirstlane(pfxl[17]); if ((nu + C.G - 1 - C.vcu) / C.G < (nu + C.G - 1) / C.G) (void)convert_steal(C, l + 1, CONV_NQUEUE, 2); }
          }
        }
        SEAM(P + 9);
    }

    if (EN(11) && IN(NPHASE - 1)) {
#pragma unroll 1
      for (int rep = 0; rep < NREP(11); ++rep) {
        const int l = NLAYER - 1; PH();
        if (!IN(NPHASE - 3)) expert_prefix(ctl + CW_CNT + (NLAYER - 1) * 1024, TC, pfxl, C.tid);
        LAS float* mt = (LAS float*)C.lds; mod_chunk_to_lds(mt, modl, 5, C.tid); __syncthreads();
        int rb, re; wave_rows(C.gw, C.NGW, TC, T, rb, re);
        constexpr int NB = 4;
        CombIdx cn[NB];
#pragma unroll
        for (int k = 0; k < NB; ++k) { const int r = (rb + k < re) ? rb + k : re - 1; cn[k] = comb_idx(C, r, pfxl, TC); }
        for (int r0 = rb; r0 < re; r0 += NB) {
            f32x4 v[NB][4]; unsigned y[NB][3][4]; CombIdx ci[NB];
#pragma unroll
            for (int k = 0; k < NB; ++k) { const int r = (r0 + k < re) ? r0 + k : re - 1; ci[k] = cn[k]; xs_load(XS + (size_t)r * DM, C.lane, v[k]); }
#pragma unroll
            for (int k = 0; k < NB; ++k) comb_load(C, ci[k], y[k]);
#pragma unroll
            for (int k = 0; k < NB; ++k) { const int r = (r0 + NB + k < re) ? r0 + NB + k : re - 1; cn[k] = comb_idx(C, r, pfxl, TC); }
#pragma unroll
            for (int k = 0; k < NB; ++k) if (r0 + k < re) { const int r = r0 + k, which = (r - TC) >> 12; comb_apply(C, mt + which * DM, y[k], v[k]); float* dst = COUT + (size_t)(r - TC) * DM;
#pragma unroll
                for (int j = 0; j < 4; ++j) *(f32x4*)(dst + j * 256 + 4 * C.lane) = v[k][j]; }
        }
      }
    }
#undef IN
#undef SEAM
}

#ifndef MK_PER_PHASE
#define MK_PER_PHASE 0
#endif
extern "C" void kernel_launch(void* const* d_in, const int* in_sizes, int n_in, void* d_out, int out_size, void* d_ws, size_t ws_size, hipStream_t stream) {
    static int grid = 0;
    if (grid == 0) {
        if (n_in != 28 || out_size != TL * DM || ws_size < WS_END) { fprintf(stderr, "kernel_launch: unexpected shapes (n_in %d, out %d, ws %zu)\n", n_in, out_size, ws_size); grid = -1; return; }
        int dev = 0, cus = 0, per_cu = 0;
        if (hipGetDevice(&dev) != hipSuccess || hipDeviceGetAttribute(&cus, hipDeviceAttributeMultiprocessorCount, dev) != hipSuccess) { grid = -1; return; }
        if (hipFuncSetAttribute((const void*)fwd_kernel, hipFuncAttributeMaxDynamicSharedMemorySize, LDS_BYTES) != hipSuccess) { fprintf(stderr, "kernel_launch: hipFuncSetAttribute failed\n"); grid = -1; return; }
        if (hipOccupancyMaxActiveBlocksPerMultiprocessor(&per_cu, (const void*)fwd_kernel, NTHR, LDS_BYTES) != hipSuccess || per_cu < 1) { fprintf(stderr, "kernel_launch: occupancy query says %d\n", per_cu); }
        (void)hipGetLastError();
        grid = cus;
    }
    if (grid < 0) return;
    (void)hipMemsetAsync((char*)d_ws + WS_CTL, 0, CTL_ZERO_BYTES, stream);
    Args a{};
    for (int i = 0; i < 28; ++i) a.in[i] = (const float*)d_in[i];
    a.out = (float*)d_out; a.ws = (unsigned char*)d_ws;
#if MK_PER_PHASE
    for (int p = 0; p < NPHASE; ++p) { a.ph_lo = p; a.ph_hi = p + 1; a.li = p; hipLaunchKernelGGL(fwd_kernel, dim3(grid), dim3(NTHR), LDS_BYTES, stream, a); }
#else
    a.ph_lo = 0; a.ph_hi = NPHASE; a.li = 0;
    hipLaunchKernelGGL(fwd_kernel, dim3(grid), dim3(NTHR), LDS_BYTES, stream, a);
#endif
}
```

```cpp
#define REPMASK 0x00
#define BARX 1
#include <hip/hip_runtime.h>
#ifdef MK_PER_PHASE
#define MK_PER_PHASE_ MK_PER_PHASE
#else
#define MK_PER_PHASE_ 0
#endif
#include <cstdio>
#include <cstdint>

#define GAS __attribute__((address_space(1)))
#define LAS __attribute__((address_space(3)))
typedef unsigned short bf16;
typedef short bf16x8 __attribute__((ext_vector_type(8)));
typedef short s16x4 __attribute__((ext_vector_type(4)));
typedef float f32x2 __attribute__((ext_vector_type(2)));
typedef float f32x4 __attribute__((ext_vector_type(4)));
typedef float f32x16 __attribute__((ext_vector_type(16)));
typedef unsigned u32x2 __attribute__((ext_vector_type(2)));
typedef unsigned u32x4 __attribute__((ext_vector_type(4)));

constexpr int DM = 1024, NB = 4, SEQ = 4096, CTXL = 256, NLAYER = 2;
constexpr int TC = NB * CTXL;
constexpr int TL = NB * SEQ;
constexpr int T = TC + TL;
constexpr int LK = CTXL + SEQ;
constexpr int INC = 3232, INCP = 3328;
constexpr int C_CQ = 0, C_CKV = 256, C_KR = 384, C_QB = 416, C_KB = 928, C_VB = 1056, C_GA = 1184, C_GB = 2208;
constexpr int PQ8 = 1024, PK8 = 1536, PV8 = 1664;
constexpr int PROW = INCP * 2, GA8 = 2560, GB8 = 3584;
constexpr int NEXP = 16, FF = 512;
constexpr float EPS = 1e-6f;
constexpr float LOG2E = 1.4426950408889634f;
constexpr float SCA = 0.10206207261596575f * LOG2E;
constexpr float SCB = 0.125f * LOG2E;
constexpr int NWAVES = 8, NTHR = 512;

constexpr size_t MiB = 1u << 20;
constexpr size_t WS_CTL = 0, CTL_ZERO_BYTES = (MK_PER_PHASE_ ? 1024 : 64) * 1024;
constexpr size_t WS_MISC = 1 * MiB;
constexpr size_t WS_CTXS = 2 * MiB;
constexpr size_t WS_ROUTE = 6 * MiB;
constexpr size_t WS_W = 9 * MiB;
constexpr size_t WS_R1 = 73 * MiB;
constexpr size_t WS_R2 = 107 * MiB;
constexpr size_t WS_R3 = 218 * MiB;
constexpr size_t WS_R4 = 286 * MiB;
constexpr size_t WS_R5 = 312 * MiB;
constexpr size_t WS_END = 346 * MiB;
constexpr size_t MO_MODV = 0;
constexpr size_t MO_TABA = 256 * 1024;
constexpr size_t MO_TABB = MO_TABA + 4096;
constexpr size_t MO_CB = MO_TABB + 8192;
constexpr size_t RO_LISTE = 0;
constexpr size_t RO_ROWW = (size_t)NEXP * T * 4;
constexpr size_t RO_TOKPOS = 2 * RO_ROWW;
constexpr size_t WO_IN = 0;
constexpr size_t WO_UQ = WO_IN + (size_t)INCP * 1024 / 2;
constexpr size_t WO_UKV = WO_UQ + 768 * 256;
constexpr size_t WO_OA = WO_UKV + 1024 * 256;
constexpr size_t WO_OUT = WO_OA + 1024 * 1024 / 2;
constexpr size_t WO_GU = WO_OUT + 1024 * 1024 / 2;
constexpr size_t WO_DN = WO_GU + (size_t)17 * 1024 * 1024 / 2;
constexpr size_t WO_END = WO_DN + (size_t)17 * 1024 * 512 / 2;
constexpr size_t WL_STRIDE = 16 * MiB;
static_assert(WO_END <= WL_STRIDE && WS_W + 2 * WL_STRIDE * 2 <= WS_R1, "weights region");
constexpr size_t R3_KA = 0, R3_VA = (size_t)T * 1024, R3_QB = R3_VA + (size_t)T * 512 * 2, R3_KB = R3_QB + (size_t)T * 512, R3_VB = R3_KB + (size_t)T * 128, R3_QA = R3_VB + (size_t)T * 128 * 2;
constexpr size_t R3_Y1 = 0, R3_Y = (size_t)T * 1024 * 2, R3_HH = 0;
constexpr int HHROWS = 3 * T + 17 * 256;
static_assert(R3_QA + (size_t)T * 1024 <= 68 * MiB && (size_t)HHROWS * 512 * 2 <= 68 * MiB && (size_t)HHROWS * 1024 * 2 <= 111 * MiB, "regions");
constexpr int CW_STEAL = 512;
constexpr int CW_CNT = 1024;
constexpr int CW_BAR = 4096;

constexpr int RING_BYTES = 131072;
constexpr int LDSX_OFF = RING_BYTES;
constexpr int LDSX_GTAB = LDSX_OFF;
constexpr int LDSX_PFX = LDSX_OFF + 8192;
constexpr int LDSX_MISC = LDSX_OFF + 8192 + 256;
constexpr int LDS_BYTES = 147456;

__device__ __forceinline__ unsigned f2bf(float f) { unsigned u = __builtin_bit_cast(unsigned, f); return (u + 0x7fffu + ((u >> 16) & 1u)) >> 16; }
typedef __bf16 bf16x2_hw __attribute__((ext_vector_type(2)));
__device__ __forceinline__ unsigned pk2(float lo, float hi) { const f32x2 v = {lo, hi}; return __builtin_bit_cast(unsigned, __builtin_convertvector(v, bf16x2_hw)); }
__device__ __forceinline__ unsigned pk4_fp8(float a, float b, float c, float d) { int w = 0; w = __builtin_amdgcn_cvt_pk_fp8_f32(a, b, w, false); w = __builtin_amdgcn_cvt_pk_fp8_f32(c, d, w, true); return (unsigned)w; }
constexpr int I8_AEXP = 4, I8_WEXP = 9;
__device__ __forceinline__ unsigned pk4_i8(float a, float b, float c, float d, float scl) {
    const float M = 12582912.0f;
    const unsigned qa = __builtin_bit_cast(unsigned, __builtin_amdgcn_fmed3f(a * scl, -127.f, 127.f) + M), qb = __builtin_bit_cast(unsigned, __builtin_amdgcn_fmed3f(b * scl, -127.f, 127.f) + M);
    const unsigned qc = __builtin_bit_cast(unsigned, __builtin_amdgcn_fmed3f(c * scl, -127.f, 127.f) + M), qd = __builtin_bit_cast(unsigned, __builtin_amdgcn_fmed3f(d * scl, -127.f, 127.f) + M);
    const unsigned lo = __builtin_amdgcn_perm(qb, qa, 0x0c0c0400u), hi = __builtin_amdgcn_perm(qd, qc, 0x0c0c0400u);
    return __builtin_amdgcn_perm(hi, lo, 0x05040100u);
}
__device__ __forceinline__ unsigned pk4_fp8_sat(float a, float b, float c, float d) {
    return pk4_fp8(__builtin_amdgcn_fmed3f(a, -448.f, 448.f), __builtin_amdgcn_fmed3f(b, -448.f, 448.f), __builtin_amdgcn_fmed3f(c, -448.f, 448.f), __builtin_amdgcn_fmed3f(d, -448.f, 448.f)); }
constexpr int FP8_WEXP = 5;
constexpr int FP8_AEXP = 3;
__device__ __forceinline__ float bflo(unsigned w) { return __builtin_bit_cast(float, w << 16); }
__device__ __forceinline__ float bfhi(unsigned w) { return __builtin_bit_cast(float, w & 0xffff0000u); }
template <int CTRL> __device__ __forceinline__ float dppf(float v) { return __builtin_bit_cast(float, __builtin_amdgcn_update_dpp(0, __builtin_bit_cast(int, v), CTRL, 0xF, 0xF, true)); }
#define DPP_X1 0xB1
#define DPP_X2 0x4E
#define DPP_HM 0x141
#define DPP_RM 0x140
__device__ __forceinline__ float rlane(float v, int l) { return __builtin_bit_cast(float, __builtin_amdgcn_readlane(__builtin_bit_cast(int, v), l)); }
__device__ __forceinline__ float row_sum16(float v) { v += dppf<DPP_X1>(v); v += dppf<DPP_X2>(v); v += dppf<DPP_HM>(v); v += dppf<DPP_RM>(v); return v; }
__device__ __forceinline__ float wave_sum(float v, int) { v = row_sum16(v); return (rlane(v, 0) + rlane(v, 16)) + (rlane(v, 32) + rlane(v, 48)); }
__device__ __forceinline__ float sum8(float v, int) { v += dppf<DPP_X1>(v); v += dppf<DPP_X2>(v); v += dppf<DPP_HM>(v); return v; }
__device__ __forceinline__ float shx(float v, int lane, int o) { return __builtin_bit_cast(float, __builtin_amdgcn_ds_bpermute((lane ^ o) << 2, __builtin_bit_cast(int, v))); }
__device__ __forceinline__ float sigmoidf_(float x) { return __builtin_amdgcn_rcpf(1.0f + __builtin_amdgcn_exp2f(-x * LOG2E)); }
__device__ __forceinline__ f32x4 sigmoid4(f32x4 x) {
    const f32x4 t = x * (-LOG2E); f32x4 e; e.x = __builtin_amdgcn_exp2f(t.x); e.y = __builtin_amdgcn_exp2f(t.y); e.z = __builtin_amdgcn_exp2f(t.z); e.w = __builtin_amdgcn_exp2f(t.w);
    const f32x4 d = e + 1.0f; f32x4 r; r.x = __builtin_amdgcn_rcpf(d.x); r.y = __builtin_amdgcn_rcpf(d.y); r.z = __builtin_amdgcn_rcpf(d.z); r.w = __builtin_amdgcn_rcpf(d.w); return r;
}
#define LDS_WAIT() asm volatile("s_waitcnt lgkmcnt(0)" ::: "memory")
#define VM_WAIT() asm volatile("s_waitcnt vmcnt(0)" ::: "memory")

namespace pg8 {
constexpr int BM = 256, BK = 64, HALF = 128, HTB = HALF * BK * 2, STAGE_BYTES = 8 * HTB, NXCD = 8, WGM = 8;
__device__ __forceinline__ int lds_byte(int r, int c) { const int st = (r >> 4) * 2 + (c >> 5), rr = r & 15, cc = c & 31, ob = rr * 64 + cc * 2; return st * 1024 + (ob ^ (((ob >> 9) & 1) << 5)); }
__device__ __forceinline__ void stage_rc(int b, int& R, int& C) { const int st = b / 1024, sb = b % 1024, swz = sb ^ (((sb >> 9) & 1) << 5); R = (st >> 1) * 16 + swz / 64; C = (st & 1) * 32 + (swz % 64) / 2; }
__device__ __forceinline__ int perm32(int rho) { const int n = rho >> 4, i = rho & 15; return 8 * (i >> 2) + 4 * n + (i & 3); }

struct Unit { int pm, pn, e, lt; };

struct StaticOrder {
    int nM, nN, nwg, G, c, lda, K;
    __device__ __forceinline__ void init(int M, int N, int G_, int c_, int lda_, int K_) { nM = M / BM; nN = N / BM; nwg = nM * nN; G = G_; c = c_; lda = lda_; K = K_; }
    __device__ __forceinline__ bool next(int i, Unit& u) const {
        const long L = (long)i * G + c; if (L >= nwg) return false;
        int wgid = (int)L; { const int q = nwg / NXCD, r = nwg % NXCD, xcd = wgid % NXCD, off = wgid / NXCD; wgid = (xcd < r ? xcd * (q + 1) : r * (q + 1) + (xcd - r) * q) + off; }
        const int nig = WGM * nN, gid = wgid / nig, fm = gid * WGM, gsz = (nM - fm) < WGM ? (nM - fm) : WGM;
        u.pm = fm + ((wgid % nig) % gsz); u.pn = (wgid % nig) / gsz; u.e = 0; u.lt = 0; return true;
    }
    __device__ __forceinline__ size_t a_off(const Unit& u) const { return (size_t)u.pm * BM * lda * 2; }
    __device__ __forceinline__ size_t b_off(const Unit& u) const { return (size_t)u.pn * BM * K * 2; }
};
struct GroupedOrder {
    const LAS int* pfx; int G, vcu, K; size_t estride;
    size_t a_stride;
    __device__ __forceinline__ bool next(int i, Unit& u) const {
        const int U = i * G + vcu, ntl = __builtin_amdgcn_readfirstlane(pfx[17]);
        if (U >= ntl * 4) return false;
        const int rt = U >> 2; int e = 0;
#pragma unroll
        for (int k = 1; k < 17; ++k) e += (rt >= __builtin_amdgcn_readfirstlane(pfx[k])) ? 1 : 0;
        u.pm = rt; u.pn = U & 3; u.e = e; u.lt = rt - __builtin_amdgcn_readfirstlane(pfx[e]); return true;
    }
    __device__ __forceinline__ size_t a_off(const Unit& u) const { return (size_t)u.pm * a_stride; }
    __device__ __forceinline__ size_t b_off(const Unit& u) const { return (size_t)u.e * estride + (size_t)u.pn * BM * K * 2; }
};

__device__ __forceinline__ unsigned cvt_pk_bf16(float lo, float hi) { unsigned r; asm volatile("v_cvt_pk_bf16_f32 %0, %1, %2" : "=v"(r) : "v"(lo), "v"(hi)); return r; }

#define OPAQ(x) asm volatile("" : "+v"(x))
struct EpiBf16 {
    static constexpr bool PERM = true, WIDE = false; static constexpr int NPRE = 0;
    bf16* O; int ldc;
    __device__ __forceinline__ void operator()(const f32x4 (&acc)[2][2][4][2], const Unit& u, int wr, int wc, int fr, int fq) const {
        char* base = (char*)(O + (size_t)u.pm * BM * ldc + u.pn * BM);
        unsigned off = (unsigned)((wr * 64 + fr) * ldc + wc * 32 + 8 * fq) * 2u; OPAQ(off);
#pragma unroll
        for (int ai = 0; ai < 2; ++ai)
#pragma unroll
          for (int m = 0; m < 4; ++m) {
#pragma unroll
            for (int bj = 0; bj < 2; ++bj) { const f32x4 v0 = acc[ai][bj][m][0], v1 = acc[ai][bj][m][1];
                u32x4 w; w.x = cvt_pk_bf16(v0[0], v0[1]); w.y = cvt_pk_bf16(v0[2], v0[3]); w.z = cvt_pk_bf16(v1[0], v1[1]); w.w = cvt_pk_bf16(v1[2], v1[3]);
                *(u32x4*)(base + off + bj * HALF * 2) = w; }
            off += (unsigned)((m == 3 ? 80 : 16) * ldc) * 2u; OPAQ(off); }
    }
};
struct EpiF8 {
    static constexpr bool PERM = true, WIDE = true; static constexpr int NPRE = 0;
    unsigned char* O; int ldc;
    __device__ __forceinline__ void operator()(const f32x4 (&acc)[2][2][4][2], const Unit& u, int wr, int wc, int fr, int fq) const {
        char* base = (char*)O + (size_t)u.pm * BM * ldc + u.pn * BM;
        unsigned off = (unsigned)((wr * 64 + fr) * ldc + wc * 64 + 16 * fq); OPAQ(off);
        constexpr float sa = (float)(1 << FP8_AEXP);
#pragma unroll
        for (int ai = 0; ai < 2; ++ai)
#pragma unroll
          for (int m = 0; m < 4; ++m) {
            const f32x4 v0 = acc[ai][0][m][0] * sa, v1 = acc[ai][0][m][1] * sa, v2 = acc[ai][1][m][0] * sa, v3 = acc[ai][1][m][1] * sa;
            u32x4 w; w.x = pk4_fp8_sat(v0[0], v0[1], v0[2], v0[3]); w.y = pk4_fp8_sat(v1[0], v1[1], v1[2], v1[3]); w.z = pk4_fp8_sat(v2[0], v2[1], v2[2], v2[3]); w.w = pk4_fp8_sat(v3[0], v3[1], v3[2], v3[3]);
            *(u32x4*)(base + off) = w;
            off += (unsigned)((m == 3 ? 80 : 16) * ldc); OPAQ(off); }
    }
};
struct EpiProj {
    static constexpr bool PERM = true, WIDE = false; static constexpr int NPRE = 0;
    bf16* O;
    __device__ __forceinline__ void operator()(const f32x4 (&acc)[2][2][4][2], const Unit& u, int wr, int wc, int fr, int fq) const {
        if (u.pn >= 2 && u.pn < 5) {
            char* base = (char*)O + (size_t)u.pm * BM * PROW + PQ8 + (u.pn - 2) * BM;
            unsigned off = (unsigned)((wr * 64 + fr) * PROW + wc * 32 + 8 * fq); OPAQ(off);
            constexpr float sa = (float)(1 << FP8_AEXP);
#pragma unroll
            for (int ai = 0; ai < 2; ++ai)
#pragma unroll
              for (int m = 0; m < 4; ++m) {
#pragma unroll
                for (int bj = 0; bj < 2; ++bj) { const f32x4 v0 = acc[ai][bj][m][0] * sa, v1 = acc[ai][bj][m][1] * sa;
                    u32x2 w; w.x = pk4_fp8_sat(v0[0], v0[1], v0[2], v0[3]); w.y = pk4_fp8_sat(v1[0], v1[1], v1[2], v1[3]);
                    *(u32x2*)(base + off + bj * HALF) = w; }
                off += (unsigned)((m == 3 ? 80 : 16) * PROW); OPAQ(off); }
        } else if (u.pn < 2) {
            char* base = (char*)(O + (size_t)u.pm * BM * INCP + u.pn * BM);
            unsigned off = (unsigned)((wr * 64 + fr) * INCP + wc * 32 + 8 * fq) * 2u; OPAQ(off);
#pragma unroll
            for (int ai = 0; ai < 2; ++ai)
#pragma unroll
              for (int m = 0; m < 4; ++m) {
#pragma unroll
                for (int bj = 0; bj < 2; ++bj) { const f32x4 v0 = acc[ai][bj][m][0], v1 = acc[ai][bj][m][1];
                    u32x4 w; w.x = cvt_pk_bf16(v0[0], v0[1]); w.y = cvt_pk_bf16(v0[2], v0[3]); w.z = cvt_pk_bf16(v1[0], v1[1]); w.w = cvt_pk_bf16(v1[2], v1[3]);
                    *(u32x4*)(base + off + bj * HALF * 2) = w; }
                off += (unsigned)((m == 3 ? 80 : 16) * INCP) * 2u; OPAQ(off); }
        } else {
            char* base = (char*)O + (size_t)u.pm * BM * PROW + GA8 + (u.pn - 5) * BM;
            unsigned off = (unsigned)((wr * 64 + fr) * PROW + wc * 32 + 8 * fq); OPAQ(off);
#pragma unroll
            for (int ai = 0; ai < 2; ++ai)
#pragma unroll
              for (int m = 0; m < 4; ++m) {
#pragma unroll
                for (int bj = 0; bj < 2; ++bj) { u32x2 w;
#pragma unroll
                    for (int n = 0; n < 2; ++n) { const f32x4 y = sigmoid4(acc[ai][bj][m][n]) * 255.0f + 0.5f;
                        const unsigned pk = (unsigned)y.x | ((unsigned)y.y << 8) | ((unsigned)y.z << 16) | ((unsigned)y.w << 24); if (n == 0) w.x = pk; else w.y = pk; }
                    *(u32x2*)(base + off + bj * HALF) = w; }
                off += (unsigned)((m == 3 ? 80 : 16) * PROW); OPAQ(off); }
        }
    }
};
template <bool SECOND> struct EpiGate {
    static constexpr bool PERM = true, WIDE = false; static constexpr int NPRE = 0;
    bf16* O; const bf16* Gt; const bf16* Y1;
    __device__ __forceinline__ void operator()(const f32x4 (&acc)[2][2][4][2], const Unit& u, int wr, int wc, int fr, int fq) const {
        char* obase = SECOND ? (char*)O + (size_t)u.pm * BM * DM + u.pn * BM : (char*)(O + (size_t)u.pm * BM * DM + u.pn * BM); const char* ybase = (const char*)(Y1 + (size_t)u.pm * BM * DM + u.pn * BM);
        const char* gbase = (const char*)(Gt + (size_t)u.pm * BM * INCP + u.pn * BM);
        unsigned off = (unsigned)((wr * 64 + fr) * DM + wc * 32 + 8 * fq) * 2u, goff = (unsigned)((wr * 64 + fr) * INCP + wc * 32 + 8 * fq) * 2u; OPAQ(off); OPAQ(goff);
#pragma unroll
        for (int ai = 0; ai < 2; ++ai)
#pragma unroll
          for (int m = 0; m < 4; ++m) {
#pragma unroll
            for (int bj = 0; bj < 2; ++bj) { const f32x4 v0 = acc[ai][bj][m][0], v1 = acc[ai][bj][m][1];
                const u32x4 g = *(const u32x4*)(gbase + goff + bj * HALF * 2);
                float r[8];
                r[0] = v0[0] * sigmoidf_(bflo(g.x)); r[1] = v0[1] * sigmoidf_(bfhi(g.x)); r[2] = v0[2] * sigmoidf_(bflo(g.y)); r[3] = v0[3] * sigmoidf_(bfhi(g.y));
                r[4] = v1[0] * sigmoidf_(bflo(g.z)); r[5] = v1[1] * sigmoidf_(bfhi(g.z)); r[6] = v1[2] * sigmoidf_(bflo(g.w)); r[7] = v1[3] * sigmoidf_(bfhi(g.w));
                if (SECOND) { const u32x4 y = *(const u32x4*)(ybase + off + bj * HALF * 2);
                    r[0] += bflo(y.x); r[1] += bfhi(y.x); r[2] += bflo(y.y); r[3] += bfhi(y.y); r[4] += bflo(y.z); r[5] += bfhi(y.z); r[6] += bflo(y.w); r[7] += bfhi(y.w); }
                if (SECOND) { constexpr float sa = (float)(1 << FP8_AEXP); u32x2 w; w.x = pk4_fp8(r[0] * sa, r[1] * sa, r[2] * sa, r[3] * sa); w.y = pk4_fp8(r[4] * sa, r[5] * sa, r[6] * sa, r[7] * sa);
                    *(u32x2*)(obase + (off >> 1) + bj * HALF) = w; }
                else { u32x4 w; w.x = cvt_pk_bf16(r[0], r[1]); w.y = cvt_pk_bf16(r[2], r[3]); w.z = cvt_pk_bf16(r[4], r[5]); w.w = cvt_pk_bf16(r[6], r[7]);
                    *(u32x4*)(obase + off + bj * HALF * 2) = w; } }
            off += (unsigned)((m == 3 ? 80 : 16) * DM) * 2u; goff += (unsigned)((m == 3 ? 80 : 16) * INCP) * 2u; OPAQ(off); OPAQ(goff); }
    }
};
struct EpiGateF {
    static constexpr bool PERM = true, WIDE = true; static constexpr int NPRE = 0;
    unsigned char* O; const unsigned char* G;
    __device__ __forceinline__ static float ub(unsigned w, int i) { return (float)((w >> (8 * i)) & 0xffu); }
    __device__ __forceinline__ void mid(f32x4 (&acc)[2][2][4][2], const Unit& u, int wr, int wc, int fr, int fq) const {
        const char* gbase = (const char*)G + (size_t)u.pm * BM * PROW + u.pn * BM;
        unsigned gl = (unsigned)((wr * 64 + fr) * PROW + wc * 64 + 16 * fq); OPAQ(gl);
        u32x4 ra[8], rb[8];
#pragma unroll
        for (int g = 0; g < 8; ++g) { ra[g] = *(const u32x4*)(gbase + GA8 + gl); rb[g] = *(const u32x4*)(gbase + GB8 + gl);
            gl += (unsigned)(((g & 3) == 3 ? 80 : 16) * PROW); OPAQ(gl); }
#pragma unroll
        for (int g = 0; g < 8; ++g) { const int ai = g >> 2, m = g & 3;
            const u32x4 a = ra[g], b = rb[g];
#pragma unroll
            for (int bj = 0; bj < 2; ++bj)
#pragma unroll
                for (int n = 0; n < 2; ++n) { const unsigned wa = a[2 * bj + n], wb = b[2 * bj + n];
#pragma unroll
                    for (int k = 0; k < 4; ++k) acc[ai][bj][m][n][k] *= ub(wa, k) * __builtin_amdgcn_rcpf(fmaxf(ub(wb, k), 1.0f)); } }
    }
    __device__ __forceinline__ void operator()(const f32x4 (&acc)[2][2][4][2], const Unit& u, int wr, int wc, int fr, int fq) const {
        char* obase = (char*)O + (size_t)u.pm * BM * DM + u.pn * BM; const char* gbase = (const char*)G + (size_t)u.pm * BM * PROW + GB8 + u.pn * BM;
        unsigned off = (unsigned)((wr * 64 + fr) * DM + wc * 64 + 16 * fq), gl = (unsigned)((wr * 64 + fr) * PROW + wc * 64 + 16 * fq); OPAQ(off); OPAQ(gl);
        constexpr float sa = (float)(1 << FP8_AEXP) / 255.0f;
        u32x4 rb[8];
#pragma unroll
        for (int g = 0; g < 8; ++g) { rb[g] = *(const u32x4*)(gbase + gl); gl += (unsigned)(((g & 3) == 3 ? 80 : 16) * PROW); OPAQ(gl); }
#pragma unroll
        for (int g = 0; g < 8; ++g) { const int ai = g >> 2, m = g & 3;
            const u32x4 b = rb[g]; u32x4 w4;
#pragma unroll
            for (int bj = 0; bj < 2; ++bj)
#pragma unroll
                for (int n = 0; n < 2; ++n) { const unsigned wb = b[2 * bj + n]; const f32x4 v = acc[ai][bj][m][n];
                    w4[2 * bj + n] = pk4_fp8_sat(v[0] * sa * fmaxf(ub(wb, 0), 1.0f), v[1] * sa * fmaxf(ub(wb, 1), 1.0f), v[2] * sa * fmaxf(ub(wb, 2), 1.0f), v[3] * sa * fmaxf(ub(wb, 3), 1.0f)); }
            *(u32x4*)(obase + off) = w4;
            off += (unsigned)((m == 3 ? 80 : 16) * DM); OPAQ(off); }
    }
};
struct EpiRes {
    static constexpr bool PERM = true, WIDE = false; static constexpr int NPRE = 0;
    bf16* xs; const float* gtv;
    int rowbase, gch;
    __device__ __forceinline__ void operator()(const f32x4 (&acc)[2][2][4][2], const Unit& u, int wr, int wc, int fr, int fq) const {
        const int lrow = rowbase + u.pm * BM;
        const int which = (lrow < TC) ? 4 : ((lrow - TC) >> 12);
        const char* gt = (const char*)(gtv + ((size_t)which * 6 + gch) * DM + u.pn * BM);
        char* ob = (char*)(xs + (size_t)lrow * DM + u.pn * BM);
        unsigned off = (unsigned)((wr * 64 + fr) * DM + wc * 32 + 8 * fq) * 2u; const unsigned goff = (unsigned)(wc * 32 + 8 * fq) * 4u; OPAQ(off);
        f32x4 gv[2][2];
#pragma unroll
        for (int bj = 0; bj < 2; ++bj)
#pragma unroll
            for (int n = 0; n < 2; ++n) gv[bj][n] = *(const f32x4*)(gt + goff + (bj * HALF + n * 4) * 4);
        u32x4 rr[8][2]; unsigned ol = off;
#pragma unroll
        for (int g = 0; g < 8; ++g) {
#pragma unroll
            for (int bj = 0; bj < 2; ++bj) rr[g][bj] = *(const u32x4*)(ob + ol + bj * HALF * 2);
            ol += (unsigned)(((g & 3) == 3 ? 80 : 16) * DM) * 2u; OPAQ(ol); }
#pragma unroll
        for (int g = 0; g < 8; ++g) { const int ai = g >> 2, m = g & 3;
#pragma unroll
            for (int bj = 0; bj < 2; ++bj) { const u32x4 w_ = rr[g][bj];
                const f32x4 c0 = (f32x4){bflo(w_.x), bfhi(w_.x), bflo(w_.y), bfhi(w_.y)}, c1 = (f32x4){bflo(w_.z), bfhi(w_.z), bflo(w_.w), bfhi(w_.w)};
                const f32x4 o0 = c0 + gv[bj][0] * acc[ai][bj][m][0], o1 = c1 + gv[bj][1] * acc[ai][bj][m][1];
                u32x4 w; w.x = cvt_pk_bf16(o0[0], o0[1]); w.y = cvt_pk_bf16(o0[2], o0[3]); w.z = cvt_pk_bf16(o1[0], o1[1]); w.w = cvt_pk_bf16(o1[2], o1[3]); *(u32x4*)(ob + off + bj * HALF * 2) = w; }
            off += (unsigned)((m == 3 ? 80 : 16) * DM) * 2u; OPAQ(off); }
    }
};
struct EpiGlu {
    static constexpr bool PERM = true, WIDE = false; static constexpr int NPRE = 0;
    bf16* HH;
    __device__ __forceinline__ void operator()(const f32x4 (&acc)[2][2][4][2], const Unit& u, int wr, int wc, int fr, int fq) const {
        char* base = (char*)HH + (size_t)u.pm * BM * FF + u.pn * HALF;
        unsigned off = (unsigned)((wr * 64 + fr) * FF + wc * 32 + 8 * fq); OPAQ(off);
#pragma unroll
        for (int ai = 0; ai < 2; ++ai)
#pragma unroll
          for (int m = 0; m < 4; ++m) {
            constexpr float sa = (float)(1 << FP8_AEXP);
            const f32x4 g0 = acc[ai][0][m][0], g1 = acc[ai][0][m][1];
            const f32x4 r0 = (g0 * sigmoid4(g0)) * (acc[ai][1][m][0] * sa), r1 = (g1 * sigmoid4(g1)) * (acc[ai][1][m][1] * sa);
            u32x2 w; w.x = pk4_fp8_sat(r0.x, r0.y, r0.z, r0.w); w.y = pk4_fp8_sat(r1.x, r1.y, r1.z, r1.w);
            *(u32x2*)(base + off) = w;
            off += (unsigned)((m == 3 ? 80 : 16) * FF); OPAQ(off); }
    }
};
struct EpiDown {
    static constexpr bool PERM = true, WIDE = true; static constexpr int NPRE = 1;
    unsigned char* YE; const float* roww;
    __device__ __forceinline__ void pre(const Unit& u, int wr, int wid, int lane, LAS unsigned char* lds) const {
        if (u.e == 16) return;
        const float* rw = roww + (size_t)(u.e & 15) * T + u.lt * BM + wr * 64 + lane;
        LAS unsigned* dst = (LAS unsigned*)(lds + LDSX_OFF + 12288) + wid * 128;
        __builtin_amdgcn_global_load_lds((const unsigned*)rw, dst, 4, 0, 0);
        __builtin_amdgcn_global_load_lds((const unsigned*)(rw + HALF), dst + 64, 4, 0, 0);
    }
    __device__ __forceinline__ void operator()(const f32x4 (&acc)[2][2][4][2], const Unit& u, int wr, int wc, int fr, int fq, int wid, LAS unsigned char* lds) const {
        char* base = (char*)YE + (size_t)u.pm * BM * DM + u.pn * BM;
        unsigned off = (unsigned)((wr * 64 + fr) * DM + wc * 64 + 16 * fq); OPAQ(off);
        const LAS float* wl = (const LAS float*)(lds + LDSX_OFF + 12288) + wid * 128 + fr;
        float wts[8];
        asm volatile("" ::: "memory");
#pragma unroll
        for (int g = 0; g < 8; ++g) wts[g] = (u.e == 16) ? 1.0f : *(const volatile LAS float*)(wl + (g >> 2) * 64 + (g & 3) * 16);
#pragma unroll
        for (int ai = 0; ai < 2; ++ai)
#pragma unroll
          for (int m = 0; m < 4; ++m) {
            const float wt = wts[ai * 4 + m] * (float)(1 << FP8_AEXP);
            { const f32x4 v0 = acc[ai][0][m][0] * wt, v1 = acc[ai][0][m][1] * wt, v2 = acc[ai][1][m][0] * wt, v3 = acc[ai][1][m][1] * wt;
                u32x4 w; w.x = pk4_fp8_sat(v0[0], v0[1], v0[2], v0[3]); w.y = pk4_fp8_sat(v1[0], v1[1], v1[2], v1[3]); w.z = pk4_fp8_sat(v2[0], v2[1], v2[2], v2[3]); w.w = pk4_fp8_sat(v3[0], v3[1], v3[2], v3[3]);
                *(u32x4*)(base + off) = w; }
            off += (unsigned)((m == 3 ? 80 : 16) * DM); OPAQ(off); }
    }
};

typedef int i32x4v __attribute__((ext_vector_type(4)));
typedef int i32x8v __attribute__((ext_vector_type(8)));
template <class Epi, class Sched, bool GATHER, int MODE = 0, bool MIDK = false>
__device__ __forceinline__ void gemm_phase(LAS unsigned char* lds, const bf16* A, int lda, const bf16* Bt, int K, const Sched& S, const Epi& E, const LAS int* gtab, int sclW = 0x7f7f7f7f, int sclA = 0x7f7f7f7f, float deq = 1.0f) {
    constexpr bool FP8 = (MODE == 1), I8 = (MODE == 2);
    int tid_ = threadIdx.x; asm volatile("" : "+v"(tid_));
    const int tid = tid_, wid = __builtin_amdgcn_readfirstlane(tid >> 6), lane = tid & 63, wr = wid >> 2, wc = wid & 3, fr = lane & 15, fq = lane >> 4;
    const int nt = K / BK;
    int RA[2], CA[2];
    unsigned voffA[2][2], voffB[2];
#pragma unroll
    for (int i = 0; i < 2; ++i) { int R, C; stage_rc(tid * 16 + i * 8192, R, C); const int Rb = Epi::WIDE ? (64 * (R >> 5) + 16 * ((R & 15) >> 2) + 4 * ((R >> 4) & 1) + (R & 3)) : (Epi::PERM ? ((R & ~31) + perm32(R & 31)) : R);
        RA[i] = R; CA[i] = C; voffB[i] = (unsigned)(Rb * K + C) * 2u;
        voffA[0][i] = (unsigned)(R * lda + C) * 2u; voffA[1][i] = 0u; }
    const size_t kstep = (size_t)(BK * 2);
    const size_t hstepB = Epi::WIDE ? (size_t)8 * K * 2 : (size_t)HALF * K * 2;
    const size_t hstepA = GATHER ? (size_t)0 : (size_t)HALF * lda * 2;
    const unsigned ldsw = (unsigned)wid * 1024u;
    const int aoff = lds_byte(wr * 64 + fr, fq * 8), boff = lds_byte(wc * 32 + fr, fq * 8);
#define PG8_SA(b, h) (((b) * 2 + (h)) * HTB)
#define PG8_SB(b, h) ((4 + (b) * 2 + (h)) * HTB)
#define PG8_STA(b, h, gbase) do { _Pragma("unroll") for (int _i = 0; _i < 2; ++_i) \
        __builtin_amdgcn_global_load_lds((const unsigned*)((const char*)(gbase) + (h) * hstepA + voffA[GATHER ? (h) : 0][_i]), (LAS unsigned*)(lds + PG8_SA(b, h) + ldsw + _i * 8192), 16, 0, 0); } while (0)
#define PG8_STB(b, h, gbase) do { _Pragma("unroll") for (int _i = 0; _i < 2; ++_i) \
        __builtin_amdgcn_global_load_lds((const unsigned*)((const char*)(gbase) + (h) * hstepB + voffB[_i]), (LAS unsigned*)(lds + PG8_SB(b, h) + ldsw + _i * 8192), 16, 0, 0); } while (0)
#define PG8_LDA(dst, b, h) do { _Pragma("unroll") for (int m = 0; m < 4; ++m) _Pragma("unroll") for (int k = 0; k < 2; ++k) dst[m][k] = *(const LAS bf16x8*)(lds + PG8_SA(b, h) + aoff + m * 2048 + k * 1024); } while (0)
#define PG8_LDB(dst, b, h) do { _Pragma("unroll") for (int n = 0; n < 2; ++n) _Pragma("unroll") for (int k = 0; k < 2; ++k) dst[n][k] = *(const LAS bf16x8*)(lds + PG8_SB(b, h) + boff + n * 2048 + k * 1024); } while (0)
#define PG8_CAT(x) __builtin_shufflevector(__builtin_bit_cast(i32x4v, x[0]), __builtin_bit_cast(i32x4v, x[1]), 0, 1, 2, 3, 4, 5, 6, 7)
#define PG8_MMA(ai, bj, At, Bt_) do { __builtin_amdgcn_s_setprio(1); _Pragma("unroll") for (int m = 0; m < 4; ++m) _Pragma("unroll") for (int n = 0; n < 2; ++n) { \
        if constexpr (FP8) { const i32x8v a8_ = PG8_CAT(Bt_[n]), b8_ = PG8_CAT(At[m]);   \
            asm volatile("v_mfma_scale_f32_16x16x128_f8f6f4 %0, %1, %2, %0, %3, %4 op_sel_hi:[0,0,0]" : "+v"(acc[ai][bj][m][n]) : "v"(a8_), "v"(b8_), "v"(sclW), "v"(sclA)); } \
        else if constexpr (I8) { _Pragma("unroll") for (int k = 0; k < 2; ++k) acc[ai][bj][m][n] = __builtin_bit_cast(f32x4, __builtin_amdgcn_mfma_i32_16x16x64_i8(__builtin_bit_cast(i32x4v, Bt_[n][k]), __builtin_bit_cast(i32x4v, At[m][k]), __builtin_bit_cast(i32x4v, acc[ai][bj][m][n]), 0, 0, 0)); } \
        else { _Pragma("unroll") for (int k = 0; k < 2; ++k) acc[ai][bj][m][n] = __builtin_amdgcn_mfma_f32_16x16x32_bf16(Bt_[n][k], At[m][k], acc[ai][bj][m][n], 0, 0, 0); } } \
        __builtin_amdgcn_s_setprio(0); } while (0)
#define PG8_WAIT_V(n) asm volatile("s_waitcnt vmcnt(" #n ")" ::: "memory")
#define PG8_WAIT_L(n) asm volatile("s_waitcnt lgkmcnt(" #n ")" ::: "memory")
#define PG8_BAR __builtin_amdgcn_s_barrier()
#define PG8_SCHED __builtin_amdgcn_sched_barrier(0)
#define PG8_GLOAD(ui_) do { _Pragma("unroll") for (int _h = 0; _h < 2; ++_h) _Pragma("unroll") for (int _i = 0; _i < 2; ++_i) \
        voffA[_h][_i] = (unsigned)(gtab[(ui_) * 256 + _h * HALF + RA[_i]] * lda + CA[_i]) * 2u; } while (0)
    Unit cur, nxt; int ui = 0;
    if (!S.next(0, cur)) return;
    f32x4 acc[2][2][4][2];
#pragma unroll
    for (int a = 0; a < 2; ++a)
#pragma unroll
        for (int b = 0; b < 2; ++b)
#pragma unroll
            for (int m = 0; m < 4; ++m)
#pragma unroll
                for (int n = 0; n < 2; ++n) acc[a][b][m][n] = (f32x4){0.f, 0.f, 0.f, 0.f};
    bf16x8 At[4][2], B0[2][2], B1[2][2];
    if constexpr (GATHER) { PG8_GLOAD(0); }
    const char* cA = (const char*)A + S.a_off(cur); const char* cB = (const char*)Bt + S.b_off(cur);
    PG8_STB(0, 0, cB); PG8_STB(0, 1, cB); PG8_STA(0, 0, cA); PG8_STA(0, 1, cA);
    if (wr == 1) PG8_BAR;
    PG8_WAIT_V(2); PG8_BAR;
    PG8_STB(1, 0, cB + kstep); PG8_STA(1, 0, cA + kstep); PG8_STB(1, 1, cB + kstep);
    PG8_WAIT_V(6); PG8_BAR;
    for (;;) {
        const bool has_next = S.next(ui + 1, nxt);
        const char* nA = has_next ? (const char*)A + S.a_off(nxt) : cA; const char* nB = has_next ? (const char*)Bt + S.b_off(nxt) : cB;
#pragma unroll 1
        for (int t = 0; t < nt; t += 2) {
            const bool last = (t == nt - 2);
            if constexpr (MIDK) { if (t == nt / 2) { if constexpr (FP8) asm volatile("s_nop 15\n\ts_nop 15\n\ts_nop 15\n\ts_nop 15" ::: "memory"); E.mid(acc, cur, wr, wc, fr, fq); } }
            if constexpr (Epi::NPRE > 0) { if (last) E.pre(cur, wr, wid, lane, lds); }
            const char* a1 = cA + (size_t)(t + 1) * kstep;
            const char* a2 = last ? nA : cA + (size_t)(t + 2) * kstep; const char* b2 = last ? nB : cB + (size_t)(t + 2) * kstep;
            const char* a3 = a2 + kstep; const char* b3 = b2 + kstep;
            PG8_LDB(B0, 0, 0); PG8_LDB(B1, 0, 1); PG8_SCHED; PG8_LDA(At, 0, 0); PG8_STA(1, 1, a1);
            if constexpr (GATHER) { if (last && has_next) { PG8_GLOAD(ui + 1); } }
            PG8_WAIT_V(8); PG8_WAIT_L(0); PG8_BAR; PG8_MMA(0, 0, At, B0); PG8_MMA(0, 1, At, B1); PG8_BAR; PG8_SCHED;
            PG8_LDA(At, 0, 1); PG8_STB(0, 0, b2); PG8_STB(0, 1, b2); PG8_STA(0, 0, a2);
            PG8_WAIT_V(8); PG8_WAIT_L(0); PG8_BAR; PG8_MMA(1, 0, At, B0); PG8_MMA(1, 1, At, B1); PG8_BAR; PG8_SCHED;
            PG8_LDB(B0, 1, 0); PG8_LDB(B1, 1, 1); PG8_SCHED; PG8_LDA(At, 1, 0); PG8_STA(0, 1, a2);
            PG8_WAIT_V(8); PG8_WAIT_L(0); PG8_BAR; PG8_MMA(0, 0, At, B0); PG8_MMA(0, 1, At, B1); PG8_BAR; PG8_SCHED;
            PG8_LDA(At, 1, 1); PG8_STB(1, 0, b3); PG8_STB(1, 1, b3); PG8_STA(1, 0, a3);
            PG8_WAIT_V(8); PG8_WAIT_L(0); PG8_BAR; PG8_MMA(1, 0, At, B0); PG8_MMA(1, 1, At, B1); PG8_BAR; PG8_SCHED;
        }
        if (wr == 0) PG8_BAR;
        if constexpr (FP8) asm volatile("s_nop 15\n\ts_nop 15\n\ts_nop 15\n\ts_nop 15" ::: "memory");
        if constexpr (I8) {
#pragma unroll
            for (int a = 0; a < 2; ++a)
#pragma unroll
                for (int b = 0; b < 2; ++b)
#pragma unroll
                    for (int m = 0; m < 4; ++m)
#pragma unroll
                        for (int n = 0; n < 2; ++n) { const i32x4v q = __builtin_bit_cast(i32x4v, acc[a][b][m][n]); acc[a][b][m][n] = (f32x4){(float)q[0] * deq, (float)q[1] * deq, (float)q[2] * deq, (float)q[3] * deq}; } }
        if constexpr (Epi::NPRE > 0) E(acc, cur, wr, wc, fr, fq, wid, lds); else E(acc, cur, wr, wc, fr, fq);
        if (!has_next) break;
#pragma unroll
        for (int a = 0; a < 2; ++a)
#pragma unroll
            for (int b = 0; b < 2; ++b)
#pragma unroll
                for (int m = 0; m < 4; ++m)
#pragma unroll
                    for (int n = 0; n < 2; ++n) acc[a][b][m][n] = (f32x4){0.f, 0.f, 0.f, 0.f};
        cur = nxt; cA = nA; cB = nB; ++ui;
        if (wr == 1) PG8_BAR;
    }
    PG8_WAIT_V(0);
    PG8_BAR;
#undef PG8_SA
#undef PG8_SB
#undef PG8_STA
#undef PG8_STB
#undef PG8_LDA
#undef PG8_LDB
#undef PG8_MMA
#undef PG8_CAT
#undef PG8_WAIT_V
#undef PG8_WAIT_L
#undef PG8_BAR
#undef PG8_SCHED
#undef PG8_GLOAD
}
}

namespace att {
constexpr int KSLOT = 8192, VSLOT = 8192, NSLOT = 3;
constexpr int L_K = 0, L_V = NSLOT * KSLOT, L_OST = L_V + NSLOT * VSLOT, L_BYTES = L_OST + NWAVES * 2048;
constexpr int QEXP = 3;
static_assert(L_BYTES <= RING_BYTES, "attention LDS");
#define SBAR() __builtin_amdgcn_sched_barrier(0)
typedef int i32x4a __attribute__((ext_vector_type(4)));
typedef int i32x8a __attribute__((ext_vector_type(8)));
__device__ __forceinline__ int crow(int r, int hi) { return (r & 3) + 8 * (r >> 2) + 4 * hi; }
__device__ __forceinline__ void glds16(const void* gsrc, unsigned lds_dst) { unsigned keep;
    asm volatile("s_mov_b32 %0, m0\n\ts_mov_b32 m0, %2\n\ts_nop 0\n\tglobal_load_lds_dwordx4 %1, off\n\ts_mov_b32 m0, %0" : "=&s"(keep) : "v"(gsrc), "s"(lds_dst) : "memory"); }
typedef float f32x2_t __attribute__((ext_vector_type(2))); typedef __bf16 bf16x2_t __attribute__((ext_vector_type(2)));
__device__ __forceinline__ unsigned cvtpk_s(float lo, float hi) { f32x2_t v = {lo, hi}; bf16x2_t b = __builtin_convertvector(v, bf16x2_t); return __builtin_bit_cast(unsigned, b); }
typedef __attribute__((address_space(3))) const char* lds_cptr;
typedef short v4i16_t __attribute__((ext_vector_type(4)));
__device__ __forceinline__ s16x4 vtr(lds_cptr p) { return __builtin_bit_cast(s16x4, __builtin_amdgcn_ds_read_tr16_b64_v4i16((LAS v4i16_t*)p)); }
__device__ __forceinline__ i32x8a kfrag(lds_cptr kp, int idx) {
    const i32x4a a = *(const LAS i32x4a*)(kp + (idx >> 1) * 4096 + (idx & 1) * 512), b = *(const LAS i32x4a*)(kp + (idx >> 1) * 4096 + (idx & 1) * 512 + 1024);
    return __builtin_shufflevector(a, b, 0, 1, 2, 3, 4, 5, 6, 7);
}
template <int DQK>
__device__ __forceinline__ void attn_unit(const unsigned char* Qw, int qpitch, const unsigned char* Kh, int kpitch, const bf16* Vh, int vpitch, unsigned char* Ow, int NT, float negc, LAS unsigned char* shm) {
    constexpr int NG = (DQK == 96) ? 2 : 1;
    int tid_ = threadIdx.x; asm volatile("" : "+v"(tid_));
    const int tid = tid_, lane = tid & 63, r32 = lane & 31, hi = lane >> 5; const int wid = __builtin_amdgcn_readfirstlane(tid >> 6);
    const unsigned lds0 = (unsigned)(uintptr_t)shm;
    i32x8a qr8[NG];
#pragma unroll
    for (int g = 0; g < NG; ++g) { const unsigned char* qp = Qw + (size_t)r32 * qpitch + g * 64 + hi * 32;
        const i32x4a a = *(const i32x4a*)qp, b = *(const i32x4a*)(qp + 16); qr8[g] = __builtin_shufflevector(a, b, 0, 1, 2, 3, 4, 5, 6, 7); }
    const bool kw = (NG == 2) || (wid < 4);
    const unsigned char* ksrc = Kh + (size_t)lane * kpitch + wid * 16;
    const bf16* vsrc = Vh + (size_t)(16 * (wid & 3) + (lane >> 2)) * vpitch + (wid >> 2) * 32 + (lane & 3) * 8;
    const unsigned kdst = lds0 + L_K + wid * 1024, vdst = lds0 + L_V + wid * 1024;
#define DMA_K(t, ks) do { if (kw) glds16(ksrc + (size_t)(t) * 64 * kpitch, (unsigned)__builtin_amdgcn_readfirstlane(kdst + (ks))); } while (0)
#define DMA_V(t, vs) glds16(vsrc + (size_t)(t) * 64 * vpitch, (unsigned)__builtin_amdgcn_readfirstlane(vdst + (vs)))
#define WAIT_BAR(NV, NK) do { if (kw) asm volatile("s_waitcnt vmcnt(%0) lgkmcnt(0)\n\ts_barrier" :: "n"((NV) + (NK)) : "memory"); \
                              else    asm volatile("s_waitcnt vmcnt(%0) lgkmcnt(0)\n\ts_barrier" :: "n"(NV) : "memory"); } while (0)
    DMA_K(0, 0); DMA_V(0, 0); DMA_K(1, KSLOT); DMA_K(2, 2 * KSLOT);
    f32x16 o[2]; o[0] = f32x16{}; o[1] = f32x16{}; f32x4 o2 = (f32x4){0.f, 0.f, 0.f, 0.f};
    f32x16 negm;
#pragma unroll
    for (int r = 0; r < 16; ++r) negm[r] = negc;
    if constexpr (NG == 1) asm volatile("" : "+v"(negm));
    int sclK = 0x7f7f7f7f, sclQ = 0x01010101 * (127 - QEXP); asm volatile("" : "+v"(sclK), "+v"(sclQ));
    const short ind1 = ((((lane & 15) == 0) && (((lane >> 4) & 1) == 0)) || (((lane & 15) == 1) && (((lane >> 4) & 1) == 1))) ? (short)0x3F80 : (short)0;
    const bf16x8 ones = (bf16x8){ind1, ind1, ind1, ind1, ind1, ind1, ind1, ind1};
#define MFSUM(a, c) __builtin_amdgcn_mfma_f32_16x16x32_bf16(a, ones, c, 0, 0, 0)
    const lds_cptr shm3 = (lds_cptr)shm; const lds_cptr kp0 = shm3 + L_K + (2 * hi) * 1024 + r32 * 16;
    const lds_cptr vp0 = shm3 + L_V + ((lane >> 4) & 1) * 32 + (lane & 3) * 8 + (4 * hi + ((lane & 15) >> 2)) * 64;
    f32x16 pA0, pA1, pB0, pB1; i32x8a kf[2 * NG];
    int kprev = 0, kcur = 0, knext = KSLOT, vprev = 0, vcur = 0, vnext = VSLOT;
#define ROT() do { kprev = kcur; kcur = knext; knext = (knext == 2 * KSLOT) ? 0 : knext + KSLOT; vprev = vcur; vcur = vnext; vnext = (vnext == 2 * VSLOT) ? 0 : vnext + VSLOT; } while (0)
#define MF32(a, b, c) __builtin_amdgcn_mfma_f32_32x32x16_bf16(a, b, c, 0, 0, 0)
#define QK_FIRST(D, A, B) do { if constexpr (NG == 1) D = __builtin_amdgcn_mfma_scale_f32_32x32x64_f8f6f4(A, B, negm, 0, 0, 0, sclK, 0, sclQ); \
                               else D = __builtin_amdgcn_mfma_scale_f32_32x32x64_f8f6f4(A, B, f32x16{}, 0, 0, 0, sclK, 0, sclQ); } while (0)
#define QK_ACC(D, A, B) D = __builtin_amdgcn_mfma_scale_f32_32x32x64_f8f6f4(A, B, D, 0, 0, 0, sclK, 0, sclQ)
#define QK_SETTLE(X, Y) do { PIN(X); PIN(Y); } while (0)
#define KEEP(x) asm volatile("" :: "v"(x))
    WAIT_BAR(1, 2);
#pragma unroll
    for (int i = 0; i < 2 * NG; ++i) kf[i] = kfrag(kp0, i);
    QK_FIRST(pA0, kf[0], qr8[0]); QK_FIRST(pA1, kf[1], qr8[0]);
    if constexpr (NG == 2) { QK_ACC(pA0, kf[2], qr8[1]); QK_ACC(pA1, kf[3], qr8[1]); }
#pragma unroll
    for (int r = 0; r < 16; ++r) { pA0[r] = __builtin_amdgcn_exp2f(pA0[r]); pA1[r] = __builtin_amdgcn_exp2f(pA1[r]); }
    WAIT_BAR(0, 0);
    DMA_K(3, 0); DMA_V(1, VSLOT);
    ROT();
#pragma unroll
    for (int i = 0; i < 2 * NG; ++i) kf[i] = kfrag(kp0 + kcur, i);
    WAIT_BAR(1, 1);
    s16x4 vlo[8], vhi[8]; u32x4 pw0, pw1, pw2, pw3;
#define PKW(P, B) cvtpk_s(P[B], P[B + 1])
#define PAF(k) __builtin_bit_cast(bf16x8, pw##k)
#define VFR(i) (bf16x8){vlo[i][0], vlo[i][1], vlo[i][2], vlo[i][3], vhi[i][0], vhi[i][1], vhi[i][2], vhi[i][3]}
#define PIN(x) asm volatile("" : "+v"(x))
#define EX(v) __builtin_amdgcn_exp2f(v)
#define VRD(i) do { vlo[i] = vtr(vp_ + (((i) >> 2) * 4096 + ((i) & 3) * 1024)); vhi[i] = vtr(vp_ + (((i) >> 2) * 4096 + ((i) & 3) * 1024 + 512)); } while (0)
#define PACK4(PW, P, B) do { PW[0] = PKW(P, B); PW[1] = PKW(P, (B) + 2); PW[2] = PKW(P, (B) + 4); PW[3] = PKW(P, (B) + 6); PIN(PW); } while (0)
#define KRD(G, i) do { if (G) { kf[i] = kfrag(kp0 + knext, i); SBAR(); } } while (0)
#define EXI(C0, C1, i) do { if ((i) < 16) C0[(i) & 15] = EX(C0[(i) & 15]); else C1[(i) & 15] = EX(C1[(i) & 15]); } while (0)
#define GAPB3(MF, C0, C1, I0) do { MF; EXI(C0, C1, I0); EXI(C0, C1, (I0) + 1); EXI(C0, C1, (I0) + 2); PIN(C0); PIN(C1); SBAR(); } while (0)
#define GAPB2(MF, C0, C1, I0) do { MF; EXI(C0, C1, I0); EXI(C0, C1, (I0) + 1); PIN(C0); PIN(C1); SBAR(); } while (0)
#define STEP(C0, C1, P0, P1, t, GK, GV, GL) do { SBAR(); \
    const lds_cptr vp_ = vp0 + vprev; \
      \
    VRD(0); VRD(4); SBAR(); \
    QK_FIRST(C0, kf[0], qr8[0]); PACK4(pw0, P0, 0); VRD(1); VRD(5); SBAR(); \
    QK_FIRST(C1, kf[1], qr8[0]); KEEP(kf[0]); PACK4(pw1, P0, 8); VRD(2); VRD(6); SBAR(); \
    if constexpr (NG == 2) { QK_ACC(C0, kf[2], qr8[1]); KEEP(kf[1]); PACK4(pw2, P1, 0); VRD(3); VRD(7); SBAR(); \
                             QK_ACC(C1, kf[3], qr8[1]); KEEP(kf[2]); PACK4(pw3, P1, 8); SBAR(); } \
    else { PACK4(pw2, P1, 0); VRD(3); VRD(7); PACK4(pw3, P1, 8); SBAR(); } \
    if (GK) { DMA_K((t) + 3, kcur); } if (GV) { DMA_V((t) + 1, vnext); } \
    QK_SETTLE(C0, C1); KEEP(kf[2 * NG - 1]); SBAR(); \
      \
    GAPB3(o[0] = MF32(PAF(0), VFR(0), o[0]), C0, C1, 0); \
    KRD(GL, 0); GAPB3(o[1] = MF32(PAF(0), VFR(4), o[1]), C0, C1, 3); \
    KRD(GL, 1); GAPB3(o2 = MFSUM(PAF(0), o2), C0, C1, 6); \
    KRD(GL && NG == 2, 2); GAPB3(o[0] = MF32(PAF(1), VFR(1), o[0]), C0, C1, 9); \
    KRD(GL && NG == 2, 3); GAPB3(o[1] = MF32(PAF(1), VFR(5), o[1]), C0, C1, 12); \
    GAPB3(o2 = MFSUM(PAF(1), o2), C0, C1, 15); \
    GAPB3(o[0] = MF32(PAF(2), VFR(2), o[0]), C0, C1, 18); \
    GAPB3(o[1] = MF32(PAF(2), VFR(6), o[1]), C0, C1, 21); \
    GAPB2(o2 = MFSUM(PAF(2), o2), C0, C1, 24); \
    GAPB2(o[0] = MF32(PAF(3), VFR(3), o[0]), C0, C1, 26); \
    GAPB2(o[1] = MF32(PAF(3), VFR(7), o[1]), C0, C1, 28); \
    GAPB2(o2 = MFSUM(PAF(3), o2), C0, C1, 30); \
    } while (0)
#define ENDW(tt) do { if ((tt) + 3 < NT) { WAIT_BAR(1, 1); } else if ((tt) + 2 < NT) { WAIT_BAR(1, 0); } else { WAIT_BAR(0, 0); } } while (0)
    int t = 1;
    for (; t + 5 < NT; t += 2) {
        STEP(pB0, pB1, pA0, pA1, t, true, true, true);     WAIT_BAR(1, 1); ROT();
        STEP(pA0, pA1, pB0, pB1, t + 1, true, true, true); WAIT_BAR(1, 1); ROT();
    }
    for (; t + 1 < NT; t += 2) {
        STEP(pB0, pB1, pA0, pA1, t, (t + 3 < NT), (t + 1 < NT), (t + 1 < NT));         ENDW(t);     ROT();
        STEP(pA0, pA1, pB0, pB1, t + 1, (t + 4 < NT), (t + 2 < NT), (t + 2 < NT));     ENDW(t + 1); ROT();
    }
    STEP(pB0, pB1, pA0, pA1, NT - 1, false, false, false);
    { PACK4(pw0, pB0, 0); PACK4(pw1, pB0, 8); PACK4(pw2, pB1, 0); PACK4(pw3, pB1, 8);
      const lds_cptr vp_ = vp0 + vcur;
      VRD(0); VRD(1); VRD(2); VRD(3); VRD(4); VRD(5); VRD(6); VRD(7);
      o[0] = MF32(PAF(0), VFR(0), o[0]); o[1] = MF32(PAF(0), VFR(4), o[1]); o2 = MFSUM(PAF(0), o2);
      o[0] = MF32(PAF(1), VFR(1), o[0]); o[1] = MF32(PAF(1), VFR(5), o[1]); o2 = MFSUM(PAF(1), o2);
      o[0] = MF32(PAF(2), VFR(2), o[0]); o[1] = MF32(PAF(2), VFR(6), o[1]); o2 = MFSUM(PAF(2), o2);
      o[0] = MF32(PAF(3), VFR(3), o[0]); o[1] = MF32(PAF(3), VFR(7), o[1]); o2 = MFSUM(PAF(3), o2); }
#undef DMA_K
#undef DMA_V
#undef WAIT_BAR
#undef ROT
#undef MF32
#undef MFSUM
#undef QK_FIRST
#undef QK_ACC
#undef QK_SETTLE
#undef KEEP
#undef PKW
#undef PAF
#undef VFR
#undef PIN
#undef EX
#undef VRD
#undef PACK4
#undef KRD
#undef EXI
#undef GAPB3
#undef GAPB2
#undef STEP
#undef ENDW
    { LAS unsigned char* stg = (LAS unsigned char*)(shm + L_OST) + wid * 2048;
      LAS float* lq = (LAS float*)stg;
      if ((lane & 15) < 2) { const int q0 = 16 * (lane & 15) + 4 * (lane >> 4);
#pragma unroll
          for (int k = 0; k < 4; ++k) lq[q0 + k] = o2[k]; }
      asm volatile("s_waitcnt lgkmcnt(0)" ::: "memory");
      float rl[16];
#pragma unroll
      for (int r = 0; r < 16; ++r) rl[r] = lq[crow(r, hi)];
      asm volatile("s_waitcnt lgkmcnt(0)" ::: "memory");
      constexpr float sa = (float)(1 << FP8_AEXP);
#pragma unroll
      for (int r = 0; r < 16; ++r) { const int orow = crow(r, hi); const float sc = __builtin_amdgcn_rcpf(rl[r]) * sa;
#pragma unroll
        for (int d0 = 0; d0 < 2; ++d0) stg[orow * 64 + d0 * 32 + r32] = (unsigned char)(pk4_fp8(__builtin_amdgcn_fmed3f(o[d0][r] * sc, -448.f, 448.f), 0.f, 0.f, 0.f) & 0xffu); }
      asm volatile("s_waitcnt lgkmcnt(0)" ::: "memory");
#pragma unroll
      for (int i = 0; i < 2; ++i) { const int row = i * 16 + (lane >> 2), ch = lane & 3; const u32x4 v = *(const LAS u32x4*)(stg + row * 64 + ch * 16); *(u32x4*)(Ow + (size_t)row * DM + ch * 16) = v; } }
    asm volatile("s_waitcnt lgkmcnt(0)\n\ts_barrier" ::: "memory");
}
#undef SBAR
}

#define XB_TMO      128
#define XB_XCNT(j)  (256  + 64 * (j))
#define XB_XSUB(j)  (1280 + 64 * (j))
#define XB_XGEN(j)  (2304 + 64 * (j))
#define XB_TOP      3328
#define XB_TOPGEN   3392
#define XCD_BAR_WORDS 3456
#define XB_SPIN_CAP (1u << 18)
__device__ __forceinline__ unsigned xb_ld(unsigned* p)              { return __hip_atomic_load(p, __ATOMIC_RELAXED, __HIP_MEMORY_SCOPE_AGENT); }
__device__ __forceinline__ unsigned xb_add(unsigned* p, unsigned v) { return __hip_atomic_fetch_add(p, v, __ATOMIC_RELAXED, __HIP_MEMORY_SCOPE_AGENT); }
__device__ __forceinline__ unsigned xb_xcc_id() { return (unsigned)__builtin_amdgcn_s_getreg((3 << 11) | 20) & 0xFu; }
#define XB_SPIN(cond, bar) do { unsigned _sp = 0; while (cond) { __builtin_amdgcn_s_sleep(1); \
    if ((++_sp & 255u) == 0u) { if (xb_ld(&(bar)[XB_TMO])) break; if (_sp > XB_SPIN_CAP) { atomicAdd(&(bar)[XB_TMO], 1u); break; } } } } while (0)
struct XcdBarrier { unsigned* bar; unsigned x; volatile LAS unsigned* st; };
__device__ __forceinline__ XcdBarrier xcd_barrier_post(unsigned* bar, volatile LAS unsigned* st) {
    XcdBarrier b; b.bar = bar; b.x = xb_xcc_id(); b.st = st;
    if (threadIdx.x == 0) (void)xb_add(&bar[XB_XCNT(b.x)], 1u);
    return b;
}
__device__ __forceinline__ void xcd_barrier_complete(unsigned* bar, unsigned x, unsigned& nloc, unsigned& nx) {
    const unsigned G = gridDim.x * gridDim.y * gridDim.z;
    unsigned sum, cnt, mine, sp = 0u;
    for (;;) {
        sum = 0u; cnt = 0u; mine = 0u;
#pragma unroll
        for (unsigned j = 0; j < 16; ++j) { const unsigned c = xb_ld(&bar[XB_XCNT(j)]); sum += c; cnt += (c > 0u) ? 1u : 0u; mine = (j == x) ? c : mine; }
        if (sum == G) break;
        __builtin_amdgcn_s_sleep(1);
        if ((++sp & 255u) == 0u) { if (xb_ld(&bar[XB_TMO])) break; if (sp > XB_SPIN_CAP) { atomicAdd(&bar[XB_TMO], 1u); break; } }
    }
    nloc = mine > 0u ? mine : 1u; nx = cnt > 0u ? cnt : 1u;
}
__device__ __forceinline__ void xcd_barrier(const XcdBarrier& b) {
    asm volatile("s_waitcnt vmcnt(0)" ::: "memory");
    __syncthreads();
    if (threadIdx.x == 0) {
        unsigned* bar = b.bar;
        __builtin_amdgcn_s_waitcnt(0);
        unsigned nloc = b.st[0], nx = b.st[1];
        if (nloc == 0u) { xcd_barrier_complete(bar, b.x, nloc, nx); b.st[0] = nloc; b.st[1] = nx; }
        const unsigned old = xb_add(&bar[XB_XSUB(b.x)], 1u);
        const unsigned gen = old / nloc;
        if (old + 1u == (gen + 1u) * nloc) {
            __builtin_amdgcn_fence(__ATOMIC_RELEASE, "agent");
            asm volatile("s_waitcnt vmcnt(0)" ::: "memory");
            const unsigned og = xb_add(&bar[XB_TOP], 1u);
            const unsigned tg = og / nx;
            if (og + 1u == (tg + 1u) * nx) xb_add(&bar[XB_TOPGEN], 1u);
            else XB_SPIN(xb_ld(&bar[XB_TOPGEN]) == tg, bar);
            __builtin_amdgcn_fence(__ATOMIC_ACQUIRE, "agent");
            xb_add(&bar[XB_XGEN(b.x)], 1u);
            asm volatile("s_waitcnt vmcnt(0)" ::: "memory");
        } else {
            XB_SPIN(xb_ld(&bar[XB_XGEN(b.x)]) == gen, bar);
            __builtin_amdgcn_fence(__ATOMIC_ACQUIRE, "agent");
            asm volatile("s_waitcnt vmcnt(0)" ::: "memory");
        }
    }
    __syncthreads();
}

struct Args { const float* in[28]; float* out; unsigned char* ws; int ph_lo, ph_hi, li, pad; };
typedef const __attribute__((address_space(4))) Args* ArgsP;
struct Ctx {
    LAS unsigned char* lds; int tid, lane, wave, vcu, G, gw, NGW;
    ArgsP ap;
};
#define CIN(k) (C.ap->in[k])
#define CWS (C.ap->ws)
#define COUT (C.ap->out)
template <bool MERGE>
__device__ __forceinline__ void ctx_mini_gemm(const Ctx& C, const unsigned char* A8, const unsigned char* W8, int sclW, int sclA,
                                              unsigned char* Y8, const unsigned char* G8, const float* xin, bf16* xs, const float* gt) {
    const int fr = C.lane & 15, fq = C.lane >> 4;
#pragma unroll 1
    for (int t = C.vcu; t < 256; t += C.G) {
        const int m = (t >> 4) * 64 + (C.wave & 3) * 16 + fr, n0 = (t & 15) * 64 + (C.wave >> 2) * 32;
        const unsigned char* ap = A8 + (size_t)m * DM + fq * 32;
        const unsigned char* bp = W8 + (size_t)(n0 + fr) * DM + fq * 32;
        const int nc = n0 + 4 * fq;
        unsigned ga[2], gb[2]; f32x4 xv[2], gv[2];
        if (MERGE) {
#pragma unroll
            for (int nb = 0; nb < 2; ++nb) { ga[nb] = *(const unsigned*)(G8 + (size_t)m * PROW + GA8 + nc + nb * 16); gb[nb] = *(const unsigned*)(G8 + (size_t)m * PROW + GB8 + nc + nb * 16); }
        } else {
#pragma unroll
            for (int nb = 0; nb < 2; ++nb) { const u32x2 w_ = *(const u32x2*)(xs + (size_t)m * DM + nc + nb * 16); xv[nb] = (f32x4){bflo(w_.x), bfhi(w_.x), bflo(w_.y), bfhi(w_.y)}; gv[nb] = *(const f32x4*)(gt + nc + nb * 16); }
        }
        f32x4 acc[2] = {(f32x4){0.f, 0.f, 0.f, 0.f}, (f32x4){0.f, 0.f, 0.f, 0.f}};
#pragma unroll
        for (int h = 0; h < 2; ++h) {
            u32x4 av[4][2], b0[4][2], b1[4][2];
#pragma unroll
            for (int k = 0; k < 4; ++k) { const int kb = (h * 4 + k) * 128;
                av[k][0] = *(const u32x4*)(ap + kb); av[k][1] = *(const u32x4*)(ap + kb + 16);
                b0[k][0] = *(const u32x4*)(bp + kb); b0[k][1] = *(const u32x4*)(bp + kb + 16);
                b1[k][0] = *(const u32x4*)(bp + 16 * DM + kb); b1[k][1] = *(const u32x4*)(bp + 16 * DM + kb + 16); }
#pragma unroll
            for (int k = 0; k < 4; ++k) {
                const pg8::i32x8v a8 = {(int)av[k][0].x, (int)av[k][0].y, (int)av[k][0].z, (int)av[k][0].w, (int)av[k][1].x, (int)av[k][1].y, (int)av[k][1].z, (int)av[k][1].w};
                const pg8::i32x8v w0 = {(int)b0[k][0].x, (int)b0[k][0].y, (int)b0[k][0].z, (int)b0[k][0].w, (int)b0[k][1].x, (int)b0[k][1].y, (int)b0[k][1].z, (int)b0[k][1].w};
                const pg8::i32x8v w1 = {(int)b1[k][0].x, (int)b1[k][0].y, (int)b1[k][0].z, (int)b1[k][0].w, (int)b1[k][1].x, (int)b1[k][1].y, (int)b1[k][1].z, (int)b1[k][1].w};
                acc[0] = __builtin_amdgcn_mfma_scale_f32_16x16x128_f8f6f4(w0, a8, acc[0], 0, 0, 0, sclW, 0, sclA);
                acc[1] = __builtin_amdgcn_mfma_scale_f32_16x16x128_f8f6f4(w1, a8, acc[1], 0, 0, 0, sclW, 0, sclA); }
            if (MERGE && h == 0) {
#pragma unroll
                for (int nb = 0; nb < 2; ++nb)
#pragma unroll
                    for (int k = 0; k < 4; ++k) acc[nb][k] *= pg8::EpiGateF::ub(ga[nb], k) * __builtin_amdgcn_rcpf(fmaxf(pg8::EpiGateF::ub(gb[nb], k), 1.0f));
            }
        }
        if (MERGE) { constexpr float sa = (float)(1 << FP8_AEXP) / 255.0f;
#pragma unroll
            for (int nb = 0; nb < 2; ++nb) { const f32x4 v = acc[nb]; const unsigned wb = gb[nb];
                *(unsigned*)(Y8 + (size_t)m * DM + nc + nb * 16) = pk4_fp8_sat(v[0] * sa * fmaxf(pg8::EpiGateF::ub(wb, 0), 1.0f), v[1] * sa * fmaxf(pg8::EpiGateF::ub(wb, 1), 1.0f), v[2] * sa * fmaxf(pg8::EpiGateF::ub(wb, 2), 1.0f), v[3] * sa * fmaxf(pg8::EpiGateF::ub(wb, 3), 1.0f)); }
        } else {
#pragma unroll
            for (int nb = 0; nb < 2; ++nb) { const f32x4 o = xv[nb] + gv[nb] * acc[nb];
                u32x2 w; w.x = pg8::cvt_pk_bf16(o[0], o[1]); w.y = pg8::cvt_pk_bf16(o[2], o[3]); *(u32x2*)(xs + (size_t)m * DM + nc + nb * 16) = w; }
        }
    }
}
__device__ __forceinline__ void transpose_item(const float* W, int N, bf16* WT, int ldo, int k0, int n0, int orow0, const float* gain, LAS float* scr, int lane) {
    float tv[32];
#pragma unroll
    for (int i = 0; i < 32; ++i) { const int kk = 2 * i + (lane >> 5); tv[i] = __builtin_nontemporal_load(W + (size_t)(k0 + kk) * N + n0 + (lane & 31)); }
#pragma unroll
    for (int i = 0; i < 32; ++i) { const int kk = 2 * i + (lane >> 5); float v = tv[i]; if (gain) v *= gain[k0 + kk]; scr[kk * 33 + (lane & 31)] = v; }
    LDS_WAIT(); asm volatile("" ::: "memory");
    const int c = lane & 7;
#pragma unroll
    for (int j = 0; j < 4; ++j) { const int n = (lane >> 3) + 8 * j; const LAS float* s = scr + (8 * c) * 33 + n;
        u32x4 o; o.x = pk2(s[0 * 33], s[1 * 33]); o.y = pk2(s[2 * 33], s[3 * 33]); o.z = pk2(s[4 * 33], s[5 * 33]); o.w = pk2(s[6 * 33], s[7 * 33]);
        *(GAS u32x4*)(WT + (size_t)(orow0 + n) * ldo + k0 + 8 * c) = o; }
    LDS_WAIT(); asm volatile("" ::: "memory");
}
template <bool I8>
__device__ __forceinline__ void transpose_item8(const float* W, int N, unsigned char* WT, int ldo, int k0, int n0, int orow0, float scl, LAS float* scr, int lane, int kdoff = 0) {
    float tv[32];
#pragma unroll
    for (int i = 0; i < 32; ++i) { const int kk = 2 * i + (lane >> 5); tv[i] = __builtin_nontemporal_load(W + (size_t)(k0 + kk) * N + n0 + (lane & 31)); }
#pragma unroll
    for (int i = 0; i < 32; ++i) { const int kk = 2 * i + (lane >> 5); scr[kk * 33 + (lane & 31)] = I8 ? tv[i] : tv[i] * scl; }
    LDS_WAIT(); asm volatile("" ::: "memory");
    const int c = lane & 7;
#pragma unroll
    for (int j = 0; j < 4; ++j) { const int n = (lane >> 3) + 8 * j; const LAS float* s = scr + (8 * c) * 33 + n;
        u32x2 o; if (I8) { o.x = pk4_i8(s[0 * 33], s[1 * 33], s[2 * 33], s[3 * 33], scl); o.y = pk4_i8(s[4 * 33], s[5 * 33], s[6 * 33], s[7 * 33], scl); }
        else { o.x = pk4_fp8(s[0 * 33], s[1 * 33], s[2 * 33], s[3 * 33]); o.y = pk4_fp8(s[4 * 33], s[5 * 33], s[6 * 33], s[7 * 33]); }
        *(GAS u32x2*)(WT + (size_t)(orow0 + n) * ldo + kdoff + k0 + 8 * c) = o; }
    LDS_WAIT(); asm volatile("" ::: "memory");
}
constexpr int CS_IN = 16 * 101, CS_UQ = 4 * 24, CS_UKV = 2 * 32, CS_OA = 8 * 32, CS_PAD = 96, CS_PAD2 = 0;
constexpr int CONV_NSTATIC = CS_IN + CS_UQ + CS_UKV + 2 * CS_OA + CS_PAD + CS_PAD2;
constexpr int CQ_OUT = 16 * 32, CQ_G = 16 * 16, CQ_D = 8 * 32;
constexpr int CONV_NQUEUE = CQ_OUT + 17 * 2 * CQ_G + 17 * CQ_D;
__device__ __forceinline__ void convert_static_item(const Ctx& C, int l, int it, LAS float* scr) {
    bf16* WB = (bf16*)(CWS + WS_W) + (size_t)l * WL_STRIDE;
    constexpr float WS8 = (float)(1 << FP8_WEXP), WI8 = (float)(1 << I8_WEXP);
    int r = it;
    if (r < CS_IN) { const int kb = r / 101, nb = r % 101; transpose_item8<true>(CIN(8) + (size_t)l * DM * INC, INC, (unsigned char*)(WB + WO_IN), 1024, 64 * kb, 32 * nb, (32 * nb < C_QB) ? 32 * nb : 32 * nb + 96, WI8, scr, C.lane); return; } r -= CS_IN;
    if (r < CS_UQ) { const int kb = r / 24, nb = r % 24; transpose_item(CIN(10) + (size_t)l * 256 * 768, 768, WB + WO_UQ, 256, 64 * kb, 32 * nb, 32 * nb, CIN(9) + l * 256, scr, C.lane); return; } r -= CS_UQ;
    if (r < CS_UKV) { const int kb = r / 32, nb = r % 32; transpose_item(CIN(12) + (size_t)l * 128 * 1024, 1024, WB + WO_UKV, 128, 64 * kb, 32 * nb, 32 * nb, CIN(11) + l * 128, scr, C.lane); return; } r -= CS_UKV;
    if (r < CS_OA) { const int kb = r / 32, nb = r % 32; transpose_item8<false>(CIN(17) + (size_t)l * 512 * DM, 1024, (unsigned char*)(WB + WO_OA), 1024, 64 * kb, 32 * nb, 32 * nb, WS8, scr, C.lane, 0); return; } r -= CS_OA;
    if (r < CS_OA) { const int kb = r / 32, nb = r % 32; transpose_item8<false>(CIN(18) + (size_t)l * 512 * DM, 1024, (unsigned char*)(WB + WO_OA), 1024, 64 * kb, 32 * nb, 32 * nb, WS8, scr, C.lane, 512); return; } r -= CS_OA;
    u32x4 zz = (u32x4){0u, 0u, 0u, 0u}; asm volatile("" : "+v"(zz));
    if (r < CS_PAD) { unsigned char* p = (unsigned char*)(WB + WO_IN) + (size_t)(C_QB + r) * 1024;
      *(GAS u32x4*)(p + C.lane * 16) = zz; return; } r -= CS_PAD;
    { const int row = r * 4 + (C.lane >> 4), ch = C.lane & 15;
      *(GAS u32x4*)(WB + WO_UKV + (size_t)row * 256 + 128 + ch * 8) = zz; }
}
__device__ __forceinline__ void convert_queue_item(const Ctx& C, int l, int it, LAS float* scr) {
    bf16* WB = (bf16*)(CWS + WS_W) + (size_t)l * WL_STRIDE;
    constexpr float WS8 = (float)(1 << FP8_WEXP), WI8 = (float)(1 << I8_WEXP);
    int r = it;
    if (r < CQ_OUT) { const int kb = r / 32, nb = r % 32; transpose_item8<false>(CIN(19) + (size_t)l * DM * DM, 1024, (unsigned char*)(WB + WO_OUT), 1024, 64 * kb, 32 * nb, 32 * nb, WS8, scr, C.lane); return; } r -= CQ_OUT;
    if (r < 17 * 2 * CQ_G) { const int e = r / (2 * CQ_G), q = r % (2 * CQ_G), up = q / CQ_G, sx = q % CQ_G, kb = sx / 16, nb = sx % 16;
        const float* src = (e < 16) ? ((up ? CIN(23) : CIN(22)) + ((size_t)l * NEXP + e) * DM * FF) : ((up ? CIN(26) : CIN(25)) + (size_t)l * DM * FF);
        const int n0 = 32 * nb, orow = (n0 >> 7) * 256 + up * 128 + (n0 & 127);
        transpose_item8<true>(src, FF, (unsigned char*)(WB + WO_GU) + (size_t)e * 1024 * 1024, 1024, 64 * kb, n0, orow, WI8, scr, C.lane); return; } r -= 17 * 2 * CQ_G;
    { const int e = r / CQ_D, sx = r % CQ_D, kb = sx / 32, nb = sx % 32;
        const float* src = (e < 16) ? (CIN(24) + ((size_t)l * NEXP + e) * FF * DM) : (CIN(27) + (size_t)l * FF * DM);
        transpose_item8<false>(src, 1024, (unsigned char*)(WB + WO_DN) + (size_t)e * 1024 * 512, 512, 64 * kb, 32 * nb, 32 * nb, WS8, scr, C.lane); }
}
__device__ __forceinline__ void convert_static(const Ctx& C, int l, int gw, int ngw) {
    LAS float* scr = (LAS float*)(C.lds + C.wave * 12288);
    for (int it = gw; it < CONV_NSTATIC; it += ngw) convert_static_item(C, l, it, scr);
}
__device__ __forceinline__ int convert_steal(const Ctx& C, int l, int limit, int max_grabs, bool precheck = false) {
    LAS float* scr = (LAS float*)(C.lds + C.wave * 12288);
    LAS int* sb = (LAS int*)(C.lds + LDSX_PFX + 128);
    unsigned* head = (unsigned*)(CWS + WS_CTL) + CW_STEAL + 64 * l;
    int g = 0;
    if (precheck) {
        __syncthreads();
        if (C.tid == 0) *sb = (int)__hip_atomic_load(head, __ATOMIC_RELAXED, __HIP_MEMORY_SCOPE_AGENT);
        __syncthreads();
        const int h0 = __builtin_amdgcn_readfirstlane(*sb);
        __syncthreads();
        if (h0 >= limit) return 0;
    }
    for (; g < max_grabs; ++g) {
        __syncthreads();
        if (C.tid == 0) *sb = (int)__hip_atomic_fetch_add(head, 16u, __ATOMIC_RELAXED, __HIP_MEMORY_SCOPE_AGENT);
        __syncthreads();
        const int base = __builtin_amdgcn_readfirstlane(*sb);
        if (base >= CONV_NQUEUE) break;
#pragma unroll 1
        for (int k = 0; k < 2; ++k) { const int it = base + C.wave * 2 + k; if (it < CONV_NQUEUE) convert_queue_item(C, l, it, scr); }
        if (base + 16 >= limit) { ++g; break; }
    }
    __syncthreads();
    return g;
}
__device__ __forceinline__ unsigned queue_head_early(const Ctx& C, int l) {
    unsigned h = 0u; if (C.tid == 0) h = __hip_atomic_load((unsigned*)(CWS + WS_CTL) + CW_STEAL + 64 * l, __ATOMIC_RELAXED, __HIP_MEMORY_SCOPE_AGENT); return h; }
__device__ __forceinline__ void sweep_late(const Ctx& C, int l, int limit, unsigned hq) {
    LAS int* sb = (LAS int*)(C.lds + LDSX_PFX + 128);
    __syncthreads();
    if (C.tid == 0) *sb = (int)hq;
    __syncthreads();
    const int h0 = __builtin_amdgcn_readfirstlane(*sb);
    __syncthreads();
    if (h0 < limit) (void)convert_steal(C, l, limit, 1 << 20);
}
__device__ __forceinline__ void mod_gemv(const Ctx& C, int unit) {
    const int l = unit / 24, jb = unit % 24, j = jb * 256 + 4 * C.lane;
    const float* wm = CIN(4) + (size_t)l * DM * 6144 + j; const float* cc = CIN(1); const float* cx = CIN(3);
    f32x4 acc[5];
#pragma unroll
    for (int w = 0; w < 5; ++w) acc[w] = (f32x4){0.f, 0.f, 0.f, 0.f};
#pragma unroll
    for (int dc = 0; dc < 2; ++dc) { const int d0 = C.wave * 128 + dc * 64;
        float s[5];
#pragma unroll
        for (int w = 0; w < 5; ++w) { const float v = (w < 4) ? cc[w * DM + d0 + C.lane] : cx[d0 + C.lane]; s[w] = v * sigmoidf_(v); }
#pragma unroll
        for (int db = 0; db < 64; db += 16) { f32x4 wv[16];
#pragma unroll
            for (int dd = 0; dd < 16; ++dd) wv[dd] = __builtin_nontemporal_load((const f32x4*)(wm + (size_t)(d0 + db + dd) * 6144));
#pragma unroll
            for (int dd = 0; dd < 16; ++dd) asm volatile("" : "+v"(wv[dd]));
#pragma unroll
            for (int dd = 0; dd < 16; ++dd)
#pragma unroll
                for (int w = 0; w < 5; ++w) acc[w] = acc[w] + wv[dd] * rlane(s[w], db + dd); } }
    LAS f32x4* part = (LAS f32x4*)C.lds;
#pragma unroll
    for (int w = 0; w < 5; ++w) part[(C.wave * 5 + w) * 64 + C.lane] = acc[w];
    __syncthreads();
    if (C.wave < 5) { f32x4 t = (f32x4){0.f, 0.f, 0.f, 0.f};
#pragma unroll
        for (int k = 0; k < 8; ++k) t = t + part[(k * 5 + C.wave) * 64 + C.lane];
        float* mv = (float*)(CWS + WS_MISC + MO_MODV) + (size_t)l * 5 * 6144; *(f32x4*)(mv + C.wave * 6144 + j) = t + *(const f32x4*)(CIN(5) + l * 6144 + j); }
    __syncthreads();
}
__device__ __forceinline__ void make_tables(const Ctx& C) {
    float* ta = (float*)(CWS + WS_MISC + MO_TABA); float* tb = (float*)(CWS + WS_MISC + MO_TABB);
    for (int i = C.lane; i < 64 * 8; i += 64) { const int pos = i >> 3, f = i & 7; const float inv = exp2f(-13.287712379549449f * (float)(2 * f) / 16.0f); const float a = (float)pos * inv; ta[2 * i] = cosf(a); ta[2 * i + 1] = sinf(a); }
    for (int i = C.lane; i < 64 * 16; i += 64) { const int pos = i >> 4, f = i & 15; const float inv = exp2f(-13.287712379549449f * (float)(2 * f) / 32.0f); const float a = (float)pos * inv; tb[2 * i] = cosf(a); tb[2 * i + 1] = sinf(a); }
    float* cb = (float*)(CWS + WS_MISC + MO_CB);
    for (int l = 0; l < NLAYER; ++l) {
        float ma = 0.f, mb = 0.f, mc = 0.f, md = 0.f;
        for (int i = C.lane; i < 96; i += 64) { ma = fmaxf(ma, fabsf(CIN(13)[l * 96 + i])); mb = fmaxf(mb, fabsf(CIN(14)[l * 96 + i])); }
        { const int i = C.lane; mc = fabsf(CIN(15)[l * 64 + i]); md = fabsf(CIN(16)[l * 64 + i]); }
#pragma unroll
        for (int o = 1; o < 64; o <<= 1) { ma = fmaxf(ma, shx(ma, C.lane, o)); mb = fmaxf(mb, shx(mb, C.lane, o)); mc = fmaxf(mc, shx(mc, C.lane, o)); md = fmaxf(md, shx(md, C.lane, o)); }
        if (C.lane == 0) { cb[l * 2 + 0] = -(SCA * 96.0f * ma * mb * 1.02f + 0.5f); cb[l * 2 + 1] = -(SCB * 64.0f * mc * md * 1.02f + 0.5f); }
    }
}
__device__ __forceinline__ const float* stream_in(const Ctx& C, int l, int r) { return (r < TC) ? CIN(2) + (size_t)r * DM : CIN(0) + (size_t)(r - TC) * DM; }
__device__ __forceinline__ void xs_load(const bf16* row, int lane, f32x4 (&v)[4]) {
#pragma unroll
    for (int j = 0; j < 4; ++j) { const u32x2 w = *(const u32x2*)(row + j * 256 + 4 * lane); v[j] = (f32x4){bflo(w.x), bfhi(w.x), bflo(w.y), bfhi(w.y)}; }
}
__device__ __forceinline__ void xs_store(bf16* row, int lane, const f32x4 (&v)[4]) {
#pragma unroll
    for (int j = 0; j < 4; ++j) { u32x2 w; w.x = pk2(v[j].x, v[j].y); w.y = pk2(v[j].z, v[j].w); *(u32x2*)(row + j * 256 + 4 * lane) = w; }
}
__device__ __forceinline__ void expert_prefix(const unsigned* cnt, int srow0, LAS int* pfx, int tid) {
    if (tid == 0) { int s = 0;
#pragma unroll
        for (int e = 0; e < 16; ++e) { pfx[e] = s; s += ((int)cnt[64 * e] + 255) >> 8; }
        pfx[16] = s; s += (T - srow0) >> 8; pfx[17] = s; }
    __syncthreads();
}
__device__ __forceinline__ void wave_rows(int gw, int NGW, int lo, int hi, int& rb, int& re) { const int n = hi - lo, q = n / NGW, rem = n % NGW; rb = lo + gw * q + (gw < rem ? gw : rem); re = rb + q + (gw < rem ? 1 : 0); }
struct CombIdx { size_t r0, r1, r2; };
__device__ __forceinline__ CombIdx comb_idx(const Ctx& C, int r, const LAS int* pfx, int srow0) {
    const int* tp = (const int*)(CWS + WS_ROUTE + RO_TOKPOS) + 2 * r; const int t0 = tp[0], t1 = tp[1];
    CombIdx ci; ci.r0 = (size_t)pfx[16] * 256 + (r - srow0); ci.r1 = (size_t)pfx[t0 >> 20] * 256 + (t0 & 0xfffff); ci.r2 = (size_t)pfx[t1 >> 20] * 256 + (t1 & 0xfffff); return ci;
}
__device__ __forceinline__ void comb_load(const Ctx& C, const CombIdx& ci, unsigned (&y)[3][4]) {
    const unsigned char* YE = (const unsigned char*)(CWS + WS_R2);
#pragma unroll
    for (int j = 0; j < 4; ++j) { y[0][j] = __builtin_nontemporal_load((const unsigned*)(YE + ci.r0 * DM + j * 256 + 4 * C.lane)); y[1][j] = __builtin_nontemporal_load((const unsigned*)(YE + ci.r1 * DM + j * 256 + 4 * C.lane)); y[2][j] = __builtin_nontemporal_load((const unsigned*)(YE + ci.r2 * DM + j * 256 + 4 * C.lane)); }
}
__device__ __forceinline__ f32x4 fp8x4_to_f32(unsigned w) {
    const f32x2 lo = __builtin_amdgcn_cvt_pk_f32_fp8((int)w, false), hi = __builtin_amdgcn_cvt_pk_f32_fp8((int)w, true);
    return (f32x4){lo.x, lo.y, hi.x, hi.y};
}
__device__ __forceinline__ void comb_apply(const Ctx& C, const LAS float* gt2, const unsigned (&y)[3][4], f32x4 (&v)[4]) {
    constexpr float us = 1.0f / (float)(1 << FP8_AEXP);
#pragma unroll
    for (int j = 0; j < 4; ++j) { const f32x4 g = *(const LAS f32x4*)(gt2 + j * 256 + 4 * C.lane);
        const f32x4 t = (fp8x4_to_f32(y[0][j]) + fp8x4_to_f32(y[1][j]) + fp8x4_to_f32(y[2][j])) * us;
        v[j] = v[j] + g * t; }
}
__device__ __forceinline__ void mod_chunk_to_lds(LAS float* dst, const float* modv_layer, int chunk, int tid) {
#pragma unroll
    for (int q = 0; q < 10; ++q) { const int i = q * NTHR + tid, w = i >> 10, j = i & 1023; dst[i] = modv_layer[(size_t)(w * 6 + chunk) * DM + j]; }
}
__device__ __forceinline__ void norm_mod_row(const Ctx& C, const f32x4 (&v)[4], const f32x4 (&g)[4], const LAS float* sh, const LAS float* sc, unsigned char* orow, f32x4 (&f)[4]) {
    float s = 0.f;
#pragma unroll
    for (int j = 0; j < 4; ++j) s += (v[j].x * v[j].x + v[j].y * v[j].y) + (v[j].z * v[j].z + v[j].w * v[j].w);
    const float rstd = __builtin_amdgcn_rsqf(wave_sum(s, C.lane) * (1.0f / DM) + EPS);
#pragma unroll
    for (int j = 0; j < 4; ++j) { const int c = j * 256 + 4 * C.lane;
        const f32x4 a = *(const LAS f32x4*)(sc + c), b = *(const LAS f32x4*)(sh + c);
        f[j] = (v[j] * rstd) * g[j] * (a + 1.0f) + b;
        *(unsigned*)(orow + c) = pk4_i8(f[j].x, f[j].y, f[j].z, f[j].w, (float)(1 << I8_AEXP)); }
}

constexpr int NPHASE = 1 + NLAYER * 10 + 1;

__global__ void __launch_bounds__(NTHR, 2) fwd_kernel(Args args) {
    extern __shared__ __attribute__((aligned(16))) unsigned char lds_raw[];
    Ctx C;
    C.lds = (LAS unsigned char*)lds_raw;
    C.tid = threadIdx.x; C.lane = C.tid & 63; C.wave = __builtin_amdgcn_readfirstlane(C.tid >> 6);
    C.G = gridDim.x; { const int bx = blockIdx.x; C.vcu = (C.G % 8 == 0) ? (bx % 8) * (C.G / 8) + bx / 8 : bx; }
    C.gw = C.vcu * NWAVES + C.wave; C.NGW = C.G * NWAVES;
    C.ap = (ArgsP)__builtin_amdgcn_kernarg_segment_ptr();
    unsigned char* ws = C.ap->ws;
    unsigned* ctl = (unsigned*)(ws + WS_CTL);
    volatile LAS unsigned* bst = (volatile LAS unsigned*)(C.lds + LDSX_MISC);
    if (C.tid < 4) bst[C.tid] = 0u;
    __syncthreads();
    XcdBarrier bar = xcd_barrier_post(ctl + CW_BAR + C.ap->li * XCD_BAR_WORDS, bst);
    const int lo = C.ap->ph_lo, hi = C.ap->ph_hi;
#ifndef PHMASK
#define PHMASK 0xfff
#endif
#define EN(kind) (((PHMASK) >> (kind)) & 1)
#ifndef REPMASK
#define REPMASK 0
#endif
#define NREP(kind) (1 + (((REPMASK) >> (kind)) & 1))
#define IN(k) (lo <= (k) && (k) < hi)
#ifndef BARX
#define BARX 1
#endif
#define SEAM(k) do { if (IN(k) && IN((k) + 1)) { _Pragma("unroll 1") for (int bx_ = 0; bx_ < BARX; ++bx_) { XcdBarrier b_ = bar; asm volatile("" : "+s"(b_.x)); xcd_barrier(b_); } } } while (0)
    LAS int* gtab = (LAS int*)(C.lds + LDSX_GTAB);
    LAS int* pfxl = (LAS int*)(C.lds + LDSX_PFX);
#define PH() { ArgsP _ap = C.ap; asm volatile("" : "+s"(_ap)); C.ap = _ap; int t_ = threadIdx.x; asm volatile("" : "+v"(t_)); C.tid = t_; C.lane = t_ & 63; C.wave = __builtin_amdgcn_readfirstlane(t_ >> 6); C.gw = C.vcu * NWAVES + C.wave; } \
    unsigned char* ws = C.ap->ws; unsigned* ctl = (unsigned*)(ws + WS_CTL); (void)ctl; \
    float* MODV = (float*)(ws + WS_MISC + MO_MODV); (void)MODV; bf16* WB = (bf16*)(ws + WS_W) + (size_t)l * WL_STRIDE; (void)WB; \
    bf16* R1 = (bf16*)(ws + WS_R1); (void)R1; bf16* PROJ = (bf16*)(ws + WS_R2); (void)PROJ; bf16* UQ = (bf16*)(ws + WS_R4); (void)UQ; bf16* QA = UQ; (void)QA; bf16* XS = (bf16*)(ws + WS_R5); (void)XS; \
    unsigned char* KA = ws + WS_R3 + R3_KA; (void)KA; bf16* VA = (bf16*)(ws + WS_R3 + R3_VA); (void)VA; unsigned char* QB = ws + WS_R3 + R3_QB; (void)QB; \
    unsigned char* KB = ws + WS_R3 + R3_KB; (void)KB; bf16* VB = (bf16*)(ws + WS_R3 + R3_VB); (void)VB; unsigned char* QA8 = ws + WS_R3 + R3_QA; (void)QA8; \
    bf16* Y1 = (bf16*)(ws + WS_R3 + R3_Y1); (void)Y1; bf16* YY = (bf16*)(ws + WS_R3 + R3_Y); (void)YY; bf16* HH = (bf16*)(ws + WS_R3 + R3_HH); (void)HH; \
    const float* modl = MODV + (size_t)l * 5 * 6144; (void)modl;

    if (EN(0) && IN(0)) {
#pragma unroll 1
      for (int rep = 0; rep < NREP(0); ++rep) {
        { ArgsP _ap = C.ap; asm volatile("" : "+s"(_ap)); C.ap = _ap; }
        const bool big = (C.G >= 250); const bool gemv_wg = big && (C.vcu % 5 == 0) && (C.vcu < 240);
        if (!big) { for (int u = C.vcu; u < 48; u += C.G) mod_gemv(C, u); } else if (gemv_wg) mod_gemv(C, C.vcu / 5);
        if (C.wave == 1 && C.vcu == 241 % C.G) make_tables(C);
        if (!big) convert_static(C, 0, C.gw, C.NGW); else if (!gemv_wg) { const int v3 = (C.vcu < 240) ? C.vcu - C.vcu / 5 - 1 : C.vcu - 48; convert_static(C, 0, v3 * NWAVES + C.wave, (C.G - 48) * NWAVES); }
        if (big && !gemv_wg) (void)convert_steal(C, 0, CONV_NQUEUE, 2);
        __syncthreads();
      }
    }
    SEAM(0);

    for (int l = 0; l < NLAYER; ++l) {
        const int P = 1 + l * 10;
        const bool lastl = (l == NLAYER - 1);
        const int mrow0 = lastl ? TC : 0;

        if (EN(1) && IN(P + 0)) {
#pragma unroll 1
          for (int rep = 0; rep < (NREP(1) > 1 && l == 0 ? 2 : 1); ++rep) {
            PH();
            if (l > 0 && !IN(P - 2)) expert_prefix(ctl + CW_CNT + (l - 1) * 1024, 0, pfxl, C.tid);
            LAS float* mt = (LAS float*)C.lds;
            mod_chunk_to_lds(mt, modl, 0, C.tid); mod_chunk_to_lds(mt + 5 * DM, modl, 1, C.tid);
            if (l > 0) mod_chunk_to_lds(mt + 10 * DM, MODV + (size_t)(l - 1) * 5 * 6144, 5, C.tid);
            f32x4 gv[4];
#pragma unroll
            for (int j = 0; j < 4; ++j) gv[j] = *(const f32x4*)(CIN(6) + l * DM + j * 256 + 4 * C.lane);
            __syncthreads();
            int rb, re; wave_rows(C.gw, C.NGW, 0, T, rb, re);
            if (l == 0) {
                for (int r0 = rb; r0 < re; r0 += 4) {
                    f32x4 v[4][4], f[4];
#pragma unroll
                    for (int k = 0; k < 4; ++k) { const int r = (r0 + k < re) ? r0 + k : re - 1; const float* src = stream_in(C, 0, r);
#pragma unroll
                        for (int j = 0; j < 4; ++j) v[k][j] = __builtin_nontemporal_load((const f32x4*)(src + j * 256 + 4 * C.lane)); }
#pragma unroll
                    for (int k = 0; k < 4; ++k) if (r0 + k < re) { const int r = r0 + k, which = (r < TC) ? 4 : ((r - TC) >> 12);
                        xs_store(XS + (size_t)r * DM, C.lane, v[k]);
                        norm_mod_row(C, v[k], gv, mt + which * DM, mt + (5 + which) * DM, (unsigned char*)R1 + (size_t)r * DM, f); }
                }
            } else {
                constexpr int NB = 4;
                CombIdx cn[NB];
#pragma unroll
                for (int k = 0; k < NB; ++k) { const int r = (rb + k < re) ? rb + k : re - 1; cn[k] = comb_idx(C, r, pfxl, 0); }
                for (int r0 = rb; r0 < re; r0 += NB) {
                    f32x4 v[NB][4], f[4]; unsigned y[NB][3][4]; CombIdx ci[NB];
#pragma unroll
                    for (int k = 0; k < NB; ++k) { const int r = (r0 + k < re) ? r0 + k : re - 1; ci[k] = cn[k]; xs_load(XS + (size_t)r * DM, C.lane, v[k]); }
#pragma unroll
                    for (int k = 0; k < NB; ++k) comb_load(C, ci[k], y[k]);
#pragma unroll
                    for (int k = 0; k < NB; ++k) { const int r = (r0 + NB + k < re) ? r0 + NB + k : re - 1; cn[k] = comb_idx(C, r, pfxl, 0); }
#pragma unroll
                    for (int k = 0; k < NB; ++k) if (r0 + k < re) { const int r = r0 + k, which = (r < TC) ? 4 : ((r - TC) >> 12);
                        comb_apply(C, mt + (10 + which) * DM, y[k], v[k]); xs_store(XS + (size_t)r * DM, C.lane, v[k]);
                        norm_mod_row(C, v[k], gv, mt + which * DM, mt + (5 + which) * DM, (unsigned char*)R1 + (size_t)r * DM, f); }
                }
            }
            __syncthreads();
            if (l > 0) convert_static(C, l, C.gw, C.NGW);
          }
        }
        SEAM(P + 0);

        if (EN(2) && IN(P + 1)) {
#pragma unroll 1
          for (int rep = 0; rep < NREP(2); ++rep) {
            PH();
            constexpr int SW = 0x01010101 * (127 - FP8_WEXP), SA0 = 0x7f7f7f7f;
            pg8::StaticOrder S; S.init(T, INCP, C.G, (int)blockIdx.x, DM / 2, DM / 2);
            pg8::EpiProj E{PROJ};
            pg8::gemm_phase<pg8::EpiProj, pg8::StaticOrder, false, 2>(C.lds, R1, DM / 2, WB + WO_IN, DM / 2, S, E, gtab, SW, SA0, 1.0f / (float)(1 << (I8_AEXP + I8_WEXP)));
            if ((S.nwg + C.G - 1 - S.c) / C.G < (S.nwg + C.G - 1) / C.G) (void)convert_steal(C, l, CONV_NQUEUE, 2);
          }
        }
        SEAM(P + 1);

        if (EN(3) && IN(P + 2)) {
#pragma unroll 1
          for (int rep = 0; rep < NREP(3); ++rep) {
            PH();
            { pg8::StaticOrder S; S.init(T, 768, C.G, (int)blockIdx.x, INCP, 256);
              pg8::EpiF8 E{(unsigned char*)UQ, 768};
              pg8::gemm_phase<pg8::EpiF8, pg8::StaticOrder, false>(C.lds, PROJ + C_CQ, INCP, WB + WO_UQ, 256, S, E, gtab); }
            __builtin_amdgcn_sched_barrier(0); asm volatile("" ::: "memory");
            { int kk = 128; asm volatile("" : "+s"(kk));
              pg8::StaticOrder S; S.init(T, 1024, C.G, (int)((blockIdx.x + 52) % C.G), INCP, kk);
              pg8::EpiF8 E{(unsigned char*)R1, 1024};
              pg8::gemm_phase<pg8::EpiF8, pg8::StaticOrder, false>(C.lds, PROJ + C_CKV, INCP, WB + WO_UKV, kk, S, E, gtab); }
          }
        }
        SEAM(P + 2);

        if (EN(4) && IN(P + 3)) {
#pragma unroll 1
          for (int rep = 0; rep < (NREP(4) > 1 ? 2 : 1); ++rep) {
            PH();
            const unsigned hq = queue_head_early(C, l);
            const float* g_qa = CIN(13) + l * 96; const float* g_ka = CIN(14) + l * 96; const float* g_qb = CIN(15) + l * 64; const float* g_kb = CIN(16) + l * 64;
            const float* tabA = (const float*)(ws + WS_MISC + MO_TABA); const float* tabB = (const float*)(ws + WS_MISC + MO_TABB);
            const int h = C.lane >> 3, j = C.lane & 7, ax = j >> 2, i0 = 2 * (j & 3);
            float gqa_n[8], gka_n[8], gqa_r[4], gka_r[4], gqb8[8], gkb8[8];
#pragma unroll
            for (int e = 0; e < 8; ++e) { gqa_n[e] = g_qa[8 * j + e]; gka_n[e] = g_ka[8 * j + e]; gqb8[e] = g_qb[8 * j + e]; gkb8[e] = g_kb[8 * j + e]; }
#pragma unroll
            for (int e = 0; e < 2; ++e) { gqa_r[e] = g_qa[64 + ax * 16 + i0 + e]; gqa_r[2 + e] = g_qa[64 + ax * 16 + 8 + i0 + e]; gka_r[e] = g_ka[64 + ax * 16 + i0 + e]; gka_r[2 + e] = g_ka[64 + ax * 16 + 8 + i0 + e]; }
            sweep_late(C, l, CQ_OUT, hq);
            int rb, re; wave_rows(C.gw, C.NGW, 0, T, rb, re);
            for (int r0 = rb; r0 < re; r0 += 2) {
                u32x2 i_cq[2]; unsigned i_ckv[2], i_q1[2], i_q2[2], i_k1[2], i_k2[2]; u32x2 i_uq[2], i_uk[2], i_uv[2], i_qb[2], i_kb[2], i_vb[2]; f32x4 t_a[2], t_b[2][4];
#pragma unroll
                for (int k = 0; k < 2; ++k) { const int r = (r0 + k < re) ? r0 + k : re - 1;
                    const bf16* pr = PROJ + (size_t)r * INCP; const unsigned char* uq = (const unsigned char*)UQ + (size_t)r * 768 + h * 96; const unsigned char* uk = (const unsigned char*)R1 + (size_t)r * 1024 + h * 128;
#define NTL(T_, p_) __builtin_nontemporal_load((const T_*)(p_))
                    i_cq[k] = NTL(u32x2, pr + C_CQ + 4 * C.lane); i_ckv[k] = NTL(unsigned, pr + C_CKV + 2 * C.lane);
                    i_uq[k] = NTL(u32x2, uq + 8 * j); i_q1[k] = NTL(unsigned short, uq + 64 + ax * 16 + i0); i_q2[k] = NTL(unsigned short, uq + 64 + ax * 16 + 8 + i0);
                    i_uk[k] = NTL(u32x2, uk + 8 * j); i_uv[k] = NTL(u32x2, uk + 64 + 8 * j);
                    i_k1[k] = NTL(unsigned, pr + C_KR + ax * 16 + i0); i_k2[k] = NTL(unsigned, pr + C_KR + ax * 16 + 8 + i0);
                    { const unsigned char* p8 = (const unsigned char*)pr; i_qb[k] = NTL(u32x2, p8 + PQ8 + h * 64 + 8 * j); i_kb[k] = NTL(u32x2, p8 + PK8 + (h & 1) * 64 + 8 * j); i_vb[k] = NTL(u32x2, p8 + PV8 + (C.lane & 15) * 8); }
#undef NTL
                    { const int n_ = (r < TC) ? 0 : ((r - TC) & 4095), pos = ax ? (n_ & 63) : (n_ >> 6);
                      t_a[k] = *(const f32x4*)(tabA + (pos * 8 + i0) * 2);
#pragma unroll
                      for (int q = 0; q < 4; ++q) t_b[k][q] = *(const f32x4*)(tabB + (pos * 16 + (j & 1) * 8 + 2 * q) * 2); } }
#pragma unroll
              for (int k = 0; k < 2; ++k) if (r0 + k < re) { const int r = r0 + k;
                const bool isctx = r < TC; const int b = isctx ? (r >> 8) : ((r - TC) >> 12); const int n = isctx ? (r & 255) : ((r - TC) & 4095);
                const int Lidx = isctx ? n : CTXL + n; const int prow = n >> 6, pcol = n & 63;
                const size_t krow = (size_t)b * LK + Lidx;
                float s1, s2;
                { const u32x2 a = i_cq[k]; const float a0 = bflo(a.x), a1 = bfhi(a.x), a2 = bflo(a.y), a3 = bfhi(a.y); s1 = (a0 * a0 + a1 * a1) + (a2 * a2 + a3 * a3);
                  const unsigned c = i_ckv[k]; const float c0 = bflo(c), c1 = bfhi(c); s2 = c0 * c0 + c1 * c1; }
                const float rs_cq = __builtin_amdgcn_rsqf(wave_sum(s1, C.lane) * (1.0f / 256.0f) + EPS), rs_ckv = __builtin_amdgcn_rsqf(wave_sum(s2, C.lane) * (1.0f / 128.0f) + EPS);
                { unsigned char* qa = QA8 + (size_t)r * 1024 + h * 128;
                  const u32x2 a = i_uq[k];
                  const f32x2 a0 = __builtin_amdgcn_cvt_pk_f32_fp8((int)a.x, false), a1 = __builtin_amdgcn_cvt_pk_f32_fp8((int)a.x, true), a2 = __builtin_amdgcn_cvt_pk_f32_fp8((int)a.y, false), a3 = __builtin_amdgcn_cvt_pk_f32_fp8((int)a.y, true);
                  const f32x2 y1 = __builtin_amdgcn_cvt_pk_f32_fp8((int)i_q1[k], false), y2 = __builtin_amdgcn_cvt_pk_f32_fp8((int)i_q2[k], false);
                  float v[8] = {a0[0], a0[1], a1[0], a1[1], a2[0], a2[1], a3[0], a3[1]}; float x1[2] = {y1[0], y1[1]}, x2[2] = {y2[0], y2[1]};
                  const float rsq_ = rs_cq * (1.0f / (float)(1 << FP8_AEXP));
                  float ss = 0.f;
#pragma unroll
                  for (int e = 0; e < 8; ++e) { v[e] *= rsq_; ss += v[e] * v[e]; }
#pragma unroll
                  for (int e = 0; e < 2; ++e) { x1[e] *= rsq_; x2[e] *= rsq_; ss += x1[e] * x1[e] + x2[e] * x2[e]; }
                  const float rn = SCA * __builtin_amdgcn_rsqf(sum8(ss, C.lane) * (1.0f / 96.0f) + EPS);
#pragma unroll
                  for (int e = 0; e < 8; ++e) v[e] *= rn * gqa_n[e];
                  float o1[2], o2[2];
#pragma unroll
                  for (int e = 0; e < 2; ++e) { const float a1 = x1[e] * rn * gqa_r[e], a2 = x2[e] * rn * gqa_r[2 + e];
                      if (isctx) { o1[e] = a1; o2[e] = a2; } else { const float cc_ = t_a[k][2 * e], ss_ = t_a[k][2 * e + 1]; o1[e] = a1 * cc_ - a2 * ss_; o2[e] = a1 * ss_ + a2 * cc_; } }
                  constexpr float qs = (float)(1 << att::QEXP);
                  u32x4 w; w.x = pk4_fp8(v[0] * qs, v[1] * qs, v[2] * qs, v[3] * qs); w.y = pk4_fp8(v[4] * qs, v[5] * qs, v[6] * qs, v[7] * qs); w.z = pk4_fp8(o1[0] * qs, o1[1] * qs, o2[0] * qs, o2[1] * qs); w.w = 0u;
                  *(u32x4*)(qa + 16 * j) = w; }
                { const u32x2 a = i_uk[k], vv = i_uv[k];
                  const unsigned x1w = i_k1[k], x2w = i_k2[k];
                  const f32x2 a0 = __builtin_amdgcn_cvt_pk_f32_fp8((int)a.x, false), a1 = __builtin_amdgcn_cvt_pk_f32_fp8((int)a.x, true), a2 = __builtin_amdgcn_cvt_pk_f32_fp8((int)a.y, false), a3 = __builtin_amdgcn_cvt_pk_f32_fp8((int)a.y, true);
                  float v[8] = {a0[0], a0[1], a1[0], a1[1], a2[0], a2[1], a3[0], a3[1]}; float x1[2] = {bflo(x1w), bfhi(x1w)}, x2[2] = {bflo(x2w), bfhi(x2w)};
                  const float rsk_ = rs_ckv * (1.0f / (float)(1 << FP8_AEXP));
                  float ss = 0.f;
#pragma unroll
                  for (int e = 0; e < 8; ++e) { v[e] *= rsk_; ss += v[e] * v[e]; }
#pragma unroll
                  for (int e = 0; e < 2; ++e) ss += x1[e] * x1[e] + x2[e] * x2[e];
                  const float rn = __builtin_amdgcn_rsqf(sum8(ss, C.lane) * (1.0f / 96.0f) + EPS);
#pragma unroll
                  for (int e = 0; e < 8; ++e) v[e] *= rn * gka_n[e];
                  float o1[2], o2[2];
#pragma unroll
                  for (int e = 0; e < 2; ++e) { const float a1 = x1[e] * rn * gka_r[e], a2 = x2[e] * rn * gka_r[2 + e];
                      if (isctx) { o1[e] = a1; o2[e] = a2; } else { const float cc_ = t_a[k][2 * e], ss_ = t_a[k][2 * e + 1]; o1[e] = a1 * cc_ - a2 * ss_; o2[e] = a1 * ss_ + a2 * cc_; } }
                  unsigned char* ka = KA + krow * 1024 + h * 128;
                  u32x4 w; w.x = pk4_fp8(v[0], v[1], v[2], v[3]); w.y = pk4_fp8(v[4], v[5], v[6], v[7]); w.z = pk4_fp8(o1[0], o1[1], o2[0], o2[1]); w.w = 0u;
                  *(u32x4*)(ka + 16 * j) = w;
                  const f32x2 q0 = __builtin_amdgcn_cvt_pk_f32_fp8((int)vv.x, false), q1 = __builtin_amdgcn_cvt_pk_f32_fp8((int)vv.x, true), q2 = __builtin_amdgcn_cvt_pk_f32_fp8((int)vv.y, false), q3 = __builtin_amdgcn_cvt_pk_f32_fp8((int)vv.y, true);
                  u32x4 wv; wv.x = pk2(q0[0] * rsk_, q0[1] * rsk_); wv.y = pk2(q1[0] * rsk_, q1[1] * rsk_); wv.z = pk2(q2[0] * rsk_, q2[1] * rsk_); wv.w = pk2(q3[0] * rsk_, q3[1] * rsk_);
                  *(u32x4*)(VA + krow * 512 + h * 64 + 8 * j) = wv; }
#pragma unroll
                for (int pass = 0; pass < 2; ++pass) {
                    const int hh = pass ? (h & 1) : h;
                    const u32x2 a = pass ? i_kb[k] : i_qb[k];
                    const f32x2 a0 = __builtin_amdgcn_cvt_pk_f32_fp8((int)a.x, false), a1 = __builtin_amdgcn_cvt_pk_f32_fp8((int)a.x, true), a2 = __builtin_amdgcn_cvt_pk_f32_fp8((int)a.y, false), a3 = __builtin_amdgcn_cvt_pk_f32_fp8((int)a.y, true);
                    constexpr float u8_ = 1.0f / (float)(1 << FP8_AEXP);
                    float v[8] = {a0[0] * u8_, a0[1] * u8_, a1[0] * u8_, a1[1] * u8_, a2[0] * u8_, a2[1] * u8_, a3[0] * u8_, a3[1] * u8_};
                    float ss = 0.f;
#pragma unroll
                    for (int e = 0; e < 8; ++e) ss += v[e] * v[e];
                    const float rn = (pass ? 1.0f : SCB) * __builtin_amdgcn_rsqf(sum8(ss, C.lane) * (1.0f / 64.0f) + EPS);
#pragma unroll
                    for (int e = 0; e < 8; ++e) v[e] *= rn * (pass ? gkb8[e] : gqb8[e]);
                    float o[8];
#pragma unroll
                    for (int e = 0; e < 8; ++e) { const float px = dppf<DPP_X2>(v[e]);
                        if (isctx) o[e] = v[e];
                        else { const float cc_ = t_b[k][e >> 1][2 * (e & 1)], ss_ = t_b[k][e >> 1][2 * (e & 1) + 1]; o[e] = (j & 2) ? (px * ss_ + v[e] * cc_) : (v[e] * cc_ - px * ss_); } }
                    const float qs = pass ? 1.0f : (float)(1 << att::QEXP);
                    u32x2 w; w.x = pk4_fp8(o[0] * qs, o[1] * qs, o[2] * qs, o[3] * qs); w.y = pk4_fp8(o[4] * qs, o[5] * qs, o[6] * qs, o[7] * qs);
                    if (!pass) *(u32x2*)(QB + (size_t)r * 512 + h * 64 + 8 * j) = w;
                    else if (C.lane < 16) *(u32x2*)(KB + krow * 128 + hh * 64 + 8 * j) = w;
                }
                if (C.lane >= 16 && C.lane < 32) { const u32x2 a = i_vb[k]; constexpr float u8_ = 1.0f / (float)(1 << FP8_AEXP);
                    const f32x2 a0 = __builtin_amdgcn_cvt_pk_f32_fp8((int)a.x, false), a1 = __builtin_amdgcn_cvt_pk_f32_fp8((int)a.x, true), a2 = __builtin_amdgcn_cvt_pk_f32_fp8((int)a.y, false), a3 = __builtin_amdgcn_cvt_pk_f32_fp8((int)a.y, true);
                    u32x4 wv; wv.x = pk2(a0[0] * u8_, a0[1] * u8_); wv.y = pk2(a1[0] * u8_, a1[1] * u8_); wv.z = pk2(a2[0] * u8_, a2[1] * u8_); wv.w = pk2(a3[0] * u8_, a3[1] * u8_);
                    *(u32x4*)(VB + krow * 128 + (C.lane - 16) * 8) = wv; }
              }
            }
          }
        }
        SEAM(P + 3);

        if (EN(5) && IN(P + 4)) {
#pragma unroll 1
          for (int rep = 0; rep < NREP(5); ++rep) {
            PH();
            const float* cb = (const float*)(ws + WS_MISC + MO_CB) + l * 2;
            const float negA = cb[0], negB = cb[1];
            unsigned char* O = (unsigned char*)R1;
            const int NU = 1024 + (lastl ? 0 : 64);
            for (int u = C.vcu; u < NU; u += C.G) {
                int kind, b, hd, NT; size_t r0;
                if (u < 1024) { const int i = u >> 8, v = u & 255, idx = 2 * v + (i >> 1); kind = i & 1; NT = LK / 64;
                    if (kind == 0) { const int bh = idx >> 4, qb = idx & 15; b = bh >> 3; hd = bh & 7; r0 = (size_t)TC + (size_t)b * SEQ + qb * 256 + C.wave * 32; }
                    else { const int bk = idx >> 6, jj = idx & 63, qb = jj >> 2, g = jj & 3; b = bk >> 1; hd = (bk & 1) * 4 + g; r0 = (size_t)TC + (size_t)b * SEQ + qb * 256 + C.wave * 32; } }
                else { const int w = u - 1024, bh = w & 31; kind = w >> 5; b = bh >> 3; hd = bh & 7; NT = CTXL / 64; r0 = (size_t)b * CTXL + C.wave * 32; }
                if (kind == 0) att::attn_unit<96>(QA8 + r0 * 1024 + hd * 128, 1024, KA + (size_t)b * LK * 1024 + hd * 128, 1024, VA + (size_t)b * LK * 512 + hd * 64, 512, O + r0 * DM + hd * 64, NT, negA, C.lds);
                else att::attn_unit<64>(QB + r0 * 512 + hd * 64, 512, KB + (size_t)b * LK * 128 + (hd >> 2) * 64, 128, VB + (size_t)b * LK * 128 + (hd >> 2) * 64, 128, O + r0 * DM + 512 + hd * 64, NT, negB, C.lds);
            }
            if (!lastl && C.vcu + 1024 >= NU) { __syncthreads();
                const int g0 = convert_steal(C, l, CONV_NQUEUE, 1); if (g0 < 1 && l + 1 < NLAYER) (void)convert_steal(C, l + 1, CONV_NQUEUE, 1); }
          }
        }
        SEAM(P + 4);

        if (EN(6) && IN(P + 5)) {
#pragma unroll 1
          for (int rep = 0; rep < NREP(6); ++rep) {
            PH();
            const int M = T - TC; const unsigned char* O = (const unsigned char*)R1 + (size_t)TC * DM;
            constexpr int SW = 0x01010101 * (127 - FP8_WEXP), SA = 0x01010101 * (127 - FP8_AEXP);
            pg8::StaticOrder S; S.init(M, DM, C.G, (int)blockIdx.x, DM / 2, DM / 2);
            pg8::EpiGateF E{(unsigned char*)YY + (size_t)TC * DM, (const unsigned char*)PROJ + (size_t)TC * PROW};
            pg8::gemm_phase<pg8::EpiGateF, pg8::StaticOrder, false, 1, true>(C.lds, (const bf16*)O, DM / 2, WB + WO_OA, DM / 2, S, E, gtab, SW, SA);
            if (mrow0 == 0) ctx_mini_gemm<true>(C, (const unsigned char*)R1, (const unsigned char*)(WB + WO_OA), SW, SA, (unsigned char*)YY, (const unsigned char*)PROJ, nullptr, nullptr, nullptr);
            if ((S.nwg + C.G - 1 - S.c) / C.G < (S.nwg + C.G - 1) / C.G) { const int g0 = convert_steal(C, l, CONV_NQUEUE, 4); if (g0 < 4 && l + 1 < NLAYER) (void)convert_steal(C, l + 1, CONV_NQUEUE, 4 - g0); }
          }
        }
        SEAM(P + 5);

        if (EN(7) && IN(P + 6)) {
#pragma unroll 1
          for (int rep = 0; rep < (NREP(7) > 1 && l == 0 ? 2 : 1); ++rep) {
            PH();
            const int M = T - TC;
            constexpr int SW = 0x01010101 * (127 - FP8_WEXP), SA = 0x01010101 * (127 - FP8_AEXP);
            pg8::StaticOrder S; S.init(M, DM, C.G, (int)blockIdx.x, DM / 2, DM / 2);
            pg8::EpiRes E{XS, modl, TC, 2};
            pg8::gemm_phase<pg8::EpiRes, pg8::StaticOrder, false, 1>(C.lds, (const bf16*)((const unsigned char*)YY + (size_t)TC * DM), DM / 2, WB + WO_OUT, DM / 2, S, E, gtab, SW, SA);
            if (mrow0 == 0) ctx_mini_gemm<false>(C, (const unsigned char*)YY, (const unsigned char*)(WB + WO_OUT), SW, SA, nullptr, nullptr, nullptr, XS, modl + (size_t)(4 * 6 + 2) * DM);
            if ((S.nwg + C.G - 1 - S.c) / C.G < (S.nwg + C.G - 1) / C.G) { const int g0 = convert_steal(C, l, CONV_NQUEUE, 4); if (g0 < 4 && l + 1 < NLAYER) (void)convert_steal(C, l + 1, CONV_NQUEUE, 4 - g0); }
          }
        }
        SEAM(P + 6);

        if (EN(8) && IN(P + 7)) {
#pragma unroll 1
          for (int rep = 0; rep < NREP(8); ++rep) {
            PH();
            const unsigned hq = queue_head_early(C, l);
            float mA[10], mB[10]; f32x4 gv[4];
            LAS float* wT = (LAS float*)C.lds;
            { const f32x4* wsrc = (const f32x4*)CIN(20); f32x4 wq[8];
#pragma unroll
              for (int q = 0; q < 8; ++q) wq[q] = wsrc[q * NTHR + C.tid];
#pragma unroll
              for (int q = 0; q < 10; ++q) { const int i = q * NTHR + C.tid, w = i >> 10, j = i & 1023; mA[q] = modl[(size_t)(w * 6 + 3) * DM + j]; mB[q] = modl[(size_t)(w * 6 + 4) * DM + j]; }
#pragma unroll
              for (int j = 0; j < 4; ++j) gv[j] = *(const f32x4*)(CIN(7) + l * DM + j * 256 + 4 * C.lane);
              sweep_late(C, l, CONV_NQUEUE, hq);
#pragma unroll
              for (int q = 0; q < 8; ++q) { const int i4 = q * NTHR + C.tid, d = i4 >> 2, e0 = (i4 & 3) * 4;
#pragma unroll
                  for (int k = 0; k < 4; ++k) wT[(e0 + k) * DM + d] = wq[q][k]; } }
            LAS int* lcnt = (LAS int*)(C.lds + 65536);
            LAS int* rt_row = lcnt + 32; LAS int* rt_e = rt_row + 256; LAS int* rt_lp = rt_e + 512; LAS float* rt_w = (LAS float*)(rt_lp + 512);
            if (C.tid < 32) lcnt[C.tid] = 0;
            __syncthreads();
            const float* brt = CIN(21);
            LAS float* mt = (LAS float*)(C.lds + 80 * 1024);
#pragma unroll
            for (int q = 0; q < 10; ++q) { const int i = q * NTHR + C.tid; mt[i] = mA[q]; mt[5 * DM + i] = mB[q]; }
            __syncthreads();
            unsigned* cnt = ctl + CW_CNT + l * 1024 + ((rep + 1 < NREP(8)) ? 2048 : 0);
            int* liste = (int*)(ws + WS_ROUTE + RO_LISTE); float* roww = (float*)(ws + WS_ROUTE + RO_ROWW); int* tokpos = (int*)(ws + WS_ROUTE + RO_TOKPOS);
            int rb, re; wave_rows(C.gw, C.NGW, mrow0, T, rb, re);
            const int lb3 = (C.lane >> 3) & 1, lb2 = (C.lane >> 2) & 1, lb1 = (C.lane >> 1) & 1, lb0 = C.lane & 1;
            const float brl = brt[C.lane & 15];
            for (int r0 = rb; r0 < re; r0 += 3) {
                f32x4 v[3][4], f[3][4];
#pragma unroll
                for (int k = 0; k < 3; ++k) { const int r = (r0 + k < re) ? r0 + k : re - 1; xs_load(XS + (size_t)r * DM, C.lane, v[k]); }
#pragma unroll
                for (int k = 0; k < 3; ++k) { const int r = (r0 + k < re) ? r0 + k : re - 1, which = (r < TC) ? 4 : ((r - TC) >> 12);
                    norm_mod_row(C, v[k], gv, mt + which * DM, mt + (5 + which) * DM, (unsigned char*)R1 + (size_t)r * DM, f[k]); }
                float a[3][16];
#pragma unroll
                for (int e = 0; e < 16; ++e) { f32x4 w[4];
#pragma unroll
                    for (int j = 0; j < 4; ++j) w[j] = *(const LAS f32x4*)(wT + e * DM + j * 256 + 4 * C.lane);
#pragma unroll
                    for (int k = 0; k < 3; ++k) { f32x4 a4 = f[k][0] * w[0];
#pragma unroll
                        for (int j = 1; j < 4; ++j) a4 = f[k][j] * w[j] + a4;
                        float t = (a4.x + a4.y) + (a4.z + a4.w);
                        asm volatile("" : "+v"(t)); a[k][e] = t; }
                    if (e & 1) __builtin_amdgcn_sched_barrier(0); }
#pragma unroll
                for (int k = 0; k < 3; ++k) {
                    float b8[8], b4[4], b2[2], b1;
#pragma unroll
                    for (int i = 0; i < 8; ++i) { const float snd = lb3 ? a[k][i] : a[k][i + 8], kp = lb3 ? a[k][i + 8] : a[k][i]; b8[i] = kp + dppf<DPP_RM>(snd); }
#pragma unroll
                    for (int i = 0; i < 4; ++i) { const float snd = lb2 ? b8[i] : b8[i + 4], kp = lb2 ? b8[i + 4] : b8[i]; b4[i] = kp + dppf<DPP_HM>(snd); }
#pragma unroll
                    for (int i = 0; i < 2; ++i) { const float snd = lb1 ? b4[i] : b4[i + 2], kp = lb1 ? b4[i + 2] : b4[i]; b2[i] = kp + dppf<DPP_X2>(snd); }
                    { const float snd = lb0 ? b2[0] : b2[1], kp = lb0 ? b2[1] : b2[0]; b1 = kp + dppf<DPP_X1>(snd); }
                    b1 += shx(b1, C.lane, 16); b1 += shx(b1, C.lane, 32);
                    const float scl = sigmoidf_(b1), sel = scl + brl;
                    const float x1 = dppf<DPP_X1>(sel), x2 = dppf<DPP_X2>(sel), x3 = dppf<0x1B>(sel);
                    const float gsum = fmaxf(fmaxf(fmaxf(sel + x1, sel + x2), fmaxf(sel + x3, x1 + x2)), fmaxf(x1 + x3, x2 + x3));
                    float best = rlane(gsum, 0); int bg = 0;
#pragma unroll
                    for (int g = 1; g < 4; ++g) { const float gs = rlane(gsum, 4 * g); if (gs > best) { best = gs; bg = g; } }
                    float m1 = -1e30f, m2 = -1e30f, w1 = 0.f, w2 = 0.f; int e1 = 0, e2 = 0;
#pragma unroll
                    for (int q = 0; q < 4; ++q) { const int e = 4 * bg + q; const float x = rlane(sel, e), sv = rlane(scl, e);
                        if (x > m1) { m2 = m1; e2 = e1; w2 = w1; m1 = x; e1 = e; w1 = sv; } else if (x > m2) { m2 = x; e2 = e; w2 = sv; } }
                    if (r0 + k < re && C.lane == 0) { const int r = r0 + k, slot = C.wave * 32 + (r - rb); const float inv = 1.0f / (w1 + w2);
                        const int lp1 = __hip_atomic_fetch_add(lcnt + e1, 1, __ATOMIC_RELAXED, __HIP_MEMORY_SCOPE_WORKGROUP), lp2 = __hip_atomic_fetch_add(lcnt + e2, 1, __ATOMIC_RELAXED, __HIP_MEMORY_SCOPE_WORKGROUP);
                        rt_row[slot] = r; rt_e[2 * slot] = e1; rt_e[2 * slot + 1] = e2; rt_lp[2 * slot] = lp1; rt_lp[2 * slot + 1] = lp2; rt_w[2 * slot] = w1 * inv; rt_w[2 * slot + 1] = w2 * inv; }
                }
            }
            __syncthreads();
            if (C.tid < 16) { const int n = lcnt[C.tid]; lcnt[16 + C.tid] = (n > 0) ? (int)__hip_atomic_fetch_add(cnt + 64 * C.tid, (unsigned)n, __ATOMIC_RELAXED, __HIP_MEMORY_SCOPE_AGENT) : 0; }
            __syncthreads();
            if (C.lane < re - rb) { const int slot = C.wave * 32 + C.lane, r = rt_row[slot];
#pragma unroll
                for (int q = 0; q < 2; ++q) { const int e = rt_e[2 * slot + q], p = lcnt[16 + e] + rt_lp[2 * slot + q];
                    liste[(size_t)e * T + p] = r; roww[(size_t)e * T + p] = rt_w[2 * slot + q]; tokpos[2 * r + q] = (e << 20) | p; } }
            __syncthreads();
          }
        }
        SEAM(P + 7);

        if (EN(9) && IN(P + 8)) {
#pragma unroll 1
          for (int rep = 0; rep < NREP(9); ++rep) {
            PH();
            expert_prefix(ctl + CW_CNT + l * 1024, mrow0, pfxl, C.tid);
            constexpr int SW = 0x01010101 * (127 - FP8_WEXP), SA0 = 0x7f7f7f7f;
            pg8::GroupedOrder S{pfxl, C.G, C.vcu, DM / 2, (size_t)1024 * 1024, 0};
            { const int* liste = (const int*)(ws + WS_ROUTE + RO_LISTE); const unsigned* cnt = ctl + CW_CNT + l * 1024; pg8::Unit u;
#pragma unroll 1
              for (int i = 0; i < 8 && S.next(i, u); ++i) if (C.tid < 256) { const int idx = u.lt * 256 + C.tid;
                  gtab[i * 256 + C.tid] = (u.e == 16) ? (mrow0 + idx) : ((idx < (int)cnt[64 * u.e]) ? liste[(size_t)u.e * T + idx] : mrow0); } }
            __syncthreads();
            pg8::EpiGlu E{HH};
            pg8::gemm_phase<pg8::EpiGlu, pg8::GroupedOrder, true, 2>(C.lds, R1, DM / 2, WB + WO_GU, DM / 2, S, E, gtab, SW, SA0, 1.0f / (float)(1 << (I8_AEXP + I8_WEXP)));
            if (l + 1 < NLAYER) { const int nu = 4 * __builtin_amdgcn_readfirstlane(pfxl[17]); if ((nu + C.G - 1 - C.vcu) / C.G < (nu + C.G - 1) / C.G) (void)convert_steal(C, l + 1, CONV_NQUEUE, 2); }
          }
        }
        SEAM(P + 8);

        if (EN(10) && IN(P + 9)) {
#pragma unroll 1
          for (int rep = 0; rep < NREP(10); ++rep) {
            PH();
            if (!IN(P + 8)) expert_prefix(ctl + CW_CNT + l * 1024, mrow0, pfxl, C.tid);
            constexpr int SW = 0x01010101 * (127 - FP8_WEXP), SA = 0x01010101 * (127 - FP8_AEXP);
            pg8::GroupedOrder S{pfxl, C.G, C.vcu, FF / 2, (size_t)1024 * 512, (size_t)256 * FF};
            pg8::EpiDown E{(unsigned char*)PROJ, (const float*)(ws + WS_ROUTE + RO_ROWW)};
            pg8::gemm_phase<pg8::EpiDown, pg8::GroupedOrder, false, 1>(C.lds, HH, FF / 2, WB + WO_DN, FF / 2, S, E, gtab, SW, SA);
            if (l + 1 < NLAYER) { const int nu = 4 * __builtin_amdgcn_readfirstlane(pfxl[17]); if ((nu + C.G - 1 - C.vcu) / C.G < (nu + C.G - 1) / C.G) (void)convert_steal(C, l + 1, CONV_NQUEUE, 2); }
          }
        }
        SEAM(P + 9);
    }

    if (EN(11) && IN(NPHASE - 1)) {
#pragma unroll 1
      for (int rep = 0; rep < NREP(11); ++rep) {
        const int l = NLAYER - 1; PH();
        if (!IN(NPHASE - 3)) expert_prefix(ctl + CW_CNT + (NLAYER - 1) * 1024, TC, pfxl, C.tid);
        LAS float* mt = (LAS float*)C.lds; mod_chunk_to_lds(mt, modl, 5, C.tid); __syncthreads();
        int rb, re; wave_rows(C.gw, C.NGW, TC, T, rb, re);
        constexpr int NB = 4;
        CombIdx cn[NB];
#pragma unroll
        for (int k = 0; k < NB; ++k) { const int r = (rb + k < re) ? rb + k : re - 1; cn[k] = comb_idx(C, r, pfxl, TC); }
        for (int r0 = rb; r0 < re; r0 += NB) {
            f32x4 v[NB][4]; unsigned y[NB][3][4]; CombIdx ci[NB];
#pragma unroll
            for (int k = 0; k < NB; ++k) { const int r = (r0 + k < re) ? r0 + k : re - 1; ci[k] = cn[k]; xs_load(XS + (size_t)r * DM, C.lane, v[k]); }
#pragma unroll
            for (int k = 0; k < NB; ++k) comb_load(C, ci[k], y[k]);
#pragma unroll
            for (int k = 0; k < NB; ++k) { const int r = (r0 + NB + k < re) ? r0 + NB + k : re - 1; cn[k] = comb_idx(C, r, pfxl, TC); }
#pragma unroll
            for (int k = 0; k < NB; ++k) if (r0 + k < re) { const int r = r0 + k, which = (r - TC) >> 12; comb_apply(C, mt + which * DM, y[k], v[k]); float* dst = COUT + (size_t)(r - TC) * DM;
#pragma unroll
                for (int j = 0; j < 4; ++j) *(f32x4*)(dst + j * 256 + 4 * C.lane) = v[k][j]; }
        }
      }
    }
#undef IN
#undef SEAM
}

#ifndef MK_PER_PHASE
#define MK_PER_PHASE 0
#endif
extern "C" void kernel_launch(void* const* d_in, const int* in_sizes, int n_in, void* d_out, int out_size, void* d_ws, size_t ws_size, hipStream_t stream) {
    static int grid = 0;
    if (grid == 0) {
        if (n_in != 28 || out_size != TL * DM || ws_size < WS_END) { fprintf(stderr, "kernel_launch: unexpected shapes (n_in %d, out %d, ws %zu)\n", n_in, out_size, ws_size); grid = -1; return; }
        int dev = 0, cus = 0, per_cu = 0;
        if (hipGetDevice(&dev) != hipSuccess || hipDeviceGetAttribute(&cus, hipDeviceAttributeMultiprocessorCount, dev) != hipSuccess) { grid = -1; return; }
        if (hipFuncSetAttribute((const void*)fwd_kernel, hipFuncAttributeMaxDynamicSharedMemorySize, LDS_BYTES) != hipSuccess) { fprintf(stderr, "kernel_launch: hipFuncSetAttribute failed\n"); grid = -1; return; }
        if (hipOccupancyMaxActiveBlocksPerMultiprocessor(&per_cu, (const void*)fwd_kernel, NTHR, LDS_BYTES) != hipSuccess || per_cu < 1) { fprintf(stderr, "kernel_launch: occupancy query says %d\n", per_cu); }
        (void)hipGetLastError();
        grid = cus;
    }
    if (grid < 0) return;
    (void)hipMemsetAsync((char*)d_ws + WS_CTL, 0, CTL_ZERO_BYTES, stream);
    Args a{};
    for (int i = 0; i < 28; ++i) a.in[i] = (const float*)d_in[i];
    a.out = (float*)d_out; a.ws = (unsigned char*)d_ws;
#if MK_PER_PHASE
    for (int p = 0; p < NPHASE; ++p) { a.ph_lo = p; a.ph_hi = p + 1; a.li = p; hipLaunchKernelGGL(fwd_kernel, dim3(grid), dim3(NTHR), LDS_BYTES, stream, a); }
#else
    a.ph_lo = 0; a.ph_hi = NPHASE; a.li = 0;
    hipLaunchKernelGGL(fwd_kernel, dim3(grid), dim3(NTHR), LDS_BYTES, stream, a);
#endif
}
```

```cpp
#define REPMASK 0x00
#define BARX 1
#include <hip/hip_runtime.h>
#ifdef MK_PER_PHASE
#define MK_PER_PHASE_ MK_PER_PHASE
#else
#define MK_PER_PHASE_ 0
#endif
#include <cstdio>
#include <cstdint>

#define GAS __attribute__((address_space(1)))
#define LAS __attribute__((address_space(3)))
typedef unsigned short bf16;
typedef short bf16x8 __attribute__((ext_vector_type(8)));
typedef short s16x4 __attribute__((ext_vector_type(4)));
typedef float f32x2 __attribute__((ext_vector_type(2)));
typedef float f32x4 __attribute__((ext_vector_type(4)));
typedef float f32x16 __attribute__((ext_vector_type(16)));
typedef unsigned u32x2 __attribute__((ext_vector_type(2)));
typedef unsigned u32x4 __attribute__((ext_vector_type(4)));

constexpr int DM = 1024, NB = 4, SEQ = 4096, CTXL = 256, NLAYER = 2;
constexpr int TC = NB * CTXL;
constexpr int TL = NB * SEQ;
constexpr int T = TC + TL;
constexpr int LK = CTXL + SEQ;
constexpr int INC = 3232, INCP = 3328;
constexpr int C_CQ = 0, C_CKV = 256, C_KR = 384, C_QB = 416, C_KB = 928, C_VB = 1056, C_GA = 1184, C_GB = 2208;
constexpr int PQ8 = 1024, PK8 = 1536, PV8 = 1664;
constexpr int PROW = INCP * 2, GA8 = 2560, GB8 = 3584;
constexpr int NEXP = 16, FF = 512;
constexpr float EPS = 1e-6f;
constexpr float LOG2E = 1.4426950408889634f;
constexpr float SCA = 0.10206207261596575f * LOG2E;
constexpr float SCB = 0.125f * LOG2E;
constexpr int NWAVES = 8, NTHR = 512;

constexpr size_t MiB = 1u << 20;
constexpr size_t WS_CTL = 0, CTL_ZERO_BYTES = (MK_PER_PHASE_ ? 1024 : 64) * 1024;
constexpr size_t WS_MISC = 1 * MiB;
constexpr size_t WS_CTXS = 2 * MiB;
constexpr size_t WS_ROUTE = 6 * MiB;
constexpr size_t WS_W = 9 * MiB;
constexpr size_t WS_R1 = 73 * MiB;
constexpr size_t WS_R2 = 107 * MiB;
constexpr size_t WS_R3 = 218 * MiB;
constexpr size_t WS_R4 = 286 * MiB;
constexpr size_t WS_R5 = 312 * MiB;
constexpr size_t WS_END = 346 * MiB;
constexpr size_t MO_MODV = 0;
constexpr size_t MO_TABA = 256 * 1024;
constexpr size_t MO_TABB = MO_TABA + 4096;
constexpr size_t MO_CB = MO_TABB + 8192;
constexpr size_t RO_LISTE = 0;
constexpr size_t RO_ROWW = (size_t)NEXP * T * 4;
constexpr size_t RO_TOKPOS = 2 * RO_ROWW;
constexpr size_t WO_IN = 0;
constexpr size_t WO_UQ = WO_IN + (size_t)INCP * 1024 / 2;
constexpr size_t WO_UKV = WO_UQ + 768 * 256;
constexpr size_t WO_OA = WO_UKV + 1024 * 256;
constexpr size_t WO_OUT = WO_OA + 1024 * 1024 / 2;
constexpr size_t WO_GU = WO_OUT + 1024 * 1024 / 2;
constexpr size_t WO_DN = WO_GU + (size_t)17 * 1024 * 1024 / 2;
constexpr size_t WO_END = WO_DN + (size_t)17 * 1024 * 512 / 2;
constexpr size_t WL_STRIDE = 16 * MiB;
static_assert(WO_END <= WL_STRIDE && WS_W + 2 * WL_STRIDE * 2 <= WS_R1, "weights region");
constexpr size_t R3_KA = 0, R3_VA = (size_t)T * 1024, R3_QB = R3_VA + (size_t)T * 512 * 2, R3_KB = R3_QB + (size_t)T * 512, R3_VB = R3_KB + (size_t)T * 128, R3_QA = R3_VB + (size_t)T * 128 * 2;
constexpr size_t R3_Y1 = 0, R3_Y = (size_t)T * 1024 * 2, R3_HH = 0;
constexpr int HHROWS = 3 * T + 17 * 256;
static_assert(R3_QA + (size_t)T * 1024 <= 68 * MiB && (size_t)HHROWS * 512 * 2 <= 68 * MiB && (size_t)HHROWS * 1024 * 2 <= 111 * MiB, "regions");
constexpr int CW_STEAL = 512;
constexpr int CW_CNT = 1024;
constexpr int CW_BAR = 4096;

constexpr int RING_BYTES = 131072;
constexpr int LDSX_OFF = RING_BYTES;
constexpr int LDSX_GTAB = LDSX_OFF;
constexpr int LDSX_PFX = LDSX_OFF + 8192;
constexpr int LDSX_MISC = LDSX_OFF + 8192 + 256;
constexpr int LDS_BYTES = 147456;

__device__ __forceinline__ unsigned f2bf(float f) { unsigned u = __builtin_bit_cast(unsigned, f); return (u + 0x7fffu + ((u >> 16) & 1u)) >> 16; }
typedef __bf16 bf16x2_hw __attribute__((ext_vector_type(2)));
__device__ __forceinline__ unsigned pk2(float lo, float hi) { const f32x2 v = {lo, hi}; return __builtin_bit_cast(unsigned, __builtin_convertvector(v, bf16x2_hw)); }
__device__ __forceinline__ unsigned pk4_fp8(float a, float b, float c, float d) { int w = 0; w = __builtin_amdgcn_cvt_pk_fp8_f32(a, b, w, false); w = __builtin_amdgcn_cvt_pk_fp8_f32(c, d, w, true); return (unsigned)w; }
constexpr int I8_AEXP = 4, I8_WEXP = 9;
__device__ __forceinline__ unsigned pk4_i8(float a, float b, float c, float d, float scl) {
    const float M = 12582912.0f;
    const unsigned qa = __builtin_bit_cast(unsigned, __builtin_amdgcn_fmed3f(a * scl, -127.f, 127.f) + M), qb = __builtin_bit_cast(unsigned, __builtin_amdgcn_fmed3f(b * scl, -127.f, 127.f) + M);
    const unsigned qc = __builtin_bit_cast(unsigned, __builtin_amdgcn_fmed3f(c * scl, -127.f, 127.f) + M), qd = __builtin_bit_cast(unsigned, __builtin_amdgcn_fmed3f(d * scl, -127.f, 127.f) + M);
    const unsigned lo = __builtin_amdgcn_perm(qb, qa, 0x0c0c0400u), hi = __builtin_amdgcn_perm(qd, qc, 0x0c0c0400u);
    return __builtin_amdgcn_perm(hi, lo, 0x05040100u);
}
__device__ __forceinline__ unsigned pk4_fp8_sat(float a, float b, float c, float d) {
    return pk4_fp8(__builtin_amdgcn_fmed3f(a, -448.f, 448.f), __builtin_amdgcn_fmed3f(b, -448.f, 448.f), __builtin_amdgcn_fmed3f(c, -448.f, 448.f), __builtin_amdgcn_fmed3f(d, -448.f, 448.f)); }
constexpr int FP8_WEXP = 5;
constexpr int FP8_AEXP = 3;
__device__ __forceinline__ float bflo(unsigned w) { return __builtin_bit_cast(float, w << 16); }
__device__ __forceinline__ float bfhi(unsigned w) { return __builtin_bit_cast(float, w & 0xffff0000u); }
template <int CTRL> __device__ __forceinline__ float dppf(float v) { return __builtin_bit_cast(float, __builtin_amdgcn_update_dpp(0, __builtin_bit_cast(int, v), CTRL, 0xF, 0xF, true)); }
#define DPP_X1 0xB1
#define DPP_X2 0x4E
#define DPP_HM 0x141
#define DPP_RM 0x140
__device__ __forceinline__ float rlane(float v, int l) { return __builtin_bit_cast(float, __builtin_amdgcn_readlane(__builtin_bit_cast(int, v), l)); }
__device__ __forceinline__ float row_sum16(float v) { v += dppf<DPP_X1>(v); v += dppf<DPP_X2>(v); v += dppf<DPP_HM>(v); v += dppf<DPP_RM>(v); return v; }
__device__ __forceinline__ float wave_sum(float v, int) { v = row_sum16(v); return (rlane(v, 0) + rlane(v, 16)) + (rlane(v, 32) + rlane(v, 48)); }
__device__ __forceinline__ float sum8(float v, int) { v += dppf<DPP_X1>(v); v += dppf<DPP_X2>(v); v += dppf<DPP_HM>(v); return v; }
__device__ __forceinline__ float shx(float v, int lane, int o) { return __builtin_bit_cast(float, __builtin_amdgcn_ds_bpermute((lane ^ o) << 2, __builtin_bit_cast(int, v))); }
__device__ __forceinline__ float sigmoidf_(float x) { return __builtin_amdgcn_rcpf(1.0f + __builtin_amdgcn_exp2f(-x * LOG2E)); }
__device__ __forceinline__ f32x4 sigmoid4(f32x4 x) {
    const f32x4 t = x * (-LOG2E); f32x4 e; e.x = __builtin_amdgcn_exp2f(t.x); e.y = __builtin_amdgcn_exp2f(t.y); e.z = __builtin_amdgcn_exp2f(t.z); e.w = __builtin_amdgcn_exp2f(t.w);
    const f32x4 d = e + 1.0f; f32x4 r; r.x = __builtin_amdgcn_rcpf(d.x); r.y = __builtin_amdgcn_rcpf(d.y); r.z = __builtin_amdgcn_rcpf(d.z); r.w = __builtin_amdgcn_rcpf(d.w); return r;
}
#define LDS_WAIT() asm volatile("s_waitcnt lgkmcnt(0)" ::: "memory")
#define VM_WAIT() asm volatile("s_waitcnt vmcnt(0)" ::: "memory")

namespace pg8 {
constexpr int BM = 256, BK = 64, HALF = 128, HTB = HALF * BK * 2, STAGE_BYTES = 8 * HTB, NXCD = 8, WGM = 8;
__device__ __forceinline__ int lds_byte(int r, int c) { const int st = (r >> 4) * 2 + (c >> 5), rr = r & 15, cc = c & 31, ob = rr * 64 + cc * 2; return st * 1024 + (ob ^ (((ob >> 9) & 1) << 5)); }
__device__ __forceinline__ void stage_rc(int b, int& R, int& C) { const int st = b / 1024, sb = b % 1024, swz = sb ^ (((sb >> 9) & 1) << 5); R = (st >> 1) * 16 + swz / 64; C = (st & 1) * 32 + (swz % 64) / 2; }
__device__ __forceinline__ int perm32(int rho) { const int n = rho >> 4, i = rho & 15; return 8 * (i >> 2) + 4 * n + (i & 3); }

struct Unit { int pm, pn, e, lt; };

struct StaticOrder {
    int nM, nN, nwg, G, c, lda, K;
    __device__ __forceinline__ void init(int M, int N, int G_, int c_, int lda_, int K_) { nM = M / BM; nN = N / BM; nwg = nM * nN; G = G_; c = c_; lda = lda_; K = K_; }
    __device__ __forceinline__ bool next(int i, Unit& u) const {
        const long L = (long)i * G + c; if (L >= nwg) return false;
        int wgid = (int)L; { const int q = nwg / NXCD, r = nwg % NXCD, xcd = wgid % NXCD, off = wgid / NXCD; wgid = (xcd < r ? xcd * (q + 1) : r * (q + 1) + (xcd - r) * q) + off; }
        const int nig = WGM * nN, gid = wgid / nig, fm = gid * WGM, gsz = (nM - fm) < WGM ? (nM - fm) : WGM;
        u.pm = fm + ((wgid % nig) % gsz); u.pn = (wgid % nig) / gsz; u.e = 0; u.lt = 0; return true;
    }
    __device__ __forceinline__ size_t a_off(const Unit& u) const { return (size_t)u.pm * BM * lda * 2; }
    __device__ __forceinline__ size_t b_off(const Unit& u) const { return (size_t)u.pn * BM * K * 2; }
};
struct GroupedOrder {
    const LAS int* pfx; int G, vcu, K; size_t estride;
    size_t a_stride;
    __device__ __forceinline__ bool next(int i, Unit& u) const {
        const int U = i * G + vcu, ntl = __builtin_amdgcn_readfirstlane(pfx[17]);
        if (U >= ntl * 4) return false;
        const int rt = U >> 2; int e = 0;
#pragma unroll
        for (int k = 1; k < 17; ++k) e += (rt >= __builtin_amdgcn_readfirstlane(pfx[k])) ? 1 : 0;
        u.pm = rt; u.pn = U & 3; u.e = e; u.lt = rt - __builtin_amdgcn_readfirstlane(pfx[e]); return true;
    }
    __device__ __forceinline__ size_t a_off(const Unit& u) const { return (size_t)u.pm * a_stride; }
    __device__ __forceinline__ size_t b_off(const Unit& u) const { return (size_t)u.e * estride + (size_t)u.pn * BM * K * 2; }
};

__device__ __forceinline__ unsigned cvt_pk_bf16(float lo, float hi) { unsigned r; asm volatile("v_cvt_pk_bf16_f32 %0, %1, %2" : "=v"(r) : "v"(lo), "v"(hi)); return r; }

#define OPAQ(x) asm volatile("" : "+v"(x))
struct EpiBf16 {
    static constexpr bool PERM = true, WIDE = false; static constexpr int NPRE = 0;
    bf16* O; int ldc;
    __device__ __forceinline__ void operator()(const f32x4 (&acc)[2][2][4][2], const Unit& u, int wr, int wc, int fr, int fq) const {
        char* base = (char*)(O + (size_t)u.pm * BM * ldc + u.pn * BM);
        unsigned off = (unsigned)((wr * 64 + fr) * ldc + wc * 32 + 8 * fq) * 2u; OPAQ(off);
#pragma unroll
        for (int ai = 0; ai < 2; ++ai)
#pragma unroll
          for (int m = 0; m < 4; ++m) {
#pragma unroll
            for (int bj = 0; bj < 2; ++bj) { const f32x4 v0 = acc[ai][bj][m][0], v1 = acc[ai][bj][m][1];
                u32x4 w; w.x = cvt_pk_bf16(v0[0], v0[1]); w.y = cvt_pk_bf16(v0[2], v0[3]); w.z = cvt_pk_bf16(v1[0], v1[1]); w.w = cvt_pk_bf16(v1[2], v1[3]);
                *(u32x4*)(base + off + bj * HALF * 2) = w; }
            off += (unsigned)((m == 3 ? 80 : 16) * ldc) * 2u; OPAQ(off); }
    }
};
struct EpiF8 {
    static constexpr bool PERM = true, WIDE = true; static constexpr int NPRE = 0;
    unsigned char* O; int ldc;
    __device__ __forceinline__ void operator()(const f32x4 (&acc)[2][2][4][2], const Unit& u, int wr, int wc, int fr, int fq) const {
        char* base = (char*)O + (size_t)u.pm * BM * ldc + u.pn * BM;
        unsigned off = (unsigned)((wr * 64 + fr) * ldc + wc * 64 + 16 * fq); OPAQ(off);
        constexpr float sa = (float)(1 << FP8_AEXP);
#pragma unroll
        for (int ai = 0; ai < 2; ++ai)
#pragma unroll
          for (int m = 0; m < 4; ++m) {
            const f32x4 v0 = acc[ai][0][m][0] * sa, v1 = acc[ai][0][m][1] * sa, v2 = acc[ai][1][m][0] * sa, v3 = acc[ai][1][m][1] * sa;
            u32x4 w; w.x = pk4_fp8_sat(v0[0], v0[1], v0[2], v0[3]); w.y = pk4_fp8_sat(v1[0], v1[1], v1[2], v1[3]); w.z = pk4_fp8_sat(v2[0], v2[1], v2[2], v2[3]); w.w = pk4_fp8_sat(v3[0], v3[1], v3[2], v3[3]);
            *(u32x4*)(base + off) = w;
            off += (unsigned)((m == 3 ? 80 : 16) * ldc); OPAQ(off); }
    }
};
struct EpiProj {
    static constexpr bool PERM = true, WIDE = false; static constexpr int NPRE = 0;
    bf16* O;
    __device__ __forceinline__ void operator()(const f32x4 (&acc)[2][2][4][2], const Unit& u, int wr, int wc, int fr, int fq) const {
        if (u.pn >= 2 && u.pn < 5) {
            char* base = (char*)O + (size_t)u.pm * BM * PROW + PQ8 + (u.pn - 2) * BM;
            unsigned off = (unsigned)((wr * 64 + fr) * PROW + wc * 32 + 8 * fq); OPAQ(off);
            constexpr float sa = (float)(1 << FP8_AEXP);
#pragma unroll
            for (int ai = 0; ai < 2; ++ai)
#pragma unroll
              for (int m = 0; m < 4; ++m) {
#pragma unroll
                for (int bj = 0; bj < 2; ++bj) { const f32x4 v0 = acc[ai][bj][m][0] * sa, v1 = acc[ai][bj][m][1] * sa;
                    u32x2 w; w.x = pk4_fp8_sat(v0[0], v0[1], v0[2], v0[3]); w.y = pk4_fp8_sat(v1[0], v1[1], v1[2], v1[3]);
                    *(u32x2*)(base + off + bj * HALF) = w; }
                off += (unsigned)((m == 3 ? 80 : 16) * PROW); OPAQ(off); }
        } else if (u.pn < 2) {
            char* base = (char*)(O + (size_t)u.pm * BM * INCP + u.pn * BM);
            unsigned off = (unsigned)((wr * 64 + fr) * INCP + wc * 32 + 8 * fq) * 2u; OPAQ(off);
#pragma unroll
            for (int ai = 0; ai < 2; ++ai)
#pragma unroll
              for (int m = 0; m < 4; ++m) {
#pragma unroll
                for (int bj = 0; bj < 2; ++bj) { const f32x4 v0 = acc[ai][bj][m][0], v1 = acc[ai][bj][m][1];
                    u32x4 w; w.x = cvt_pk_bf16(v0[0], v0[1]); w.y = cvt_pk_bf16(v0[2], v0[3]); w.z = cvt_pk_bf16(v1[0], v1[1]); w.w = cvt_pk_bf16(v1[2], v1[3]);
                    *(u32x4*)(base + off + bj * HALF * 2) = w; }
                off += (unsigned)((m == 3 ? 80 : 16) * INCP) * 2u; OPAQ(off); }
        } else {
            char* base = (char*)O + (size_t)u.pm * BM * PROW + GA8 + (u.pn - 5) * BM;
            unsigned off = (unsigned)((wr * 64 + fr) * PROW + wc * 32 + 8 * fq); OPAQ(off);
#pragma unroll
            for (int ai = 0; ai < 2; ++ai)
#pragma unroll
              for (int m = 0; m < 4; ++m) {
#pragma unroll
                for (int bj = 0; bj < 2; ++bj) { u32x2 w;
#pragma unroll
                    for (int n = 0; n < 2; ++n) { const f32x4 y = sigmoid4(acc[ai][bj][m][n]) * 255.0f + 0.5f;
                        const unsigned pk = (unsigned)y.x | ((unsigned)y.y << 8) | ((unsigned)y.z << 16) | ((unsigned)y.w << 24); if (n == 0) w.x = pk; else w.y = pk; }
                    *(u32x2*)(base + off + bj * HALF) = w; }
                off += (unsigned)((m == 3 ? 80 : 16) * PROW); OPAQ(off); }
        }
    }
};
template <bool SECOND> struct EpiGate {
    static constexpr bool PERM = true, WIDE = false; static constexpr int NPRE = 0;
    bf16* O; const bf16* Gt; const bf16* Y1;
    __device__ __forceinline__ void operator()(const f32x4 (&acc)[2][2][4][2], const Unit& u, int wr, int wc, int fr, int fq) const {
        char* obase = SECOND ? (char*)O + (size_t)u.pm * BM * DM + u.pn * BM : (char*)(O + (size_t)u.pm * BM * DM + u.pn * BM); const char* ybase = (const char*)(Y1 + (size_t)u.pm * BM * DM + u.pn * BM);
        const char* gbase = (const char*)(Gt + (size_t)u.pm * BM * INCP + u.pn * BM);
        unsigned off = (unsigned)((wr * 64 + fr) * DM + wc * 32 + 8 * fq) * 2u, goff = (unsigned)((wr * 64 + fr) * INCP + wc * 32 + 8 * fq) * 2u; OPAQ(off); OPAQ(goff);
#pragma unroll
        for (int ai = 0; ai < 2; ++ai)
#pragma unroll
          for (int m = 0; m < 4; ++m) {
#pragma unroll
            for (int bj = 0; bj < 2; ++bj) { const f32x4 v0 = acc[ai][bj][m][0], v1 = acc[ai][bj][m][1];
                const u32x4 g = *(const u32x4*)(gbase + goff + bj * HALF * 2);
                float r[8];
                r[0] = v0[0] * sigmoidf_(bflo(g.x)); r[1] = v0[1] * sigmoidf_(bfhi(g.x)); r[2] = v0[2] * sigmoidf_(bflo(g.y)); r[3] = v0[3] * sigmoidf_(bfhi(g.y));
                r[4] = v1[0] * sigmoidf_(bflo(g.z)); r[5] = v1[1] * sigmoidf_(bfhi(g.z)); r[6] = v1[2] * sigmoidf_(bflo(g.w)); r[7] = v1[3] * sigmoidf_(bfhi(g.w));
                if (SECOND) { const u32x4 y = *(const u32x4*)(ybase + off + bj * HALF * 2);
                    r[0] += bflo(y.x); r[1] += bfhi(y.x); r[2] += bflo(y.y); r[3] += bfhi(y.y); r[4] += bflo(y.z); r[5] += bfhi(y.z); r[6] += bflo(y.w); r[7] += bfhi(y.w); }
                if (SECOND) { constexpr float sa = (float)(1 << FP8_AEXP); u32x2 w; w.x = pk4_fp8(r[0] * sa, r[1] * sa, r[2] * sa, r[3] * sa); w.y = pk4_fp8(r[4] * sa, r[5] * sa, r[6] * sa, r[7] * sa);
                    *(u32x2*)(obase + (off >> 1) + bj * HALF) = w; }
                else { u32x4 w; w.x = cvt_pk_bf16(r[0], r[1]); w.y = cvt_pk_bf16(r[2], r[3]); w.z = cvt_pk_bf16(r[4], r[5]); w.w = cvt_pk_bf16(r[6], r[7]);
                    *(u32x4*)(obase + off + bj * HALF * 2) = w; } }
            off += (unsigned)((m == 3 ? 80 : 16) * DM) * 2u; goff += (unsigned)((m == 3 ? 80 : 16) * INCP) * 2u; OPAQ(off); OPAQ(goff); }
    }
};
struct EpiGateF {
    static constexpr bool PERM = true, WIDE = true; static constexpr int NPRE = 0;
    unsigned char* O; const unsigned char* G;
    __device__ __forceinline__ static float ub(unsigned w, int i) { return (float)((w >> (8 * i)) & 0xffu); }
    __device__ __forceinline__ void mid(f32x4 (&acc)[2][2][4][2], const Unit& u, int wr, int wc, int fr, int fq) const {
        const char* gbase = (const char*)G + (size_t)u.pm * BM * PROW + u.pn * BM;
        unsigned gl = (unsigned)((wr * 64 + fr) * PROW + wc * 64 + 16 * fq); OPAQ(gl);
        u32x4 ra[8], rb[8];
#pragma unroll
        for (int g = 0; g < 8; ++g) { ra[g] = *(const u32x4*)(gbase + GA8 + gl); rb[g] = *(const u32x4*)(gbase + GB8 + gl);
            gl += (unsigned)(((g & 3) == 3 ? 80 : 16) * PROW); OPAQ(gl); }
#pragma unroll
        for (int g = 0; g < 8; ++g) { const int ai = g >> 2, m = g & 3;
            const u32x4 a = ra[g], b = rb[g];
#pragma unroll
            for (int bj = 0; bj < 2; ++bj)
#pragma unroll
                for (int n = 0; n < 2; ++n) { const unsigned wa = a[2 * bj + n], wb = b[2 * bj + n];
#pragma unroll
                    for (int k = 0; k < 4; ++k) acc[ai][bj][m][n][k] *= ub(wa, k) * __builtin_amdgcn_rcpf(fmaxf(ub(wb, k), 1.0f)); } }
    }
    __device__ __forceinline__ void operator()(const f32x4 (&acc)[2][2][4][2], const Unit& u, int wr, int wc, int fr, int fq) const {
        char* obase = (char*)O + (size_t)u.pm * BM * DM + u.pn * BM; const char* gbase = (const char*)G + (size_t)u.pm * BM * PROW + GB8 + u.pn * BM;
        unsigned off = (unsigned)((wr * 64 + fr) * DM + wc * 64 + 16 * fq), gl = (unsigned)((wr * 64 + fr) * PROW + wc * 64 + 16 * fq); OPAQ(off); OPAQ(gl);
        constexpr float sa = (float)(1 << FP8_AEXP) / 255.0f;
        u32x4 rb[8];
#pragma unroll
        for (int g = 0; g < 8; ++g) { rb[g] = *(const u32x4*)(gbase + gl); gl += (unsigned)(((g & 3) == 3 ? 80 : 16) * PROW); OPAQ(gl); }
#pragma unroll
        for (int g = 0; g < 8; ++g) { const int ai = g >> 2, m = g & 3;
            const u32x4 b = rb[g]; u32x4 w4;
#pragma unroll
            for (int bj = 0; bj < 2; ++bj)
#pragma unroll
                for (int n = 0; n < 2; ++n) { const unsigned wb = b[2 * bj + n]; const f32x4 v = acc[ai][bj][m][n];
                    w4[2 * bj + n] = pk4_fp8_sat(v[0] * sa * fmaxf(ub(wb, 0), 1.0f), v[1] * sa * fmaxf(ub(wb, 1), 1.0f), v[2] * sa * fmaxf(ub(wb, 2), 1.0f), v[3] * sa * fmaxf(ub(wb, 3), 1.0f)); }
            *(u32x4*)(obase + off) = w4;
            off += (unsigned)((m == 3 ? 80 : 16) * DM); OPAQ(off); }
    }
};
struct EpiRes {
    static constexpr bool PERM = true, WIDE = false; static constexpr int NPRE = 0;
    bf16* xs; const float* gtv;
    int rowbase, gch;
    __device__ __forceinline__ void operator()(const f32x4 (&acc)[2][2][4][2], const Unit& u, int wr, int wc, int fr, int fq) const {
        const int lrow = rowbase + u.pm * BM;
        const int which = (lrow < TC) ? 4 : ((lrow - TC) >> 12);
        const char* gt = (const char*)(gtv + ((size_t)which * 6 + gch) * DM + u.pn * BM);
        char* ob = (char*)(xs + (size_t)lrow * DM + u.pn * BM);
        unsigned off = (unsigned)((wr * 64 + fr) * DM + wc * 32 + 8 * fq) * 2u; const unsigned goff = (unsigned)(wc * 32 + 8 * fq) * 4u; OPAQ(off);
        f32x4 gv[2][2];
#pragma unroll
        for (int bj = 0; bj < 2; ++bj)
#pragma unroll
            for (int n = 0; n < 2; ++n) gv[bj][n] = *(const f32x4*)(gt + goff + (bj * HALF + n * 4) * 4);
        u32x4 rr[8][2]; unsigned ol = off;
#pragma unroll
        for (int g = 0; g < 8; ++g) {
#pragma unroll
            for (int bj = 0; bj < 2; ++bj) rr[g][bj] = *(const u32x4*)(ob + ol + bj * HALF * 2);
            ol += (unsigned)(((g & 3) == 3 ? 80 : 16) * DM) * 2u; OPAQ(ol); }
#pragma unroll
        for (int g = 0; g < 8; ++g) { const int ai = g >> 2, m = g & 3;
#pragma unroll
            for (int bj = 0; bj < 2; ++bj) { const u32x4 w_ = rr[g][bj];
                const f32x4 c0 = (f32x4){bflo(w_.x), bfhi(w_.x), bflo(w_.y), bfhi(w_.y)}, c1 = (f32x4){bflo(w_.z), bfhi(w_.z), bflo(w_.w), bfhi(w_.w)};
                const f32x4 o0 = c0 + gv[bj][0] * acc[ai][bj][m][0], o1 = c1 + gv[bj][1] * acc[ai][bj][m][1];
                u32x4 w; w.x = cvt_pk_bf16(o0[0], o0[1]); w.y = cvt_pk_bf16(o0[2], o0[3]); w.z = cvt_pk_bf16(o1[0], o1[1]); w.w = cvt_pk_bf16(o1[2], o1[3]); *(u32x4*)(ob + off + bj * HALF * 2) = w; }
            off += (unsigned)((m == 3 ? 80 : 16) * DM) * 2u; OPAQ(off); }
    }
};
struct EpiGlu {
    static constexpr bool PERM = true, WIDE = false; static constexpr int NPRE = 0;
    bf16* HH;
    __device__ __forceinline__ void operator()(const f32x4 (&acc)[2][2][4][2], const Unit& u, int wr, int wc, int fr, int fq) const {
        char* base = (char*)HH + (size_t)u.pm * BM * FF + u.pn * HALF;
        unsigned off = (unsigned)((wr * 64 + fr) * FF + wc * 32 + 8 * fq); OPAQ(off);
#pragma unroll
        for (int ai = 0; ai < 2; ++ai)
#pragma unroll
          for (int m = 0; m < 4; ++m) {
            constexpr float sa = (float)(1 << FP8_AEXP);
            const f32x4 g0 = acc[ai][0][m][0], g1 = acc[ai][0][m][1];
            const f32x4 r0 = (g0 * sigmoid4(g0)) * (acc[ai][1][m][0] * sa), r1 = (g1 * sigmoid4(g1)) * (acc[ai][1][m][1] * sa);
            u32x2 w; w.x = pk4_fp8_sat(r0.x, r0.y, r0.z, r0.w); w.y = pk4_fp8_sat(r1.x, r1.y, r1.z, r1.w);
            *(u32x2*)(base + off) = w;
            off += (unsigned)((m == 3 ? 80 : 16) * FF); OPAQ(off); }
    }
};
struct EpiDown {
    static constexpr bool PERM = true, WIDE = true; static constexpr int NPRE = 1;
    unsigned char* YE; const float* roww;
    __device__ __forceinline__ void pre(const Unit& u, int wr, int wid, int lane, LAS unsigned char* lds) const {
        if (u.e == 16) return;
        const float* rw = roww + (size_t)(u.e & 15) * T + u.lt * BM + wr * 64 + lane;
        LAS unsigned* dst = (LAS unsigned*)(lds + LDSX_OFF + 12288) + wid * 128;
        __builtin_amdgcn_global_load_lds((const unsigned*)rw, dst, 4, 0, 0);
        __builtin_amdgcn_global_load_lds((const unsigned*)(rw + HALF), dst + 64, 4, 0, 0);
    }
    __device__ __forceinline__ void operator()(const f32x4 (&acc)[2][2][4][2], const Unit& u, int wr, int wc, int fr, int fq, int wid, LAS unsigned char* lds) const {
        char* base = (char*)YE + (size_t)u.pm * BM * DM + u.pn * BM;
        unsigned off = (unsigned)((wr * 64 + fr) * DM + wc * 64 + 16 * fq); OPAQ(off);
        const LAS float* wl = (const LAS float*)(lds + LDSX_OFF + 12288) + wid * 128 + fr;
        float wts[8];
        asm volatile("" ::: "memory");
#pragma unroll
        for (int g = 0; g < 8; ++g) wts[g] = (u.e == 16) ? 1.0f : *(const volatile LAS float*)(wl + (g >> 2) * 64 + (g & 3) * 16);
#pragma unroll
        for (int ai = 0; ai < 2; ++ai)
#pragma unroll
          for (int m = 0; m < 4; ++m) {
            const float wt = wts[ai * 4 + m] * (float)(1 << FP8_AEXP);
            { const f32x4 v0 = acc[ai][0][m][0] * wt, v1 = acc[ai][0][m][1] * wt, v2 = acc[ai][1][m][0] * wt, v3 = acc[ai][1][m][1] * wt;
                u32x4 w; w.x = pk4_fp8_sat(v0[0], v0[1], v0[2], v0[3]); w.y = pk4_fp8_sat(v1[0], v1[1], v1[2], v1[3]); w.z = pk4_fp8_sat(v2[0], v2[1], v2[2], v2[3]); w.w = pk4_fp8_sat(v3[0], v3[1], v3[2], v3[3]);
                *(u32x4*)(base + off) = w; }
            off += (unsigned)((m == 3 ? 80 : 16) * DM); OPAQ(off); }
    }
};

typedef int i32x4v __attribute__((ext_vector_type(4)));
typedef int i32x8v __attribute__((ext_vector_type(8)));
template <class Epi, class Sched, bool GATHER, int MODE = 0, bool MIDK = false>
__device__ __forceinline__ void gemm_phase(LAS unsigned char* lds, const bf16* A, int lda, const bf16* Bt, int K, const Sched& S, const Epi& E, const LAS int* gtab, int sclW = 0x7f7f7f7f, int sclA = 0x7f7f7f7f, float deq = 1.0f) {
    constexpr bool FP8 = (MODE == 1), I8 = (MODE == 2);
    int tid_ = threadIdx.x; asm volatile("" : "+v"(tid_));
    const int tid = tid_, wid = __builtin_amdgcn_readfirstlane(tid >> 6), lane = tid & 63, wr = wid >> 2, wc = wid & 3, fr = lane & 15, fq = lane >> 4;
    const int nt = K / BK;
    int RA[2], CA[2];
    unsigned voffA[2][2], voffB[2];
#pragma unroll
    for (int i = 0; i < 2; ++i) { int R, C; stage_rc(tid * 16 + i * 8192, R, C); const int Rb = Epi::WIDE ? (64 * (R >> 5) + 16 * ((R & 15) >> 2) + 4 * ((R >> 4) & 1) + (R & 3)) : (Epi::PERM ? ((R & ~31) + perm32(R & 31)) : R);
        RA[i] = R; CA[i] = C; voffB[i] = (unsigned)(Rb * K + C) * 2u;
        voffA[0][i] = (unsigned)(R * lda + C) * 2u; voffA[1][i] = 0u; }
    const size_t kstep = (size_t)(BK * 2);
    const size_t hstepB = Epi::WIDE ? (size_t)8 * K * 2 : (size_t)HALF * K * 2;
    const size_t hstepA = GATHER ? (size_t)0 : (size_t)HALF * lda * 2;
    const unsigned ldsw = (unsigned)wid * 1024u;
    const int aoff = lds_byte(wr * 64 + fr, fq * 8), boff = lds_byte(wc * 32 + fr, fq * 8);
#define PG8_SA(b, h) (((b) * 2 + (h)) * HTB)
#define PG8_SB(b, h) ((4 + (b) * 2 + (h)) * HTB)
#define PG8_STA(b, h, gbase) do { _Pragma("unroll") for (int _i = 0; _i < 2; ++_i) \
        __builtin_amdgcn_global_load_lds((const unsigned*)((const char*)(gbase) + (h) * hstepA + voffA[GATHER ? (h) : 0][_i]), (LAS unsigned*)(lds + PG8_SA(b, h) + ldsw + _i * 8192), 16, 0, 0); } while (0)
#define PG8_STB(b, h, gbase) do { _Pragma("unroll") for (int _i = 0; _i < 2; ++_i) \
        __builtin_amdgcn_global_load_lds((const unsigned*)((const char*)(gbase) + (h) * hstepB + voffB[_i]), (LAS unsigned*)(lds + PG8_SB(b, h) + ldsw + _i * 8192), 16, 0, 0); } while (0)
#define PG8_LDA(dst, b, h) do { _Pragma("unroll") for (int m = 0; m < 4; ++m) _Pragma("unroll") for (int k = 0; k < 2; ++k) dst[m][k] = *(const LAS bf16x8*)(lds + PG8_SA(b, h) + aoff + m * 2048 + k * 1024); } while (0)
#define PG8_LDB(dst, b, h) do { _Pragma("unroll") for (int n = 0; n < 2; ++n) _Pragma("unroll") for (int k = 0; k < 2; ++k) dst[n][k] = *(const LAS bf16x8*)(lds + PG8_SB(b, h) + boff + n * 2048 + k * 1024); } while (0)
#define PG8_CAT(x) __builtin_shufflevector(__builtin_bit_cast(i32x4v, x[0]), __builtin_bit_cast(i32x4v, x[1]), 0, 1, 2, 3, 4, 5, 6, 7)
#define PG8_MMA(ai, bj, At, Bt_) do { __builtin_amdgcn_s_setprio(1); _Pragma("unroll") for (int m = 0; m < 4; ++m) _Pragma("unroll") for (int n = 0; n < 2; ++n) { \
        if constexpr (FP8) { const i32x8v a8_ = PG8_CAT(Bt_[n]), b8_ = PG8_CAT(At[m]);   \
            asm volatile("v_mfma_scale_f32_16x16x128_f8f6f4 %0, %1, %2, %0, %3, %4 op_sel_hi:[0,0,0]" : "+v"(acc[ai][bj][m][n]) : "v"(a8_), "v"(b8_), "v"(sclW), "v"(sclA)); } \
        else if constexpr (I8) { _Pragma("unroll") for (int k = 0; k < 2; ++k) acc[ai][bj][m][n] = __builtin_bit_cast(f32x4, __builtin_amdgcn_mfma_i32_16x16x64_i8(__builtin_bit_cast(i32x4v, Bt_[n][k]), __builtin_bit_cast(i32x4v, At[m][k]), __builtin_bit_cast(i32x4v, acc[ai][bj][m][n]), 0, 0, 0)); } \
        else { _Pragma("unroll") for (int k = 0; k < 2; ++k) acc[ai][bj][m][n] = __builtin_amdgcn_mfma_f32_16x16x32_bf16(Bt_[n][k], At[m][k], acc[ai][bj][m][n], 0, 0, 0); } } \
        __builtin_amdgcn_s_setprio(0); } while (0)
#define PG8_WAIT_V(n) asm volatile("s_waitcnt vmcnt(" #n ")" ::: "memory")
#define PG8_WAIT_L(n) asm volatile("s_waitcnt lgkmcnt(" #n ")" ::: "memory")
#define PG8_BAR __builtin_amdgcn_s_barrier()
#define PG8_SCHED __builtin_amdgcn_sched_barrier(0)
#define PG8_GLOAD(ui_) do { _Pragma("unroll") for (int _h = 0; _h < 2; ++_h) _Pragma("unroll") for (int _i = 0; _i < 2; ++_i) \
        voffA[_h][_i] = (unsigned)(gtab[(ui_) * 256 + _h * HALF + RA[_i]] * lda + CA[_i]) * 2u; } while (0)
    Unit cur, nxt; int ui = 0;
    if (!S.next(0, cur)) return;
    f32x4 acc[2][2][4][2];
#pragma unroll
    for (int a = 0; a < 2; ++a)
#pragma unroll
        for (int b = 0; b < 2; ++b)
#pragma unroll
            for (int m = 0; m < 4; ++m)
#pragma unroll
                for (int n = 0; n < 2; ++n) acc[a][b][m][n] = (f32x4){0.f, 0.f, 0.f, 0.f};
    bf16x8 At[4][2], B0[2][2], B1[2][2];
    if constexpr (GATHER) { PG8_GLOAD(0); }
    const char* cA = (const char*)A + S.a_off(cur); const char* cB = (const char*)Bt + S.b_off(cur);
    PG8_STB(0, 0, cB); PG8_STB(0, 1, cB); PG8_STA(0, 0, cA); PG8_STA(0, 1, cA);
    if (wr == 1) PG8_BAR;
    PG8_WAIT_V(2); PG8_BAR;
    PG8_STB(1, 0, cB + kstep); PG8_STA(1, 0, cA + kstep); PG8_STB(1, 1, cB + kstep);
    PG8_WAIT_V(6); PG8_BAR;
    for (;;) {
        const bool has_next = S.next(ui + 1, nxt);
        const char* nA = has_next ? (const char*)A + S.a_off(nxt) : cA; const char* nB = has_next ? (const char*)Bt + S.b_off(nxt) : cB;
#pragma unroll 1
        for (int t = 0; t < nt; t += 2) {
            const bool last = (t == nt - 2);
            if constexpr (MIDK) { if (t == nt / 2) { if constexpr (FP8) asm volatile("s_nop 15\n\ts_nop 15\n\ts_nop 15\n\ts_nop 15" ::: "memory"); E.mid(acc, cur, wr, wc, fr, fq); } }
            if constexpr (Epi::NPRE > 0) { if (last) E.pre(cur, wr, wid, lane, lds); }
            const char* a1 = cA + (size_t)(t + 1) * kstep;
            const char* a2 = last ? nA : cA + (size_t)(t + 2) * kstep; const char* b2 = last ? nB : cB + (size_t)(t + 2) * kstep;
            const char* a3 = a2 + kstep; const char* b3 = b2 + kstep;
            PG8_LDB(B0, 0, 0); PG8_LDB(B1, 0, 1); PG8_SCHED; PG8_LDA(At, 0, 0); PG8_STA(1, 1, a1);
            if constexpr (GATHER) { if (last && has_next) { PG8_GLOAD(ui + 1); } }
            PG8_WAIT_V(8); PG8_WAIT_L(0); PG8_BAR; PG8_MMA(0, 0, At, B0); PG8_MMA(0, 1, At, B1); PG8_BAR; PG8_SCHED;
            PG8_LDA(At, 0, 1); PG8_STB(0, 0, b2); PG8_STB(0, 1, b2); PG8_STA(0, 0, a2);
            PG8_WAIT_V(8); PG8_WAIT_L(0); PG8_BAR; PG8_MMA(1, 0, At, B0); PG8_MMA(1, 1, At, B1); PG8_BAR; PG8_SCHED;
            PG8_LDB(B0, 1, 0); PG8_LDB(B1, 1, 1); PG8_SCHED; PG8_LDA(At, 1, 0); PG8_STA(0, 1, a2);
            PG8_WAIT_V(8); PG8_WAIT_L(0); PG8_BAR; PG8_MMA(0, 0, At, B0); PG8_MMA(0, 1, At, B1); PG8_BAR; PG8_SCHED;
            PG8_LDA(At, 1, 1); PG8_STB(1, 0, b3); PG8_STB(1, 1, b3); PG8_STA(1, 0, a3);
            PG8_WAIT_V(8); PG8_WAIT_L(0); PG8_BAR; PG8_MMA(1, 0, At, B0); PG8_MMA(1, 1, At, B1); PG8_BAR; PG8_SCHED;
        }
        if (wr == 0) PG8_BAR;
        if constexpr (FP8) asm volatile("s_nop 15\n\ts_nop 15\n\ts_nop 15\n\ts_nop 15" ::: "memory");
        if constexpr (I8) {
#pragma unroll
            for (int a = 0; a < 2; ++a)
#pragma unroll
                for (int b = 0; b < 2; ++b)
#pragma unroll
                    for (int m = 0; m < 4; ++m)
#pragma unroll
                        for (int n = 0; n < 2; ++n) { const i32x4v q = __builtin_bit_cast(i32x4v, acc[a][b][m][n]); acc[a][b][m][n] = (f32x4){(float)q[0] * deq, (float)q[1] * deq, (float)q[2] * deq, (float)q[3] * deq}; } }
        if constexpr (Epi::NPRE > 0) E(acc, cur, wr, wc, fr, fq, wid, lds); else E(acc, cur, wr, wc, fr, fq);
        if (!has_next) break;
#pragma unroll
        for (int a = 0; a < 2; ++a)
#pragma unroll
            for (int b = 0; b < 2; ++b)
#pragma unroll
                for (int m = 0; m < 4; ++m)
#pragma unroll
                    for (int n = 0; n < 2; ++n) acc[a][b][m][n] = (f32x4){0.f, 0.f, 0.f, 0.f};
        cur = nxt; cA = nA; cB = nB; ++ui;
        if (wr == 1) PG8_BAR;
    }
    PG8_WAIT_V(0);
    PG8_BAR;
#undef PG8_SA
#undef PG8_SB
#undef PG8_STA
#undef PG8_STB
#undef PG8_LDA
#undef PG8_LDB
#undef PG8_MMA
#undef PG8_CAT
#undef PG8_WAIT_V
#undef PG8_WAIT_L
#undef PG8_BAR
#undef PG8_SCHED
#undef PG8_GLOAD
}
}

namespace att {
constexpr int KSLOT = 8192, VSLOT = 8192, NSLOT = 3;
constexpr int L_K = 0, L_V = NSLOT * KSLOT, L_OST = L_V + NSLOT * VSLOT, L_BYTES = L_OST + NWAVES * 2048;
constexpr int QEXP = 3;
static_assert(L_BYTES <= RING_BYTES, "attention LDS");
#define SBAR() __builtin_amdgcn_sched_barrier(0)
typedef int i32x4a __attribute__((ext_vector_type(4)));
typedef int i32x8a __attribute__((ext_vector_type(8)));
__device__ __forceinline__ int crow(int r, int hi) { return (r & 3) + 8 * (r >> 2) + 4 * hi; }
__device__ __forceinline__ void glds16(const void* gsrc, unsigned lds_dst) { unsigned keep;
    asm volatile("s_mov_b32 %0, m0\n\ts_mov_b32 m0, %2\n\ts_nop 0\n\tglobal_load_lds_dwordx4 %1, off\n\ts_mov_b32 m0, %0" : "=&s"(keep) : "v"(gsrc), "s"(lds_dst) : "memory"); }
typedef float f32x2_t __attribute__((ext_vector_type(2))); typedef __bf16 bf16x2_t __attribute__((ext_vector_type(2)));
__device__ __forceinline__ unsigned cvtpk_s(float lo, float hi) { f32x2_t v = {lo, hi}; bf16x2_t b = __builtin_convertvector(v, bf16x2_t); return __builtin_bit_cast(unsigned, b); }
typedef __attribute__((address_space(3))) const char* lds_cptr;
typedef short v4i16_t __attribute__((ext_vector_type(4)));
__device__ __forceinline__ s16x4 vtr(lds_cptr p) { return __builtin_bit_cast(s16x4, __builtin_amdgcn_ds_read_tr16_b64_v4i16((LAS v4i16_t*)p)); }
__device__ __forceinline__ i32x8a kfrag(lds_cptr kp, int idx) {
    const i32x4a a = *(const LAS i32x4a*)(kp + (idx >> 1) * 4096 + (idx & 1) * 512), b = *(const LAS i32x4a*)(kp + (idx >> 1) * 4096 + (idx & 1) * 512 + 1024);
    return __builtin_shufflevector(a, b, 0, 1, 2, 3, 4, 5, 6, 7);
}
template <int DQK>
__device__ __forceinline__ void attn_unit(const unsigned char* Qw, int qpitch, const unsigned char* Kh, int kpitch, const bf16* Vh, int vpitch, unsigned char* Ow, int NT, float negc, LAS unsigned char* shm) {
    constexpr int NG = (DQK == 96) ? 2 : 1;
    int tid_ = threadIdx.x; asm volatile("" : "+v"(tid_));
    const int tid = tid_, lane = tid & 63, r32 = lane & 31, hi = lane >> 5; const int wid = __builtin_amdgcn_readfirstlane(tid >> 6);
    const unsigned lds0 = (unsigned)(uintptr_t)shm;
    i32x8a qr8[NG];
#pragma unroll
    for (int g = 0; g < NG; ++g) { const unsigned char* qp = Qw + (size_t)r32 * qpitch + g * 64 + hi * 32;
        const i32x4a a = *(const i32x4a*)qp, b = *(const i32x4a*)(qp + 16); qr8[g] = __builtin_shufflevector(a, b, 0, 1, 2, 3, 4, 5, 6, 7); }
    const bool kw = (NG == 2) || (wid < 4);
    const unsigned char* ksrc = Kh + (size_t)lane * kpitch + wid * 16;
    const bf16* vsrc = Vh + (size_t)(16 * (wid & 3) + (lane >> 2)) * vpitch + (wid >> 2) * 32 + (lane & 3) * 8;
    const unsigned kdst = lds0 + L_K + wid * 1024, vdst = lds0 + L_V + wid * 1024;
#define DMA_K(t, ks) do { if (kw) glds16(ksrc + (size_t)(t) * 64 * kpitch, (unsigned)__builtin_amdgcn_readfirstlane(kdst + (ks))); } while (0)
#define DMA_V(t, vs) glds16(vsrc + (size_t)(t) * 64 * vpitch, (unsigned)__builtin_amdgcn_readfirstlane(vdst + (vs)))
#define WAIT_BAR(NV, NK) do { if (kw) asm volatile("s_waitcnt vmcnt(%0) lgkmcnt(0)\n\ts_barrier" :: "n"((NV) + (NK)) : "memory"); \
                              else    asm volatile("s_waitcnt vmcnt(%0) lgkmcnt(0)\n\ts_barrier" :: "n"(NV) : "memory"); } while (0)
    DMA_K(0, 0); DMA_V(0, 0); DMA_K(1, KSLOT); DMA_K(2, 2 * KSLOT);
    f32x16 o[2]; o[0] = f32x16{}; o[1] = f32x16{}; f32x4 o2 = (f32x4){0.f, 0.f, 0.f, 0.f};
    f32x16 negm;
#pragma unroll
    for (int r = 0; r < 16; ++r) negm[r] = negc;
    if constexpr (NG == 1) asm volatile("" : "+v"(negm));
    int sclK = 0x7f7f7f7f, sclQ = 0x01010101 * (127 - QEXP); asm volatile("" : "+v"(sclK), "+v"(sclQ));
    const short ind1 = ((((lane & 15) == 0) && (((lane >> 4) & 1) == 0)) || (((lane & 15) == 1) && (((lane >> 4) & 1) == 1))) ? (short)0x3F80 : (short)0;
    const bf16x8 ones = (bf16x8){ind1, ind1, ind1, ind1, ind1, ind1, ind1, ind1};
#define MFSUM(a, c) __builtin_amdgcn_mfma_f32_16x16x32_bf16(a, ones, c, 0, 0, 0)
    const lds_cptr shm3 = (lds_cptr)shm; const lds_cptr kp0 = shm3 + L_K + (2 * hi) * 1024 + r32 * 16;
    const lds_cptr vp0 = shm3 + L_V + ((lane >> 4) & 1) * 32 + (lane & 3) * 8 + (4 * hi + ((lane & 15) >> 2)) * 64;
    f32x16 pA0, pA1, pB0, pB1; i32x8a kf[2 * NG];
    int kprev = 0, kcur = 0, knext = KSLOT, vprev = 0, vcur = 0, vnext = VSLOT;
#define ROT() do { kprev = kcur; kcur = knext; knext = (knext == 2 * KSLOT) ? 0 : knext + KSLOT; vprev = vcur; vcur = vnext; vnext = (vnext == 2 * VSLOT) ? 0 : vnext + VSLOT; } while (0)
#define MF32(a, b, c) __builtin_amdgcn_mfma_f32_32x32x16_bf16(a, b, c, 0, 0, 0)
#define QK_FIRST(D, A, B) do { if constexpr (NG == 1) D = __builtin_amdgcn_mfma_scale_f32_32x32x64_f8f6f4(A, B, negm, 0, 0, 0, sclK, 0, sclQ); \
                               else D = __builtin_amdgcn_mfma_scale_f32_32x32x64_f8f6f4(A, B, f32x16{}, 0, 0, 0, sclK, 0, sclQ); } while (0)
#define QK_ACC(D, A, B) D = __builtin_amdgcn_mfma_scale_f32_32x32x64_f8f6f4(A, B, D, 0, 0, 0, sclK, 0, sclQ)
#define QK_SETTLE(X, Y) do { PIN(X); PIN(Y); } while (0)
#define KEEP(x) asm volatile("" :: "v"(x))
    WAIT_BAR(1, 2);
#pragma unroll
    for (int i = 0; i < 2 * NG; ++i) kf[i] = kfrag(kp0, i);
    QK_FIRST(pA0, kf[0], qr8[0]); QK_FIRST(pA1, kf[1], qr8[0]);
    if constexpr (NG == 2) { QK_ACC(pA0, kf[2], qr8[1]); QK_ACC(pA1, kf[3], qr8[1]); }
#pragma unroll
    for (int r = 0; r < 16; ++r) { pA0[r] = __builtin_amdgcn_exp2f(pA0[r]); pA1[r] = __builtin_amdgcn_exp2f(pA1[r]); }
    WAIT_BAR(0, 0);
    DMA_K(3, 0); DMA_V(1, VSLOT);
    ROT();
#pragma unroll
    for (int i = 0; i < 2 * NG; ++i) kf[i] = kfrag(kp0 + kcur, i);
    WAIT_BAR(1, 1);
    s16x4 vlo[8], vhi[8]; u32x4 pw0, pw1, pw2, pw3;
#define PKW(P, B) cvtpk_s(P[B], P[B + 1])
#define PAF(k) __builtin_bit_cast(bf16x8, pw##k)
#define VFR(i) (bf16x8){vlo[i][0], vlo[i][1], vlo[i][2], vlo[i][3], vhi[i][0], vhi[i][1], vhi[i][2], vhi[i][3]}
#define PIN(x) asm volatile("" : "+v"(x))
#define EX(v) __builtin_amdgcn_exp2f(v)
#define VRD(i) do { vlo[i] = vtr(vp_ + (((i) >> 2) * 4096 + ((i) & 3) * 1024)); vhi[i] = vtr(vp_ + (((i) >> 2) * 4096 + ((i) & 3) * 1024 + 512)); } while (0)
#define PACK4(PW, P, B) do { PW[0] = PKW(P, B); PW[1] = PKW(P, (B) + 2); PW[2] = PKW(P, (B) + 4); PW[3] = PKW(P, (B) + 6); PIN(PW); } while (0)
#define KRD(G, i) do { if (G) { kf[i] = kfrag(kp0 + knext, i); SBAR(); } } while (0)
#define EXI(C0, C1, i) do { if ((i) < 16) C0[(i) & 15] = EX(C0[(i) & 15]); else C1[(i) & 15] = EX(C1[(i) & 15]); } while (0)
#define GAPB3(MF, C0, C1, I0) do { MF; EXI(C0, C1, I0); EXI(C0, C1, (I0) + 1); EXI(C0, C1, (I0) + 2); PIN(C0); PIN(C1); SBAR(); } while (0)
#define GAPB2(MF, C0, C1, I0) do { MF; EXI(C0, C1, I0); EXI(C0, C1, (I0) + 1); PIN(C0); PIN(C1); SBAR(); } while (0)
#define STEP(C0, C1, P0, P1, t, GK, GV, GL) do { SBAR(); \
    const lds_cptr vp_ = vp0 + vprev; \
      \
    VRD(0); VRD(4); SBAR(); \
    QK_FIRST(C0, kf[0], qr8[0]); PACK4(pw0, P0, 0); VRD(1); VRD(5); SBAR(); \
    QK_FIRST(C1, kf[1], qr8[0]); KEEP(kf[0]); PACK4(pw1, P0, 8); VRD(2); VRD(6); SBAR(); \
    if constexpr (NG == 2) { QK_ACC(C0, kf[2], qr8[1]); KEEP(kf[1]); PACK4(pw2, P1, 0); VRD(3); VRD(7); SBAR(); \
                             QK_ACC(C1, kf[3], qr8[1]); KEEP(kf[2]); PACK4(pw3, P1, 8); SBAR(); } \
    else { PACK4(pw2, P1, 0); VRD(3); VRD(7); PACK4(pw3, P1, 8); SBAR(); } \
    if (GK) { DMA_K((t) + 3, kcur); } if (GV) { DMA_V((t) + 1, vnext); } \
    QK_SETTLE(C0, C1); KEEP(kf[2 * NG - 1]); SBAR(); \
      \
    GAPB3(o[0] = MF32(PAF(0), VFR(0), o[0]), C0, C1, 0); \
    KRD(GL, 0); GAPB3(o[1] = MF32(PAF(0), VFR(4), o[1]), C0, C1, 3); \
    KRD(GL, 1); GAPB3(o2 = MFSUM(PAF(0), o2), C0, C1, 6); \
    KRD(GL && NG == 2, 2); GAPB3(o[0] = MF32(PAF(1), VFR(1), o[0]), C0, C1, 9); \
    KRD(GL && NG == 2, 3); GAPB3(o[1] = MF32(PAF(1), VFR(5), o[1]), C0, C1, 12); \
    GAPB3(o2 = MFSUM(PAF(1), o2), C0, C1, 15); \
    GAPB3(o[0] = MF32(PAF(2), VFR(2), o[0]), C0, C1, 18); \
    GAPB3(o[1] = MF32(PAF(2), VFR(6), o[1]), C0, C1, 21); \
    GAPB2(o2 = MFSUM(PAF(2), o2), C0, C1, 24); \
    GAPB2(o[0] = MF32(PAF(3), VFR(3), o[0]), C0, C1, 26); \
    GAPB2(o[1] = MF32(PAF(3), VFR(7), o[1]), C0, C1, 28); \
    GAPB2(o2 = MFSUM(PAF(3), o2), C0, C1, 30); \
    } while (0)
#define ENDW(tt) do { if ((tt) + 3 < NT) { WAIT_BAR(1, 1); } else if ((tt) + 2 < NT) { WAIT_BAR(1, 0); } else { WAIT_BAR(0, 0); } } while (0)
    int t = 1;
    for (; t + 5 < NT; t += 2) {
        STEP(pB0, pB1, pA0, pA1, t, true, true, true);     WAIT_BAR(1, 1); ROT();
        STEP(pA0, pA1, pB0, pB1, t + 1, true, true, true); WAIT_BAR(1, 1); ROT();
    }
    for (; t + 1 < NT; t += 2) {
        STEP(pB0, pB1, pA0, pA1, t, (t + 3 < NT), (t + 1 < NT), (t + 1 < NT));         ENDW(t);     ROT();
        STEP(pA0, pA1, pB0, pB1, t + 1, (t + 4 < NT), (t + 2 < NT), (t + 2 < NT));     ENDW(t + 1); ROT();
    }
    STEP(pB0, pB1, pA0, pA1, NT - 1, false, false, false);
    { PACK4(pw0, pB0, 0); PACK4(pw1, pB0, 8); PACK4(pw2, pB1, 0); PACK4(pw3, pB1, 8);
      const lds_cptr vp_ = vp0 + vcur;
      VRD(0); VRD(1); VRD(2); VRD(3); VRD(4); VRD(5); VRD(6); VRD(7);
      o[0] = MF32(PAF(0), VFR(0), o[0]); o[1] = MF32(PAF(0), VFR(4), o[1]); o2 = MFSUM(PAF(0), o2);
      o[0] = MF32(PAF(1), VFR(1), o[0]); o[1] = MF32(PAF(1), VFR(5), o[1]); o2 = MFSUM(PAF(1), o2);
      o[0] = MF32(PAF(2), VFR(2), o[0]); o[1] = MF32(PAF(2), VFR(6), o[1]); o2 = MFSUM(PAF(2), o2);
      o[0] = MF32(PAF(3), VFR(3), o[0]); o[1] = MF32(PAF(3), VFR(7), o[1]); o2 = MFSUM(PAF(3), o2); }
#undef DMA_K
#undef DMA_V
#undef WAIT_BAR
#undef ROT
#undef MF32
#undef MFSUM
#undef QK_FIRST
#undef QK_ACC
#undef QK_SETTLE
#undef KEEP
#undef PKW
#undef PAF
#undef VFR
#undef PIN
#undef EX
#undef VRD
#undef PACK4
#undef KRD
#undef EXI
#undef GAPB3
#undef GAPB2
#undef STEP
#undef ENDW
    { LAS unsigned char* stg = (LAS unsigned char*)(shm + L_OST) + wid * 2048;
      LAS float* lq = (LAS float*)stg;
      if ((lane & 15) < 2) { const int q0 = 16 * (lane & 15) + 4 * (lane >> 4);
#pragma unroll
          for (int k = 0; k < 4; ++k) lq[q0 + k] = o2[k]; }
      asm volatile("s_waitcnt lgkmcnt(0)" ::: "memory");
      float rl[16];
#pragma unroll
      for (int r = 0; r < 16; ++r) rl[r] = lq[crow(r, hi)];
      asm volatile("s_waitcnt lgkmcnt(0)" ::: "memory");
      constexpr float sa = (float)(1 << FP8_AEXP);
#pragma unroll
      for (int r = 0; r < 16; ++r) { const int orow = crow(r, hi); const float sc = __builtin_amdgcn_rcpf(rl[r]) * sa;
#pragma unroll
        for (int d0 = 0; d0 < 2; ++d0) stg[orow * 64 + d0 * 32 + r32] = (unsigned char)(pk4_fp8(__builtin_amdgcn_fmed3f(o[d0][r] * sc, -448.f, 448.f), 0.f, 0.f, 0.f) & 0xffu); }
      asm volatile("s_waitcnt lgkmcnt(0)" ::: "memory");
#pragma unroll
      for (int i = 0; i < 2; ++i) { const int row = i * 16 + (lane >> 2), ch = lane & 3; const u32x4 v = *(const LAS u32x4*)(stg + row * 64 + ch * 16); *(u32x4*)(Ow + (size_t)row * DM + ch * 16) = v; } }
    asm volatile("s_waitcnt lgkmcnt(0)\n\ts_barrier" ::: "memory");
}
#undef SBAR
}

#define XB_TMO      128
#define XB_XCNT(j)  (256  + 64 * (j))
#define XB_XSUB(j)  (1280 + 64 * (j))
#define XB_XGEN(j)  (2304 + 64 * (j))
#define XB_TOP      3328
#define XB_TOPGEN   3392
#define XCD_BAR_WORDS 3456
#define XB_SPIN_CAP (1u << 18)
__device__ __forceinline__ unsigned xb_ld(unsigned* p)              { return __hip_atomic_load(p, __ATOMIC_RELAXED, __HIP_MEMORY_SCOPE_AGENT); }
__device__ __forceinline__ unsigned xb_add(unsigned* p, unsigned v) { return __hip_atomic_fetch_add(p, v, __ATOMIC_RELAXED, __HIP_MEMORY_SCOPE_AGENT); }
__device__ __forceinline__ unsigned xb_xcc_id() { return (unsigned)__builtin_amdgcn_s_getreg((3 << 11) | 20) & 0xFu; }
#define XB_SPIN(cond, bar) do { unsigned _sp = 0; while (cond) { __builtin_amdgcn_s_sleep(1); \
    if ((++_sp & 255u) == 0u) { if (xb_ld(&(bar)[XB_TMO])) break; if (_sp > XB_SPIN_CAP) { atomicAdd(&(bar)[XB_TMO], 1u); break; } } } } while (0)
struct XcdBarrier { unsigned* bar; unsigned x; volatile LAS unsigned* st; };
__device__ __forceinline__ XcdBarrier xcd_barrier_post(unsigned* bar, volatile LAS unsigned* st) {
    XcdBarrier b; b.bar = bar; b.x = xb_xcc_id(); b.st = st;
    if (threadIdx.x == 0) (void)xb_add(&bar[XB_XCNT(b.x)], 1u);
    return b;
}
__device__ __forceinline__ void xcd_barrier_complete(unsigned* bar, unsigned x, unsigned& nloc, unsigned& nx) {
    const unsigned G = gridDim.x * gridDim.y * gridDim.z;
    unsigned sum, cnt, mine, sp = 0u;
    for (;;) {
        sum = 0u; cnt = 0u; mine = 0u;
#pragma unroll
        for (unsigned j = 0; j < 16; ++j) { const unsigned c = xb_ld(&bar[XB_XCNT(j)]); sum += c; cnt += (c > 0u) ? 1u : 0u; mine = (j == x) ? c : mine; }
        if (sum == G) break;
        __builtin_amdgcn_s_sleep(1);
        if ((++sp & 255u) == 0u) { if (xb_ld(&bar[XB_TMO])) break; if (sp > XB_SPIN_CAP) { atomicAdd(&bar[XB_TMO], 1u); break; } }
    }
    nloc = mine > 0u ? mine : 1u; nx = cnt > 0u ? cnt : 1u;
}
__device__ __forceinline__ void xcd_barrier(const XcdBarrier& b) {
    asm volatile("s_waitcnt vmcnt(0)" ::: "memory");
    __syncthreads();
    if (threadIdx.x == 0) {
        unsigned* bar = b.bar;
        __builtin_amdgcn_s_waitcnt(0);
        unsigned nloc = b.st[0], nx = b.st[1];
        if (nloc == 0u) { xcd_barrier_complete(bar, b.x, nloc, nx); b.st[0] = nloc; b.st[1] = nx; }
        const unsigned old = xb_add(&bar[XB_XSUB(b.x)], 1u);
        const unsigned gen = old / nloc;
        if (old + 1u == (gen + 1u) * nloc) {
            __builtin_amdgcn_fence(__ATOMIC_RELEASE, "agent");
            asm volatile("s_waitcnt vmcnt(0)" ::: "memory");
            const unsigned og = xb_add(&bar[XB_TOP], 1u);
            const unsigned tg = og / nx;
            if (og + 1u == (tg + 1u) * nx) xb_add(&bar[XB_TOPGEN], 1u);
            else XB_SPIN(xb_ld(&bar[XB_TOPGEN]) == tg, bar);
            __builtin_amdgcn_fence(__ATOMIC_ACQUIRE, "agent");
            xb_add(&bar[XB_XGEN(b.x)], 1u);
            asm volatile("s_waitcnt vmcnt(0)" ::: "memory");
        } else {
            XB_SPIN(xb_ld(&bar[XB_XGEN(b.x)]) == gen, bar);
            __builtin_amdgcn_fence(__ATOMIC_ACQUIRE, "agent");
            asm volatile("s_waitcnt vmcnt(0)" ::: "memory");
        }
    }
    __syncthreads();
}

struct Args { const float* in[28]; float* out; unsigned char* ws; int ph_lo, ph_hi, li, pad; };
typedef const __attribute__((address_space(4))) Args* ArgsP;
struct Ctx {
    LAS unsigned char* lds; int tid, lane, wave, vcu, G, gw, NGW;
    ArgsP ap;
};
#define CIN(k) (C.ap->in[k])
#define CWS (C.ap->ws)
#define COUT (C.ap->out)
template <bool MERGE>
__device__ __forceinline__ void ctx_mini_gemm(const Ctx& C, const unsigned char* A8, const unsigned char* W8, int sclW, int sclA,
                                              unsigned char* Y8, const unsigned char* G8, const float* xin, bf16* xs, const float* gt) {
    const int fr = C.lane & 15, fq = C.lane >> 4;
#pragma unroll 1
    for (int t = C.vcu; t < 256; t += C.G) {
        const int m = (t >> 4) * 64 + (C.wave & 3) * 16 + fr, n0 = (t & 15) * 64 + (C.wave >> 2) * 32;
        const unsigned char* ap = A8 + (size_t)m * DM + fq * 32;
        const unsigned char* bp = W8 + (size_t)(n0 + fr) * DM + fq * 32;
        const int nc = n0 + 4 * fq;
        unsigned ga[2], gb[2]; f32x4 xv[2], gv[2];
        if (MERGE) {
#pragma unroll
            for (int nb = 0; nb < 2; ++nb) { ga[nb] = *(const unsigned*)(G8 + (size_t)m * PROW + GA8 + nc + nb * 16); gb[nb] = *(const unsigned*)(G8 + (size_t)m * PROW + GB8 + nc + nb * 16); }
        } else {
#pragma unroll
            for (int nb = 0; nb < 2; ++nb) { const u32x2 w_ = *(const u32x2*)(xs + (size_t)m * DM + nc + nb * 16); xv[nb] = (f32x4){bflo(w_.x), bfhi(w_.x), bflo(w_.y), bfhi(w_.y)}; gv[nb] = *(const f32x4*)(gt + nc + nb * 16); }
        }
        f32x4 acc[2] = {(f32x4){0.f, 0.f, 0.f, 0.f}, (f32x4){0.f, 0.f, 0.f, 0.f}};
#pragma unroll
        for (int h = 0; h < 2; ++h) {
            u32x4 av[4][2], b0[4][2], b1[4][2];
#pragma unroll
            for (int k = 0; k < 4; ++k) { const int kb = (h * 4 + k) * 128;
                av[k][0] = *(const u32x4*)(ap + kb); av[k][1] = *(const u32x4*)(ap + kb + 16);
                b0[k][0] = *(const u32x4*)(bp + kb); b0[k][1] = *(const u32x4*)(bp + kb + 16);
                b1[k][0] = *(const u32x4*)(bp + 16 * DM + kb); b1[k][1] = *(const u32x4*)(bp + 16 * DM + kb + 16); }
#pragma unroll
            for (int k = 0; k < 4; ++k) {
                const pg8::i32x8v a8 = {(int)av[k][0].x, (int)av[k][0].y, (int)av[k][0].z, (int)av[k][0].w, (int)av[k][1].x, (int)av[k][1].y, (int)av[k][1].z, (int)av[k][1].w};
                const pg8::i32x8v w0 = {(int)b0[k][0].x, (int)b0[k][0].y, (int)b0[k][0].z, (int)b0[k][0].w, (int)b0[k][1].x, (int)b0[k][1].y, (int)b0[k][1].z, (int)b0[k][1].w};
                const pg8::i32x8v w1 = {(int)b1[k][0].x, (int)b1[k][0].y, (int)b1[k][0].z, (int)b1[k][0].w, (int)b1[k][1].x, (int)b1[k][1].y, (int)b1[k][1].z, (int)b1[k][1].w};
                acc[0] = __builtin_amdgcn_mfma_scale_f32_16x16x128_f8f6f4(w0, a8, acc[0], 0, 0, 0, sclW, 0, sclA);
                acc[1] = __builtin_amdgcn_mfma_scale_f32_16x16x128_f8f6f4(w1, a8, acc[1], 0, 0, 0, sclW, 0, sclA); }
            if (MERGE && h == 0) {
#pragma unroll
                for (int nb = 0; nb < 2; ++nb)
#pragma unroll
                    for (int k = 0; k < 4; ++k) acc[nb][k] *= pg8::EpiGateF::ub(ga[nb], k) * __builtin_amdgcn_rcpf(fmaxf(pg8::EpiGateF::ub(gb[nb], k), 1.0f));
            }
        }
        if (MERGE) { constexpr float sa = (float)(1 << FP8_AEXP) / 255.0f;
#pragma unroll
            for (int nb = 0; nb < 2; ++nb) { const f32x4 v = acc[nb]; const unsigned wb = gb[nb];
                *(unsigned*)(Y8 + (size_t)m * DM + nc + nb * 16) = pk4_fp8_sat(v[0] * sa * fmaxf(pg8::EpiGateF::ub(wb, 0), 1.0f), v[1] * sa * fmaxf(pg8::EpiGateF::ub(wb, 1), 1.0f), v[2] * sa * fmaxf(pg8::EpiGateF::ub(wb, 2), 1.0f), v[3] * sa * fmaxf(pg8::EpiGateF::ub(wb, 3), 1.0f)); }
        } else {
#pragma unroll
            for (int nb = 0; nb < 2; ++nb) { const f32x4 o = xv[nb] + gv[nb] * acc[nb];
                u32x2 w; w.x = pg8::cvt_pk_bf16(o[0], o[1]); w.y = pg8::cvt_pk_bf16(o[2], o[3]); *(u32x2*)(xs + (size_t)m * DM + nc + nb * 16) = w; }
        }
    }
}
__device__ __forceinline__ void transpose_item(const float* W, int N, bf16* WT, int ldo, int k0, int n0, int orow0, const float* gain, LAS float* scr, int lane) {
    float tv[32];
#pragma unroll
    for (int i = 0; i < 32; ++i) { const int kk = 2 * i + (lane >> 5); tv[i] = __builtin_nontemporal_load(W + (size_t)(k0 + kk) * N + n0 + (lane & 31)); }
#pragma unroll
    for (int i = 0; i < 32; ++i) { const int kk = 2 * i + (lane >> 5); float v = tv[i]; if (gain) v *= gain[k0 + kk]; scr[kk * 33 + (lane & 31)] = v; }
    LDS_WAIT(); asm volatile("" ::: "memory");
    const int c = lane & 7;
#pragma unroll
    for (int j = 0; j < 4; ++j) { const int n = (lane >> 3) + 8 * j; const LAS float* s = scr + (8 * c) * 33 + n;
        u32x4 o; o.x = pk2(s[0 * 33], s[1 * 33]); o.y = pk2(s[2 * 33], s[3 * 33]); o.z = pk2(s[4 * 33], s[5 * 33]); o.w = pk2(s[6 * 33], s[7 * 33]);
        *(GAS u32x4*)(WT + (size_t)(orow0 + n) * ldo + k0 + 8 * c) = o; }
    LDS_WAIT(); asm volatile("" ::: "memory");
}
template <bool I8>
__device__ __forceinline__ void transpose_item8(const float* W, int N, unsigned char* WT, int ldo, int k0, int n0, int orow0, float scl, LAS float* scr, int lane, int kdoff = 0) {
    float tv[32];
#pragma unroll
    for (int i = 0; i < 32; ++i) { const int kk = 2 * i + (lane >> 5); tv[i] = __builtin_nontemporal_load(W + (size_t)(k0 + kk) * N + n0 + (lane & 31)); }
#pragma unroll
    for (int i = 0; i < 32; ++i) { const int kk = 2 * i + (lane >> 5); scr[kk * 33 + (lane & 31)] = I8 ? tv[i] : tv[i] * scl; }
    LDS_WAIT(); asm volatile("" ::: "memory");
    const int c = lane & 7;
#pragma unroll
    for (int j = 0; j < 4; ++j) { const int n = (lane >> 3) + 8 * j; const LAS float* s = scr + (8 * c) * 33 + n;
        u32x2 o; if (I8) { o.x = pk4_i8(s[0 * 33], s[1 * 33], s[2 * 33], s[3 * 33], scl); o.y = pk4_i8(s[4 * 33], s[5 * 33], s[6 * 33], s[7 * 33], scl); }
        else { o.x = pk4_fp8(s[0 * 33], s[1 * 33], s[2 * 33], s[3 * 33]); o.y = pk4_fp8(s[4 * 33], s[5 * 33], s[6 * 33], s[7 * 33]); }
        *(GAS u32x2*)(WT + (size_t)(orow0 + n) * ldo + kdoff + k0 + 8 * c) = o; }
    LDS_WAIT(); asm volatile("" ::: "memory");
}
constexpr int CS_IN = 16 * 101, CS_UQ = 4 * 24, CS_UKV = 2 * 32, CS_OA = 8 * 32, CS_PAD = 96, CS_PAD2 = 0;
constexpr int CONV_NSTATIC = CS_IN + CS_UQ + CS_UKV + 2 * CS_OA + CS_PAD + CS_PAD2;
constexpr int CQ_OUT = 16 * 32, CQ_G = 16 * 16, CQ_D = 8 * 32;
constexpr int CONV_NQUEUE = CQ_OUT + 17 * 2 * CQ_G + 17 * CQ_D;
__device__ __forceinline__ void convert_static_item(const Ctx& C, int l, int it, LAS float* scr) {
    bf16* WB = (bf16*)(CWS + WS_W) + (size_t)l * WL_STRIDE;
    constexpr float WS8 = (float)(1 << FP8_WEXP), WI8 = (float)(1 << I8_WEXP);
    int r = it;
    if (r < CS_IN) { const int kb = r / 101, nb = r % 101; transpose_item8<true>(CIN(8) + (size_t)l * DM * INC, INC, (unsigned char*)(WB + WO_IN), 1024, 64 * kb, 32 * nb, (32 * nb < C_QB) ? 32 * nb : 32 * nb + 96, WI8, scr, C.lane); return; } r -= CS_IN;
    if (r < CS_UQ) { const int kb = r / 24, nb = r % 24; transpose_item(CIN(10) + (size_t)l * 256 * 768, 768, WB + WO_UQ, 256, 64 * kb, 32 * nb, 32 * nb, CIN(9) + l * 256, scr, C.lane); return; } r -= CS_UQ;
    if (r < CS_UKV) { const int kb = r / 32, nb = r % 32; transpose_item(CIN(12) + (size_t)l * 128 * 1024, 1024, WB + WO_UKV, 128, 64 * kb, 32 * nb, 32 * nb, CIN(11) + l * 128, scr, C.lane); return; } r -= CS_UKV;
    if (r < CS_OA) { const int kb = r / 32, nb = r % 32; transpose_item8<false>(CIN(17) + (size_t)l * 512 * DM, 1024, (unsigned char*)(WB + WO_OA), 1024, 64 * kb, 32 * nb, 32 * nb, WS8, scr, C.lane, 0); return; } r -= CS_OA;
    if (r < CS_OA) { const int kb = r / 32, nb = r % 32; transpose_item8<false>(CIN(18) + (size_t)l * 512 * DM, 1024, (unsigned char*)(WB + WO_OA), 1024, 64 * kb, 32 * nb, 32 * nb, WS8, scr, C.lane, 512); return; } r -= CS_OA;
    u32x4 zz = (u32x4){0u, 0u, 0u, 0u}; asm volatile("" : "+v"(zz));
    if (r < CS_PAD) { unsigned char* p = (unsigned char*)(WB + WO_IN) + (size_t)(C_QB + r) * 1024;
      *(GAS u32x4*)(p + C.lane * 16) = zz; return; } r -= CS_PAD;
    { const int row = r * 4 + (C.lane >> 4), ch = C.lane & 15;
      *(GAS u32x4*)(WB + WO_UKV + (size_t)row * 256 + 128 + ch * 8) = zz; }
}
__device__ __forceinline__ void convert_queue_item(const Ctx& C, int l, int it, LAS float* scr) {
    bf16* WB = (bf16*)(CWS + WS_W) + (size_t)l * WL_STRIDE;
    constexpr float WS8 = (float)(1 << FP8_WEXP), WI8 = (float)(1 << I8_WEXP);
    int r = it;
    if (r < CQ_OUT) { const int kb = r / 32, nb = r % 32; transpose_item8<false>(CIN(19) + (size_t)l * DM * DM, 1024, (unsigned char*)(WB + WO_OUT), 1024, 64 * kb, 32 * nb, 32 * nb, WS8, scr, C.lane); return; } r -= CQ_OUT;
    if (r < 17 * 2 * CQ_G) { const int e = r / (2 * CQ_G), q = r % (2 * CQ_G), up = q / CQ_G, sx = q % CQ_G, kb = sx / 16, nb = sx % 16;
        const float* src = (e < 16) ? ((up ? CIN(23) : CIN(22)) + ((size_t)l * NEXP + e) * DM * FF) : ((up ? CIN(26) : CIN(25)) + (size_t)l * DM * FF);
        const int n0 = 32 * nb, orow = (n0 >> 7) * 256 + up * 128 + (n0 & 127);
        transpose_item8<true>(src, FF, (unsigned char*)(WB + WO_GU) + (size_t)e * 1024 * 1024, 1024, 64 * kb, n0, orow, WI8, scr, C.lane); return; } r -= 17 * 2 * CQ_G;
    { const int e = r / CQ_D, sx = r % CQ_D, kb = sx / 32, nb = sx % 32;
        const float* src = (e < 16) ? (CIN(24) + ((size_t)l * NEXP + e) * FF * DM) : (CIN(27) + (size_t)l * FF * DM);
        transpose_item8<false>(src, 1024, (unsigned char*)(WB + WO_DN) + (size_t)e * 1024 * 512, 512, 64 * kb, 32 * nb, 32 * nb, WS8, scr, C.lane); }
}
__device__ __forceinline__ void convert_static(const Ctx& C, int l, int gw, int ngw) {
    LAS float* scr = (LAS float*)(C.lds + C.wave * 12288);
    for (int it = gw; it < CONV_NSTATIC; it += ngw) convert_static_item(C, l, it, scr);
}
__device__ __forceinline__ int convert_steal(const Ctx& C, int l, int limit, int max_grabs, bool precheck = false) {
    LAS float* scr = (LAS float*)(C.lds + C.wave * 12288);
    LAS int* sb = (LAS int*)(C.lds + LDSX_PFX + 128);
    unsigned* head = (unsigned*)(CWS + WS_CTL) + CW_STEAL + 64 * l;
    const int qoff = (l > 0) ? CONV_NSTATIC : 0;
    int g = 0;
    if (precheck) {
        __syncthreads();
        if (C.tid == 0) *sb = (int)__hip_atomic_load(head, __ATOMIC_RELAXED, __HIP_MEMORY_SCOPE_AGENT);
        __syncthreads();
        const int h0 = __builtin_amdgcn_readfirstlane(*sb);
        __syncthreads();
        if (h0 >= limit + qoff) return 0;
    }
    for (; g < max_grabs; ++g) {
        __syncthreads();
        if (C.tid == 0) *sb = (int)__hip_atomic_fetch_add(head, 16u, __ATOMIC_RELAXED, __HIP_MEMORY_SCOPE_AGENT);
        __syncthreads();
        const int base = __builtin_amdgcn_readfirstlane(*sb);
        if (base >= qoff + CONV_NQUEUE) break;
#pragma unroll 1
        for (int k = 0; k < 2; ++k) { const int it = base + C.wave * 2 + k; if (it < qoff) convert_static_item(C, l, it, scr); else if (it < qoff + CONV_NQUEUE) convert_queue_item(C, l, it - qoff, scr); }
        if (base + 16 >= limit + qoff) { ++g; break; }
    }
    __syncthreads();
    return g;
}
__device__ __forceinline__ unsigned queue_head_early(const Ctx& C, int l) {
    unsigned h = 0u; if (C.tid == 0) h = __hip_atomic_load((unsigned*)(CWS + WS_CTL) + CW_STEAL + 64 * l, __ATOMIC_RELAXED, __HIP_MEMORY_SCOPE_AGENT); return h; }
__device__ __forceinline__ void sweep_late(const Ctx& C, int l, int limit, unsigned hq) {
    LAS int* sb = (LAS int*)(C.lds + LDSX_PFX + 128);
    __syncthreads();
    if (C.tid == 0) *sb = (int)hq;
    __syncthreads();
    const int h0 = __builtin_amdgcn_readfirstlane(*sb);
    __syncthreads();
    if (h0 < limit + ((l > 0) ? CONV_NSTATIC : 0)) (void)convert_steal(C, l, limit, 1 << 20);
}
__device__ __forceinline__ void mod_gemv(const Ctx& C, int unit) {
    const int l = unit / 24, jb = unit % 24, j = jb * 256 + 4 * C.lane;
    const float* wm = CIN(4) + (size_t)l * DM * 6144 + j; const float* cc = CIN(1); const float* cx = CIN(3);
    f32x4 acc[5];
#pragma unroll
    for (int w = 0; w < 5; ++w) acc[w] = (f32x4){0.f, 0.f, 0.f, 0.f};
#pragma unroll
    for (int dc = 0; dc < 2; ++dc) { const int d0 = C.wave * 128 + dc * 64;
        float s[5];
#pragma unroll
        for (int w = 0; w < 5; ++w) { const float v = (w < 4) ? cc[w * DM + d0 + C.lane] : cx[d0 + C.lane]; s[w] = v * sigmoidf_(v); }
#pragma unroll
        for (int db = 0; db < 64; db += 16) { f32x4 wv[16];
#pragma unroll
            for (int dd = 0; dd < 16; ++dd) wv[dd] = __builtin_nontemporal_load((const f32x4*)(wm + (size_t)(d0 + db + dd) * 6144));
#pragma unroll
            for (int dd = 0; dd < 16; ++dd) asm volatile("" : "+v"(wv[dd]));
#pragma unroll
            for (int dd = 0; dd < 16; ++dd)
#pragma unroll
                for (int w = 0; w < 5; ++w) acc[w] = acc[w] + wv[dd] * rlane(s[w], db + dd); } }
    LAS f32x4* part = (LAS f32x4*)C.lds;
#pragma unroll
    for (int w = 0; w < 5; ++w) part[(C.wave * 5 + w) * 64 + C.lane] = acc[w];
    __syncthreads();
    if (C.wave < 5) { f32x4 t = (f32x4){0.f, 0.f, 0.f, 0.f};
#pragma unroll
        for (int k = 0; k < 8; ++k) t = t + part[(k * 5 + C.wave) * 64 + C.lane];
        float* mv = (float*)(CWS + WS_MISC + MO_MODV) + (size_t)l * 5 * 6144; *(f32x4*)(mv + C.wave * 6144 + j) = t + *(const f32x4*)(CIN(5) + l * 6144 + j); }
    __syncthreads();
}
__device__ __forceinline__ void make_tables(const Ctx& C) {
    float* ta = (float*)(CWS + WS_MISC + MO_TABA); float* tb = (float*)(CWS + WS_MISC + MO_TABB);
    for (int i = C.lane; i < 64 * 8; i += 64) { const int pos = i >> 3, f = i & 7; const float inv = exp2f(-13.287712379549449f * (float)(2 * f) / 16.0f); const float a = (float)pos * inv; ta[2 * i] = cosf(a); ta[2 * i + 1] = sinf(a); }
    for (int i = C.lane; i < 64 * 16; i += 64) { const int pos = i >> 4, f = i & 15; const float inv = exp2f(-13.287712379549449f * (float)(2 * f) / 32.0f); const float a = (float)pos * inv; tb[2 * i] = cosf(a); tb[2 * i + 1] = sinf(a); }
    float* cb = (float*)(CWS + WS_MISC + MO_CB);
    for (int l = 0; l < NLAYER; ++l) {
        float ma = 0.f, mb = 0.f, mc = 0.f, md = 0.f;
        for (int i = C.lane; i < 96; i += 64) { ma = fmaxf(ma, fabsf(CIN(13)[l * 96 + i])); mb = fmaxf(mb, fabsf(CIN(14)[l * 96 + i])); }
        { const int i = C.lane; mc = fabsf(CIN(15)[l * 64 + i]); md = fabsf(CIN(16)[l * 64 + i]); }
#pragma unroll
        for (int o = 1; o < 64; o <<= 1) { ma = fmaxf(ma, shx(ma, C.lane, o)); mb = fmaxf(mb, shx(mb, C.lane, o)); mc = fmaxf(mc, shx(mc, C.lane, o)); md = fmaxf(md, shx(md, C.lane, o)); }
        if (C.lane == 0) { cb[l * 2 + 0] = -(SCA * 96.0f * ma * mb * 1.02f + 0.5f); cb[l * 2 + 1] = -(SCB * 64.0f * mc * md * 1.02f + 0.5f); }
    }
}
__device__ __forceinline__ const float* stream_in(const Ctx& C, int l, int r) { return (r < TC) ? CIN(2) + (size_t)r * DM : CIN(0) + (size_t)(r - TC) * DM; }
__device__ __forceinline__ void xs_load(const bf16* row, int lane, f32x4 (&v)[4]) {
#pragma unroll
    for (int j = 0; j < 4; ++j) { const u32x2 w = *(const u32x2*)(row + j * 256 + 4 * lane); v[j] = (f32x4){bflo(w.x), bfhi(w.x), bflo(w.y), bfhi(w.y)}; }
}
__device__ __forceinline__ void xs_store(bf16* row, int lane, const f32x4 (&v)[4]) {
#pragma unroll
    for (int j = 0; j < 4; ++j) { u32x2 w; w.x = pk2(v[j].x, v[j].y); w.y = pk2(v[j].z, v[j].w); *(u32x2*)(row + j * 256 + 4 * lane) = w; }
}
__device__ __forceinline__ void expert_prefix(const unsigned* cnt, int srow0, LAS int* pfx, int tid) {
    if (tid == 0) { int s = 0;
#pragma unroll
        for (int e = 0; e < 16; ++e) { pfx[e] = s; s += ((int)cnt[64 * e] + 255) >> 8; }
        pfx[16] = s; s += (T - srow0) >> 8; pfx[17] = s; }
    __syncthreads();
}
__device__ __forceinline__ void wave_rows(int gw, int NGW, int lo, int hi, int& rb, int& re) { const int n = hi - lo, q = n / NGW, rem = n % NGW; rb = lo + gw * q + (gw < rem ? gw : rem); re = rb + q + (gw < rem ? 1 : 0); }
struct CombIdx { size_t r0, r1, r2; };
__device__ __forceinline__ CombIdx comb_idx(const Ctx& C, int r, const LAS int* pfx, int srow0) {
    const int* tp = (const int*)(CWS + WS_ROUTE + RO_TOKPOS) + 2 * r; const int t0 = tp[0], t1 = tp[1];
    CombIdx ci; ci.r0 = (size_t)pfx[16] * 256 + (r - srow0); ci.r1 = (size_t)pfx[t0 >> 20] * 256 + (t0 & 0xfffff); ci.r2 = (size_t)pfx[t1 >> 20] * 256 + (t1 & 0xfffff); return ci;
}
__device__ __forceinline__ void comb_load(const Ctx& C, const CombIdx& ci, unsigned (&y)[3][4]) {
    const unsigned char* YE = (const unsigned char*)(CWS + WS_R2);
#pragma unroll
    for (int j = 0; j < 4; ++j) { y[0][j] = __builtin_nontemporal_load((const unsigned*)(YE + ci.r0 * DM + j * 256 + 4 * C.lane)); y[1][j] = __builtin_nontemporal_load((const unsigned*)(YE + ci.r1 * DM + j * 256 + 4 * C.lane)); y[2][j] = __builtin_nontemporal_load((const unsigned*)(YE + ci.r2 * DM + j * 256 + 4 * C.lane)); }
}
__device__ __forceinline__ f32x4 fp8x4_to_f32(unsigned w) {
    const f32x2 lo = __builtin_amdgcn_cvt_pk_f32_fp8((int)w, false), hi = __builtin_amdgcn_cvt_pk_f32_fp8((int)w, true);
    return (f32x4){lo.x, lo.y, hi.x, hi.y};
}
__device__ __forceinline__ void comb_apply(const Ctx& C, const LAS float* gt2, const unsigned (&y)[3][4], f32x4 (&v)[4]) {
    constexpr float us = 1.0f / (float)(1 << FP8_AEXP);
#pragma unroll
    for (int j = 0; j < 4; ++j) { const f32x4 g = *(const LAS f32x4*)(gt2 + j * 256 + 4 * C.lane);
        const f32x4 t = (fp8x4_to_f32(y[0][j]) + fp8x4_to_f32(y[1][j]) + fp8x4_to_f32(y[2][j])) * us;
        v[j] = v[j] + g * t; }
}
__device__ __forceinline__ void mod_chunk_to_lds(LAS float* dst, const float* modv_layer, int chunk, int tid) {
#pragma unroll
    for (int q = 0; q < 10; ++q) { const int i = q * NTHR + tid, w = i >> 10, j = i & 1023; dst[i] = modv_layer[(size_t)(w * 6 + chunk) * DM + j]; }
}
__device__ __forceinline__ void norm_mod_row(const Ctx& C, const f32x4 (&v)[4], const f32x4 (&g)[4], const LAS float* sh, const LAS float* sc, unsigned char* orow, f32x4 (&f)[4]) {
    float s = 0.f;
#pragma unroll
    for (int j = 0; j < 4; ++j) s += (v[j].x * v[j].x + v[j].y * v[j].y) + (v[j].z * v[j].z + v[j].w * v[j].w);
    const float rstd = __builtin_amdgcn_rsqf(wave_sum(s, C.lane) * (1.0f / DM) + EPS);
#pragma unroll
    for (int j = 0; j < 4; ++j) { const int c = j * 256 + 4 * C.lane;
        const f32x4 a = *(const LAS f32x4*)(sc + c), b = *(const LAS f32x4*)(sh + c);
        f[j] = (v[j] * rstd) * g[j] * (a + 1.0f) + b;
        *(unsigned*)(orow + c) = pk4_i8(f[j].x, f[j].y, f[j].z, f[j].w, (float)(1 << I8_AEXP)); }
}

constexpr int NPHASE = 1 + NLAYER * 10 + 1;

__global__ void __launch_bounds__(NTHR, 2) fwd_kernel(Args args) {
    extern __shared__ __attribute__((aligned(16))) unsigned char lds_raw[];
    Ctx C;
    C.lds = (LAS unsigned char*)lds_raw;
    C.tid = threadIdx.x; C.lane = C.tid & 63; C.wave = __builtin_amdgcn_readfirstlane(C.tid >> 6);
    C.G = gridDim.x; { const int bx = blockIdx.x; C.vcu = (C.G % 8 == 0) ? (bx % 8) * (C.G / 8) + bx / 8 : bx; }
    C.gw = C.vcu * NWAVES + C.wave; C.NGW = C.G * NWAVES;
    C.ap = (ArgsP)__builtin_amdgcn_kernarg_segment_ptr();
    unsigned char* ws = C.ap->ws;
    unsigned* ctl = (unsigned*)(ws + WS_CTL);
    volatile LAS unsigned* bst = (volatile LAS unsigned*)(C.lds + LDSX_MISC);
    if (C.tid < 4) bst[C.tid] = 0u;
    __syncthreads();
    XcdBarrier bar = xcd_barrier_post(ctl + CW_BAR + C.ap->li * XCD_BAR_WORDS, bst);
    const int lo = C.ap->ph_lo, hi = C.ap->ph_hi;
#ifndef PHMASK
#define PHMASK 0xfff
#endif
#define EN(kind) (((PHMASK) >> (kind)) & 1)
#ifndef REPMASK
#define REPMASK 0
#endif
#define NREP(kind) (1 + (((REPMASK) >> (kind)) & 1))
#define IN(k) (lo <= (k) && (k) < hi)
#ifndef BARX
#define BARX 1
#endif
#define SEAM(k) do { if (IN(k) && IN((k) + 1)) { _Pragma("unroll 1") for (int bx_ = 0; bx_ < BARX; ++bx_) { XcdBarrier b_ = bar; asm volatile("" : "+s"(b_.x)); xcd_barrier(b_); } } } while (0)
    LAS int* gtab = (LAS int*)(C.lds + LDSX_GTAB);
    LAS int* pfxl = (LAS int*)(C.lds + LDSX_PFX);
#define PH() { ArgsP _ap = C.ap; asm volatile("" : "+s"(_ap)); C.ap = _ap; int t_ = threadIdx.x; asm volatile("" : "+v"(t_)); C.tid = t_; C.lane = t_ & 63; C.wave = __builtin_amdgcn_readfirstlane(t_ >> 6); C.gw = C.vcu * NWAVES + C.wave; } \
    unsigned char* ws = C.ap->ws; unsigned* ctl = (unsigned*)(ws + WS_CTL); (void)ctl; \
    float* MODV = (float*)(ws + WS_MISC + MO_MODV); (void)MODV; bf16* WB = (bf16*)(ws + WS_W) + (size_t)l * WL_STRIDE; (void)WB; \
    bf16* R1 = (bf16*)(ws + WS_R1); (void)R1; bf16* PROJ = (bf16*)(ws + WS_R2); (void)PROJ; bf16* UQ = (bf16*)(ws + WS_R4); (void)UQ; bf16* QA = UQ; (void)QA; bf16* XS = (bf16*)(ws + WS_R5); (void)XS; \
    unsigned char* KA = ws + WS_R3 + R3_KA; (void)KA; bf16* VA = (bf16*)(ws + WS_R3 + R3_VA); (void)VA; unsigned char* QB = ws + WS_R3 + R3_QB; (void)QB; \
    unsigned char* KB = ws + WS_R3 + R3_KB; (void)KB; bf16* VB = (bf16*)(ws + WS_R3 + R3_VB); (void)VB; unsigned char* QA8 = ws + WS_R3 + R3_QA; (void)QA8; \
    bf16* Y1 = (bf16*)(ws + WS_R3 + R3_Y1); (void)Y1; bf16* YY = (bf16*)(ws + WS_R3 + R3_Y); (void)YY; bf16* HH = (bf16*)(ws + WS_R3 + R3_HH); (void)HH; \
    const float* modl = MODV + (size_t)l * 5 * 6144; (void)modl;

    if (EN(0) && IN(0)) {
#pragma unroll 1
      for (int rep = 0; rep < NREP(0); ++rep) {
        { ArgsP _ap = C.ap; asm volatile("" : "+s"(_ap)); C.ap = _ap; }
        const bool big = (C.G >= 250); const bool gemv_wg = big && (C.vcu % 5 == 0) && (C.vcu < 240);
        if (!big) { for (int u = C.vcu; u < 48; u += C.G) mod_gemv(C, u); } else if (gemv_wg) mod_gemv(C, C.vcu / 5);
        if (C.wave == 1 && C.vcu == 241 % C.G) make_tables(C);
        if (!big) convert_static(C, 0, C.gw, C.NGW); else if (!gemv_wg) { const int v3 = (C.vcu < 240) ? C.vcu - C.vcu / 5 - 1 : C.vcu - 48; convert_static(C, 0, v3 * NWAVES + C.wave, (C.G - 48) * NWAVES); }
        if (big && !gemv_wg) (void)convert_steal(C, 0, CONV_NQUEUE, 2);
        __syncthreads();
      }
    }
    SEAM(0);

    for (int l = 0; l < NLAYER; ++l) {
        const int P = 1 + l * 10;
        const bool lastl = (l == NLAYER - 1);
        const int mrow0 = lastl ? TC : 0;

        if (EN(1) && IN(P + 0)) {
#pragma unroll 1
          for (int rep = 0; rep < (NREP(1) > 1 && l == 0 ? 2 : 1); ++rep) {
            PH();
            const unsigned hqs = (l > 0) ? queue_head_early(C, l) : 0u;
            if (l > 0 && !IN(P - 2)) expert_prefix(ctl + CW_CNT + (l - 1) * 1024, 0, pfxl, C.tid);
            LAS float* mt = (LAS float*)C.lds;
            mod_chunk_to_lds(mt, modl, 0, C.tid); mod_chunk_to_lds(mt + 5 * DM, modl, 1, C.tid);
            if (l > 0) mod_chunk_to_lds(mt + 10 * DM, MODV + (size_t)(l - 1) * 5 * 6144, 5, C.tid);
            f32x4 gv[4];
#pragma unroll
            for (int j = 0; j < 4; ++j) gv[j] = *(const f32x4*)(CIN(6) + l * DM + j * 256 + 4 * C.lane);
            __syncthreads();
            int rb, re; wave_rows(C.gw, C.NGW, 0, T, rb, re);
            if (l == 0) {
                for (int r0 = rb; r0 < re; r0 += 4) {
                    f32x4 v[4][4], f[4];
#pragma unroll
                    for (int k = 0; k < 4; ++k) { const int r = (r0 + k < re) ? r0 + k : re - 1; const float* src = stream_in(C, 0, r);
#pragma unroll
                        for (int j = 0; j < 4; ++j) v[k][j] = __builtin_nontemporal_load((const f32x4*)(src + j * 256 + 4 * C.lane)); }
#pragma unroll
                    for (int k = 0; k < 4; ++k) if (r0 + k < re) { const int r = r0 + k, which = (r < TC) ? 4 : ((r - TC) >> 12);
                        xs_store(XS + (size_t)r * DM, C.lane, v[k]);
                        norm_mod_row(C, v[k], gv, mt + which * DM, mt + (5 + which) * DM, (unsigned char*)R1 + (size_t)r * DM, f); }
                }
            } else {
                constexpr int NB = 4;
                CombIdx cn[NB];
#pragma unroll
                for (int k = 0; k < NB; ++k) { const int r = (rb + k < re) ? rb + k : re - 1; cn[k] = comb_idx(C, r, pfxl, 0); }
                for (int r0 = rb; r0 < re; r0 += NB) {
                    f32x4 v[NB][4], f[4]; unsigned y[NB][3][4]; CombIdx ci[NB];
#pragma unroll
                    for (int k = 0; k < NB; ++k) { const int r = (r0 + k < re) ? r0 + k : re - 1; ci[k] = cn[k]; xs_load(XS + (size_t)r * DM, C.lane, v[k]); }
#pragma unroll
                    for (int k = 0; k < NB; ++k) comb_load(C, ci[k], y[k]);
#pragma unroll
                    for (int k = 0; k < NB; ++k) { const int r = (r0 + NB + k < re) ? r0 + NB + k : re - 1; cn[k] = comb_idx(C, r, pfxl, 0); }
#pragma unroll
                    for (int k = 0; k < NB; ++k) if (r0 + k < re) { const int r = r0 + k, which = (r < TC) ? 4 : ((r - TC) >> 12);
                        comb_apply(C, mt + (10 + which) * DM, y[k], v[k]); xs_store(XS + (size_t)r * DM, C.lane, v[k]);
                        norm_mod_row(C, v[k], gv, mt + which * DM, mt + (5 + which) * DM, (unsigned char*)R1 + (size_t)r * DM, f); }
                }
            }
            __syncthreads();
            if (l > 0) sweep_late(C, l, 0, hqs);
          }
        }
        SEAM(P + 0);

        if (EN(2) && IN(P + 1)) {
#pragma unroll 1
          for (int rep = 0; rep < NREP(2); ++rep) {
            PH();
            constexpr int SW = 0x01010101 * (127 - FP8_WEXP), SA0 = 0x7f7f7f7f;
            pg8::StaticOrder S; S.init(T, INCP, C.G, (int)blockIdx.x, DM / 2, DM / 2);
            pg8::EpiProj E{PROJ};
            pg8::gemm_phase<pg8::EpiProj, pg8::StaticOrder, false, 2>(C.lds, R1, DM / 2, WB + WO_IN, DM / 2, S, E, gtab, SW, SA0, 1.0f / (float)(1 << (I8_AEXP + I8_WEXP)));
            if ((S.nwg + C.G - 1 - S.c) / C.G < (S.nwg + C.G - 1) / C.G) (void)convert_steal(C, l, CONV_NQUEUE, 2);
          }
        }
        SEAM(P + 1);

        if (EN(3) && IN(P + 2)) {
#pragma unroll 1
          for (int rep = 0; rep < NREP(3); ++rep) {
            PH();
            { pg8::StaticOrder S; S.init(T, 768, C.G, (int)blockIdx.x, INCP, 256);
              pg8::EpiF8 E{(unsigned char*)UQ, 768};
              pg8::gemm_phase<pg8::EpiF8, pg8::StaticOrder, false>(C.lds, PROJ + C_CQ, INCP, WB + WO_UQ, 256, S, E, gtab); }
            __builtin_amdgcn_sched_barrier(0); asm volatile("" ::: "memory");
            { int kk = 128; asm volatile("" : "+s"(kk));
              pg8::StaticOrder S; S.init(T, 1024, C.G, (int)((blockIdx.x + 52) % C.G), INCP, kk);
              pg8::EpiF8 E{(unsigned char*)R1, 1024};
              pg8::gemm_phase<pg8::EpiF8, pg8::StaticOrder, false>(C.lds, PROJ + C_CKV, INCP, WB + WO_UKV, kk, S, E, gtab); }
          }
        }
        SEAM(P + 2);

        if (EN(4) && IN(P + 3)) {
#pragma unroll 1
          for (int rep = 0; rep < (NREP(4) > 1 ? 2 : 1); ++rep) {
            PH();
            const unsigned hq = queue_head_early(C, l);
            const float* g_qa = CIN(13) + l * 96; const float* g_ka = CIN(14) + l * 96; const float* g_qb = CIN(15) + l * 64; const float* g_kb = CIN(16) + l * 64;
            const float* tabA = (const float*)(ws + WS_MISC + MO_TABA); const float* tabB = (const float*)(ws + WS_MISC + MO_TABB);
            const int h = C.lane >> 3, j = C.lane & 7, ax = j >> 2, i0 = 2 * (j & 3);
            float gqa_n[8], gka_n[8], gqa_r[4], gka_r[4], gqb8[8], gkb8[8];
#pragma unroll
            for (int e = 0; e < 8; ++e) { gqa_n[e] = g_qa[8 * j + e]; gka_n[e] = g_ka[8 * j + e]; gqb8[e] = g_qb[8 * j + e]; gkb8[e] = g_kb[8 * j + e]; }
#pragma unroll
            for (int e = 0; e < 2; ++e) { gqa_r[e] = g_qa[64 + ax * 16 + i0 + e]; gqa_r[2 + e] = g_qa[64 + ax * 16 + 8 + i0 + e]; gka_r[e] = g_ka[64 + ax * 16 + i0 + e]; gka_r[2 + e] = g_ka[64 + ax * 16 + 8 + i0 + e]; }
            sweep_late(C, l, CQ_OUT, hq);
            int rb, re; wave_rows(C.gw, C.NGW, 0, T, rb, re);
            for (int r0 = rb; r0 < re; r0 += 2) {
                u32x2 i_cq[2]; unsigned i_ckv[2], i_q1[2], i_q2[2], i_k1[2], i_k2[2]; u32x2 i_uq[2], i_uk[2], i_uv[2], i_qb[2], i_kb[2], i_vb[2]; f32x4 t_a[2], t_b[2][4];
#pragma unroll
                for (int k = 0; k < 2; ++k) { const int r = (r0 + k < re) ? r0 + k : re - 1;
                    const bf16* pr = PROJ + (size_t)r * INCP; const unsigned char* uq = (const unsigned char*)UQ + (size_t)r * 768 + h * 96; const unsigned char* uk = (const unsigned char*)R1 + (size_t)r * 1024 + h * 128;
#define NTL(T_, p_) __builtin_nontemporal_load((const T_*)(p_))
                    i_cq[k] = NTL(u32x2, pr + C_CQ + 4 * C.lane); i_ckv[k] = NTL(unsigned, pr + C_CKV + 2 * C.lane);
                    i_uq[k] = NTL(u32x2, uq + 8 * j); i_q1[k] = NTL(unsigned short, uq + 64 + ax * 16 + i0); i_q2[k] = NTL(unsigned short, uq + 64 + ax * 16 + 8 + i0);
                    i_uk[k] = NTL(u32x2, uk + 8 * j); i_uv[k] = NTL(u32x2, uk + 64 + 8 * j);
                    i_k1[k] = NTL(unsigned, pr + C_KR + ax * 16 + i0); i_k2[k] = NTL(unsigned, pr + C_KR + ax * 16 + 8 + i0);
                    { const unsigned char* p8 = (const unsigned char*)pr; i_qb[k] = NTL(u32x2, p8 + PQ8 + h * 64 + 8 * j); i_kb[k] = NTL(u32x2, p8 + PK8 + (h & 1) * 64 + 8 * j); i_vb[k] = NTL(u32x2, p8 + PV8 + (C.lane & 15) * 8); }
#undef NTL
                    { const int n_ = (r < TC) ? 0 : ((r - TC) & 4095), pos = ax ? (n_ & 63) : (n_ >> 6);
                      t_a[k] = *(const f32x4*)(tabA + (pos * 8 + i0) * 2);
#pragma unroll
                      for (int q = 0; q < 4; ++q) t_b[k][q] = *(const f32x4*)(tabB + (pos * 16 + (j & 1) * 8 + 2 * q) * 2); } }
#pragma unroll
              for (int k = 0; k < 2; ++k) if (r0 + k < re) { const int r = r0 + k;
                const bool isctx = r < TC; const int b = isctx ? (r >> 8) : ((r - TC) >> 12); const int n = isctx ? (r & 255) : ((r - TC) & 4095);
                const int Lidx = isctx ? n : CTXL + n; const int prow = n >> 6, pcol = n & 63;
                const size_t krow = (size_t)b * LK + Lidx;
                float s1, s2;
                { const u32x2 a = i_cq[k]; const float a0 = bflo(a.x), a1 = bfhi(a.x), a2 = bflo(a.y), a3 = bfhi(a.y); s1 = (a0 * a0 + a1 * a1) + (a2 * a2 + a3 * a3);
                  const unsigned c = i_ckv[k]; const float c0 = bflo(c), c1 = bfhi(c); s2 = c0 * c0 + c1 * c1; }
                const float rs_cq = __builtin_amdgcn_rsqf(wave_sum(s1, C.lane) * (1.0f / 256.0f) + EPS), rs_ckv = __builtin_amdgcn_rsqf(wave_sum(s2, C.lane) * (1.0f / 128.0f) + EPS);
                { unsigned char* qa = QA8 + (size_t)r * 1024 + h * 128;
                  const u32x2 a = i_uq[k];
                  const f32x2 a0 = __builtin_amdgcn_cvt_pk_f32_fp8((int)a.x, false), a1 = __builtin_amdgcn_cvt_pk_f32_fp8((int)a.x, true), a2 = __builtin_amdgcn_cvt_pk_f32_fp8((int)a.y, false), a3 = __builtin_amdgcn_cvt_pk_f32_fp8((int)a.y, true);
                  const f32x2 y1 = __builtin_amdgcn_cvt_pk_f32_fp8((int)i_q1[k], false), y2 = __builtin_amdgcn_cvt_pk_f32_fp8((int)i_q2[k], false);
                  float v[8] = {a0[0], a0[1], a1[0], a1[1], a2[0], a2[1], a3[0], a3[1]}; float x1[2] = {y1[0], y1[1]}, x2[2] = {y2[0], y2[1]};
                  const float rsq_ = rs_cq * (1.0f / (float)(1 << FP8_AEXP));
                  float ss = 0.f;
#pragma unroll
                  for (int e = 0; e < 8; ++e) { v[e] *= rsq_; ss += v[e] * v[e]; }
#pragma unroll
                  for (int e = 0; e < 2; ++e) { x1[e] *= rsq_; x2[e] *= rsq_; ss += x1[e] * x1[e] + x2[e] * x2[e]; }
                  const float rn = SCA * __builtin_amdgcn_rsqf(sum8(ss, C.lane) * (1.0f / 96.0f) + EPS);
#pragma unroll
                  for (int e = 0; e < 8; ++e) v[e] *= rn * gqa_n[e];
                  float o1[2], o2[2];
#pragma unroll
                  for (int e = 0; e < 2; ++e) { const float a1 = x1[e] * rn * gqa_r[e], a2 = x2[e] * rn * gqa_r[2 + e];
                      if (isctx) { o1[e] = a1; o2[e] = a2; } else { const float cc_ = t_a[k][2 * e], ss_ = t_a[k][2 * e + 1]; o1[e] = a1 * cc_ - a2 * ss_; o2[e] = a1 * ss_ + a2 * cc_; } }
                  constexpr float qs = (float)(1 << att::QEXP);
                  u32x4 w; w.x = pk4_fp8(v[0] * qs, v[1] * qs, v[2] * qs, v[3] * qs); w.y = pk4_fp8(v[4] * qs, v[5] * qs, v[6] * qs, v[7] * qs); w.z = pk4_fp8(o1[0] * qs, o1[1] * qs, o2[0] * qs, o2[1] * qs); w.w = 0u;
                  *(u32x4*)(qa + 16 * j) = w; }
                { const u32x2 a = i_uk[k], vv = i_uv[k];
                  const unsigned x1w = i_k1[k], x2w = i_k2[k];
                  const f32x2 a0 = __builtin_amdgcn_cvt_pk_f32_fp8((int)a.x, false), a1 = __builtin_amdgcn_cvt_pk_f32_fp8((int)a.x, true), a2 = __builtin_amdgcn_cvt_pk_f32_fp8((int)a.y, false), a3 = __builtin_amdgcn_cvt_pk_f32_fp8((int)a.y, true);
                  float v[8] = {a0[0], a0[1], a1[0], a1[1], a2[0], a2[1], a3[0], a3[1]}; float x1[2] = {bflo(x1w), bfhi(x1w)}, x2[2] = {bflo(x2w), bfhi(x2w)};
                  const float rsk_ = rs_ckv * (1.0f / (float)(1 << FP8_AEXP));
                  float ss = 0.f;
#pragma unroll
                  for (int e = 0; e < 8; ++e) { v[e] *= rsk_; ss += v[e] * v[e]; }
#pragma unroll
                  for (int e = 0; e < 2; ++e) ss += x1[e] * x1[e] + x2[e] * x2[e];
                  const float rn = __builtin_amdgcn_rsqf(sum8(ss, C.lane) * (1.0f / 96.0f) + EPS);
#pragma unroll
                  for (int e = 0; e < 8; ++e) v[e] *= rn * gka_n[e];
                  float o1[2], o2[2];
#pragma unroll
                  for (int e = 0; e < 2; ++e) { const float a1 = x1[e] * rn * gka_r[e], a2 = x2[e] * rn * gka_r[2 + e];
                      if (isctx) { o1[e] = a1; o2[e] = a2; } else { const float cc_ = t_a[k][2 * e], ss_ = t_a[k][2 * e + 1]; o1[e] = a1 * cc_ - a2 * ss_; o2[e] = a1 * ss_ + a2 * cc_; } }
                  unsigned char* ka = KA + krow * 1024 + h * 128;
                  u32x4 w; w.x = pk4_fp8(v[0], v[1], v[2], v[3]); w.y = pk4_fp8(v[4], v[5], v[6], v[7]); w.z = pk4_fp8(o1[0], o1[1], o2[0], o2[1]); w.w = 0u;
                  *(u32x4*)(ka + 16 * j) = w;
                  const f32x2 q0 = __builtin_amdgcn_cvt_pk_f32_fp8((int)vv.x, false), q1 = __builtin_amdgcn_cvt_pk_f32_fp8((int)vv.x, true), q2 = __builtin_amdgcn_cvt_pk_f32_fp8((int)vv.y, false), q3 = __builtin_amdgcn_cvt_pk_f32_fp8((int)vv.y, true);
                  u32x4 wv; wv.x = pk2(q0[0] * rsk_, q0[1] * rsk_); wv.y = pk2(q1[0] * rsk_, q1[1] * rsk_); wv.z = pk2(q2[0] * rsk_, q2[1] * rsk_); wv.w = pk2(q3[0] * rsk_, q3[1] * rsk_);
                  *(u32x4*)(VA + krow * 512 + h * 64 + 8 * j) = wv; }
#pragma unroll
                for (int pass = 0; pass < 2; ++pass) {
                    const int hh = pass ? (h & 1) : h;
                    const u32x2 a = pass ? i_kb[k] : i_qb[k];
                    const f32x2 a0 = __builtin_amdgcn_cvt_pk_f32_fp8((int)a.x, false), a1 = __builtin_amdgcn_cvt_pk_f32_fp8((int)a.x, true), a2 = __builtin_amdgcn_cvt_pk_f32_fp8((int)a.y, false), a3 = __builtin_amdgcn_cvt_pk_f32_fp8((int)a.y, true);
                    constexpr float u8_ = 1.0f / (float)(1 << FP8_AEXP);
                    float v[8] = {a0[0] * u8_, a0[1] * u8_, a1[0] * u8_, a1[1] * u8_, a2[0] * u8_, a2[1] * u8_, a3[0] * u8_, a3[1] * u8_};
                    float ss = 0.f;
#pragma unroll
                    for (int e = 0; e < 8; ++e) ss += v[e] * v[e];
                    const float rn = (pass ? 1.0f : SCB) * __builtin_amdgcn_rsqf(sum8(ss, C.lane) * (1.0f / 64.0f) + EPS);
#pragma unroll
                    for (int e = 0; e < 8; ++e) v[e] *= rn * (pass ? gkb8[e] : gqb8[e]);
                    float o[8];
#pragma unroll
                    for (int e = 0; e < 8; ++e) { const float px = dppf<DPP_X2>(v[e]);
                        if (isctx) o[e] = v[e];
                        else { const float cc_ = t_b[k][e >> 1][2 * (e & 1)], ss_ = t_b[k][e >> 1][2 * (e & 1) + 1]; o[e] = (j & 2) ? (px * ss_ + v[e] * cc_) : (v[e] * cc_ - px * ss_); } }
                    const float qs = pass ? 1.0f : (float)(1 << att::QEXP);
                    u32x2 w; w.x = pk4_fp8(o[0] * qs, o[1] * qs, o[2] * qs, o[3] * qs); w.y = pk4_fp8(o[4] * qs, o[5] * qs, o[6] * qs, o[7] * qs);
                    if (!pass) *(u32x2*)(QB + (size_t)r * 512 + h * 64 + 8 * j) = w;
                    else if (C.lane < 16) *(u32x2*)(KB + krow * 128 + hh * 64 + 8 * j) = w;
                }
                if (C.lane >= 16 && C.lane < 32) { const u32x2 a = i_vb[k]; constexpr float u8_ = 1.0f / (float)(1 << FP8_AEXP);
                    const f32x2 a0 = __builtin_amdgcn_cvt_pk_f32_fp8((int)a.x, false), a1 = __builtin_amdgcn_cvt_pk_f32_fp8((int)a.x, true), a2 = __builtin_amdgcn_cvt_pk_f32_fp8((int)a.y, false), a3 = __builtin_amdgcn_cvt_pk_f32_fp8((int)a.y, true);
                    u32x4 wv; wv.x = pk2(a0[0] * u8_, a0[1] * u8_); wv.y = pk2(a1[0] * u8_, a1[1] * u8_); wv.z = pk2(a2[0] * u8_, a2[1] * u8_); wv.w = pk2(a3[0] * u8_, a3[1] * u8_);
                    *(u32x4*)(VB + krow * 128 + (C.lane - 16) * 8) = wv; }
              }
            }
          }
        }
        SEAM(P + 3);

        if (EN(5) && IN(P + 4)) {
#pragma unroll 1
          for (int rep = 0; rep < NREP(5); ++rep) {
            PH();
            const float* cb = (const float*)(ws + WS_MISC + MO_CB) + l * 2;
            const float negA = cb[0], negB = cb[1];
            unsigned char* O = (unsigned char*)R1;
            const int NU = 1024 + (lastl ? 0 : 64);
            for (int u = C.vcu; u < NU; u += C.G) {
                int kind, b, hd, NT; size_t r0;
                if (u < 1024) { const int i = u >> 8, v = u & 255, idx = 2 * v + (i >> 1); kind = i & 1; NT = LK / 64;
                    if (kind == 0) { const int bh = idx >> 4, qb = idx & 15; b = bh >> 3; hd = bh & 7; r0 = (size_t)TC + (size_t)b * SEQ + qb * 256 + C.wave * 32; }
                    else { const int bk = idx >> 6, jj = idx & 63, qb = jj >> 2, g = jj & 3; b = bk >> 1; hd = (bk & 1) * 4 + g; r0 = (size_t)TC + (size_t)b * SEQ + qb * 256 + C.wave * 32; } }
                else { const int w = u - 1024, bh = w & 31; kind = w >> 5; b = bh >> 3; hd = bh & 7; NT = CTXL / 64; r0 = (size_t)b * CTXL + C.wave * 32; }
                if (kind == 0) att::attn_unit<96>(QA8 + r0 * 1024 + hd * 128, 1024, KA + (size_t)b * LK * 1024 + hd * 128, 1024, VA + (size_t)b * LK * 512 + hd * 64, 512, O + r0 * DM + hd * 64, NT, negA, C.lds);
                else att::attn_unit<64>(QB + r0 * 512 + hd * 64, 512, KB + (size_t)b * LK * 128 + (hd >> 2) * 64, 128, VB + (size_t)b * LK * 128 + (hd >> 2) * 64, 128, O + r0 * DM + 512 + hd * 64, NT, negB, C.lds);
            }
            if (!lastl && C.vcu + 1024 >= NU) { __syncthreads();
                const int g0 = convert_steal(C, l, CONV_NQUEUE, 1); if (g0 < 1 && l + 1 < NLAYER) (void)convert_steal(C, l + 1, CONV_NQUEUE, 1); }
          }
        }
        SEAM(P + 4);

        if (EN(6) && IN(P + 5)) {
#pragma unroll 1
          for (int rep = 0; rep < NREP(6); ++rep) {
            PH();
            const int M = T - TC; const unsigned char* O = (const unsigned char*)R1 + (size_t)TC * DM;
            constexpr int SW = 0x01010101 * (127 - FP8_WEXP), SA = 0x01010101 * (127 - FP8_AEXP);
            pg8::StaticOrder S; S.init(M, DM, C.G, (int)blockIdx.x, DM / 2, DM / 2);
            pg8::EpiGateF E{(unsigned char*)YY + (size_t)TC * DM, (const unsigned char*)PROJ + (size_t)TC * PROW};
            pg8::gemm_phase<pg8::EpiGateF, pg8::StaticOrder, false, 1, true>(C.lds, (const bf16*)O, DM / 2, WB + WO_OA, DM / 2, S, E, gtab, SW, SA);
            if (mrow0 == 0) ctx_mini_gemm<true>(C, (const unsigned char*)R1, (const unsigned char*)(WB + WO_OA), SW, SA, (unsigned char*)YY, (const unsigned char*)PROJ, nullptr, nullptr, nullptr);
            if ((S.nwg + C.G - 1 - S.c) / C.G < (S.nwg + C.G - 1) / C.G) { const int g0 = convert_steal(C, l, CONV_NQUEUE, 4); if (g0 < 4 && l + 1 < NLAYER) (void)convert_steal(C, l + 1, CONV_NQUEUE, 4 - g0); }
          }
        }
        SEAM(P + 5);

        if (EN(7) && IN(P + 6)) {
#pragma unroll 1
          for (int rep = 0; rep < (NREP(7) > 1 && l == 0 ? 2 : 1); ++rep) {
            PH();
            const int M = T - TC;
            constexpr int SW = 0x01010101 * (127 - FP8_WEXP), SA = 0x01010101 * (127 - FP8_AEXP);
            pg8::StaticOrder S; S.init(M, DM, C.G, (int)blockIdx.x, DM / 2, DM / 2);
            pg8::EpiRes E{XS, modl, TC, 2};
            pg8::gemm_phase<pg8::EpiRes, pg8::StaticOrder, false, 1>(C.lds, (const bf16*)((const unsigned char*)YY + (size_t)TC * DM), DM / 2, WB + WO_OUT, DM / 2, S, E, gtab, SW, SA);
            if (mrow0 == 0) ctx_mini_gemm<false>(C, (const unsigned char*)YY, (const unsigned char*)(WB + WO_OUT), SW, SA, nullptr, nullptr, nullptr, XS, modl + (size_t)(4 * 6 + 2) * DM);
            if ((S.nwg + C.G - 1 - S.c) / C.G < (S.nwg + C.G - 1) / C.G) { const int g0 = convert_steal(C, l, CONV_NQUEUE, 4); if (g0 < 4 && l + 1 < NLAYER) (void)convert_steal(C, l + 1, CONV_NQUEUE, 4 - g0); }
          }
        }
        SEAM(P + 6);

        if (EN(8) && IN(P + 7)) {
#pragma unroll 1
          for (int rep = 0; rep < NREP(8); ++rep) {
            PH();
            const unsigned hq = queue_head_early(C, l);
            float mA[10], mB[10]; f32x4 gv[4];
            LAS float* wT = (LAS float*)C.lds;
            { const f32x4* wsrc = (const f32x4*)CIN(20); f32x4 wq[8];
#pragma unroll
              for (int q = 0; q < 8; ++q) wq[q] = wsrc[q * NTHR + C.tid];
#pragma unroll
              for (int q = 0; q < 10; ++q) { const int i = q * NTHR + C.tid, w = i >> 10, j = i & 1023; mA[q] = modl[(size_t)(w * 6 + 3) * DM + j]; mB[q] = modl[(size_t)(w * 6 + 4) * DM + j]; }
#pragma unroll
              for (int j = 0; j < 4; ++j) gv[j] = *(const f32x4*)(CIN(7) + l * DM + j * 256 + 4 * C.lane);
              sweep_late(C, l, CONV_NQUEUE, hq);
#pragma unroll
              for (int q = 0; q < 8; ++q) { const int i4 = q * NTHR + C.tid, d = i4 >> 2, e0 = (i4 & 3) * 4;
#pragma unroll
                  for (int k = 0; k < 4; ++k) wT[(e0 + k) * DM + d] = wq[q][k]; } }
            LAS int* lcnt = (LAS int*)(C.lds + 65536);
            LAS int* rt_row = lcnt + 32; LAS int* rt_e = rt_row + 256; LAS int* rt_lp = rt_e + 512; LAS float* rt_w = (LAS float*)(rt_lp + 512);
            if (C.tid < 32) lcnt[C.tid] = 0;
            __syncthreads();
            const float* brt = CIN(21);
            LAS float* mt = (LAS float*)(C.lds + 80 * 1024);
#pragma unroll
            for (int q = 0; q < 10; ++q) { const int i = q * NTHR + C.tid; mt[i] = mA[q]; mt[5 * DM + i] = mB[q]; }
            __syncthreads();
            unsigned* cnt = ctl + CW_CNT + l * 1024 + ((rep + 1 < NREP(8)) ? 2048 : 0);
            int* liste = (int*)(ws + WS_ROUTE + RO_LISTE); float* roww = (float*)(ws + WS_ROUTE + RO_ROWW); int* tokpos = (int*)(ws + WS_ROUTE + RO_TOKPOS);
            int rb, re; wave_rows(C.gw, C.NGW, mrow0, T, rb, re);
            const int lb3 = (C.lane >> 3) & 1, lb2 = (C.lane >> 2) & 1, lb1 = (C.lane >> 1) & 1, lb0 = C.lane & 1;
            const float brl = brt[C.lane & 15];
            for (int r0 = rb; r0 < re; r0 += 3) {
                f32x4 v[3][4], f[3][4];
#pragma unroll
                for (int k = 0; k < 3; ++k) { const int r = (r0 + k < re) ? r0 + k : re - 1; xs_load(XS + (size_t)r * DM, C.lane, v[k]); }
#pragma unroll
                for (int k = 0; k < 3; ++k) { const int r = (r0 + k < re) ? r0 + k : re - 1, which = (r < TC) ? 4 : ((r - TC) >> 12);
                    norm_mod_row(C, v[k], gv, mt + which * DM, mt + (5 + which) * DM, (unsigned char*)R1 + (size_t)r * DM, f[k]); }
                float a[3][16];
#pragma unroll
                for (int e = 0; e < 16; ++e) { f32x4 w[4];
#pragma unroll
                    for (int j = 0; j < 4; ++j) w[j] = *(const LAS f32x4*)(wT + e * DM + j * 256 + 4 * C.lane);
#pragma unroll
                    for (int k = 0; k < 3; ++k) { f32x4 a4 = f[k][0] * w[0];
#pragma unroll
                        for (int j = 1; j < 4; ++j) a4 = f[k][j] * w[j] + a4;
                        float t = (a4.x + a4.y) + (a4.z + a4.w);
                        asm volatile("" : "+v"(t)); a[k][e] = t; }
                    if (e & 1) __builtin_amdgcn_sched_barrier(0); }
#pragma unroll
                for (int k = 0; k < 3; ++k) {
                    float b8[8], b4[4], b2[2], b1;
#pragma unroll
                    for (int i = 0; i < 8; ++i) { const float snd = lb3 ? a[k][i] : a[k][i + 8], kp = lb3 ? a[k][i + 8] : a[k][i]; b8[i] = kp + dppf<DPP_RM>(snd); }
#pragma unroll
                    for (int i = 0; i < 4; ++i) { const float snd = lb2 ? b8[i] : b8[i + 4], kp = lb2 ? b8[i + 4] : b8[i]; b4[i] = kp + dppf<DPP_HM>(snd); }
#pragma unroll
                    for (int i = 0; i < 2; ++i) { const float snd = lb1 ? b4[i] : b4[i + 2], kp = lb1 ? b4[i + 2] : b4[i]; b2[i] = kp + dppf<DPP_X2>(snd); }
                    { const float snd = lb0 ? b2[0] : b2[1], kp = lb0 ? b2[1] : b2[0]; b1 = kp + dppf<DPP_X1>(snd); }
                    b1 += shx(b1, C.lane, 16); b1 += shx(b1, C.lane, 32);
                    const float scl = sigmoidf_(b1), sel = scl + brl;
                    const float x1 = dppf<DPP_X1>(sel), x2 = dppf<DPP_X2>(sel), x3 = dppf<0x1B>(sel);
                    const float gsum = fmaxf(fmaxf(fmaxf(sel + x1, sel + x2), fmaxf(sel + x3, x1 + x2)), fmaxf(x1 + x3, x2 + x3));
                    float best = rlane(gsum, 0); int bg = 0;
#pragma unroll
                    for (int g = 1; g < 4; ++g) { const float gs = rlane(gsum, 4 * g); if (gs > best) { best = gs; bg = g; } }
                    float m1 = -1e30f, m2 = -1e30f, w1 = 0.f, w2 = 0.f; int e1 = 0, e2 = 0;
#pragma unroll
                    for (int q = 0; q < 4; ++q) { const int e = 4 * bg + q; const float x = rlane(sel, e), sv = rlane(scl, e);
                        if (x > m1) { m2 = m1; e2 = e1; w2 = w1; m1 = x; e1 = e; w1 = sv; } else if (x > m2) { m2 = x; e2 = e; w2 = sv; } }
                    if (r0 + k < re && C.lane == 0) { const int r = r0 + k, slot = C.wave * 32 + (r - rb); const float inv = 1.0f / (w1 + w2);
                        const int lp1 = __hip_atomic_fetch_add(lcnt + e1, 1, __ATOMIC_RELAXED, __HIP_MEMORY_SCOPE_WORKGROUP), lp2 = __hip_atomic_fetch_add(lcnt + e2, 1, __ATOMIC_RELAXED, __HIP_MEMORY_SCOPE_WORKGROUP);
                        rt_row[slot] = r; rt_e[2 * slot] = e1; rt_e[2 * slot + 1] = e2; rt_lp[2 * slot] = lp1; rt_lp[2 * slot + 1] = lp2; rt_w[2 * slot] = w1 * inv; rt_w[2 * slot + 1] = w2 * inv; }
                }
            }
            __syncthreads();
            if (C.tid < 16) { const int n = lcnt[C.tid]; lcnt[16 + C.tid] = (n > 0) ? (int)__hip_atomic_fetch_add(cnt + 64 * C.tid, (unsigned)n, __ATOMIC_RELAXED, __HIP_MEMORY_SCOPE_AGENT) : 0; }
            __syncthreads();
            if (C.lane < re - rb) { const int slot = C.wave * 32 + C.lane, r = rt_row[slot];
#pragma unroll
                for (int q = 0; q < 2; ++q) { const int e = rt_e[2 * slot + q], p = lcnt[16 + e] + rt_lp[2 * slot + q];
                    liste[(size_t)e * T + p] = r; roww[(size_t)e * T + p] = rt_w[2 * slot + q]; tokpos[2 * r + q] = (e << 20) | p; } }
            __syncthreads();
          }
        }
        SEAM(P + 7);

        if (EN(9) && IN(P + 8)) {
#pragma unroll 1
          for (int rep = 0; rep < NREP(9); ++rep) {
            PH();
            expert_prefix(ctl + CW_CNT + l * 1024, mrow0, pfxl, C.tid);
            constexpr int SW = 0x01010101 * (127 - FP8_WEXP), SA0 = 0x7f7f7f7f;
            pg8::GroupedOrder S{pfxl, C.G, C.vcu, DM / 2, (size_t)1024 * 1024, 0};
            { const int* liste = (const int*)(ws + WS_ROUTE + RO_LISTE); const unsigned* cnt = ctl + CW_CNT + l * 1024; pg8::Unit u;
#pragma unroll 1
              for (int i = 0; i < 8 && S.next(i, u); ++i) if (C.tid < 256) { const int idx = u.lt * 256 + C.tid;
                  gtab[i * 256 + C.tid] = (u.e == 16) ? (mrow0 + idx) : ((idx < (int)cnt[64 * u.e]) ? liste[(size_t)u.e * T + idx] : mrow0); } }
            __syncthreads();
            pg8::EpiGlu E{HH};
            pg8::gemm_phase<pg8::EpiGlu, pg8::GroupedOrder, true, 2>(C.lds, R1, DM / 2, WB + WO_GU, DM / 2, S, E, gtab, SW, SA0, 1.0f / (float)(1 << (I8_AEXP + I8_WEXP)));
            if (l + 1 < NLAYER) { const int nu = 4 * __builtin_amdgcn_readfirstlane(pfxl[17]); if ((nu + C.G - 1 - C.vcu) / C.G < (nu + C.G - 1) / C.G) (void)convert_steal(C, l + 1, CONV_NQUEUE, 2); }
          }
        }
        SEAM(P + 8);

        if (EN(10) && IN(P + 9)) {
#pragma unroll 1
          for (int rep = 0; rep < NREP(10); ++rep) {
            PH();
            if (!IN(P + 8)) expert_prefix(ctl + CW_CNT + l * 1024, mrow0, pfxl, C.tid);
            constexpr int SW = 0x01010101 * (127 - FP8_WEXP), SA = 0x01010101 * (127 - FP8_AEXP);
            pg8::GroupedOrder S{pfxl, C.G, C.vcu, FF / 2, (size_t)1024 * 512, (size_t)256 * FF};
            pg8::EpiDown E{(unsigned char*)PROJ, (const float*)(ws + WS_ROUTE + RO_ROWW)};
            pg8::gemm_phase<pg8::EpiDown, pg8::GroupedOrder, false, 1>(C.lds, HH, FF / 2, WB + WO_DN, FF / 2, S, E, gtab, SW, SA);
            if (l + 1 < NLAYER) { const int nu = 4 * __builtin_amdgcn_readfirstlane(pfxl[17]); if ((nu + C.G - 1 - C.vcu) / C.G < (nu + C.G - 1) / C.G) (void)convert_steal(C, l + 1, CONV_NQUEUE, 2); }
          }
        }
        SEAM(P + 9);
    }

    if (EN(11) && IN(NPHASE - 1)) {
#pragma unroll 1
      for (int rep = 0; rep < NREP(11); ++rep) {
        const int l = NLAYER - 1; PH();
        if (!IN(NPHASE - 3)) expert_prefix(ctl + CW_CNT + (NLAYER - 1) * 1024, TC, pfxl, C.tid);
        LAS float* mt = (LAS float*)C.lds; mod_chunk_to_lds(mt, modl, 5, C.tid); __syncthreads();
        int rb, re; wave_rows(C.gw, C.NGW, TC, T, rb, re);
        constexpr int NB = 4;
        CombIdx cn[NB];
#pragma unroll
        for (int k = 0; k < NB; ++k) { const int r = (rb + k < re) ? rb + k : re - 1; cn[k] = comb_idx(C, r, pfxl, TC); }
        for (int r0 = rb; r0 < re; r0 += NB) {
            f32x4 v[NB][4]; unsigned y[NB][3][4]; CombIdx ci[NB];
#pragma unroll
            for (int k = 0; k < NB; ++k) { const int r = (r0 + k < re) ? r0 + k : re - 1; ci[k] = cn[k]; xs_load(XS + (size_t)r * DM, C.lane, v[k]); }
#pragma unroll
            for (int k = 0; k < NB; ++k) comb_load(C, ci[k], y[k]);
#pragma unroll
            for (int k = 0; k < NB; ++k) { const int r = (r0 + NB + k < re) ? r0 + NB + k : re - 1; cn[k] = comb_idx(C, r, pfxl, TC); }
#pragma unroll
            for (int k = 0; k < NB; ++k) if (r0 + k < re) { const int r = r0 + k, which = (r - TC) >> 12; comb_apply(C, mt + which * DM, y[k], v[k]); float* dst = COUT + (size_t)(r - TC) * DM;
#pragma unroll
                for (int j = 0; j < 4; ++j) *(f32x4*)(dst + j * 256 + 4 * C.lane) = v[k][j]; }
        }
      }
    }
#undef IN
#undef SEAM
}

#ifndef MK_PER_PHASE
#define MK_PER_PHASE 0
#endif
extern "C" void kernel_launch(void* const* d_in, const int* in_sizes, int n_in, void* d_out, int out_size, void* d_ws, size_t ws_size, hipStream_t stream) {
    static int grid = 0;
    if (grid == 0) {
        if (n_in != 28 || out_size != TL * DM || ws_size < WS_END) { fprintf(stderr, "kernel_launch: unexpected shapes (n_in %d, out %d, ws %zu)\n", n_in, out_size, ws_size); grid = -1; return; }
        int dev = 0, cus = 0, per_cu = 0;
        if (hipGetDevice(&dev) != hipSuccess || hipDeviceGetAttribute(&cus, hipDeviceAttributeMultiprocessorCount, dev) != hipSuccess) { grid = -1; return; }
        if (hipFuncSetAttribute((const void*)fwd_kernel, hipFuncAttributeMaxDynamicSharedMemorySize, LDS_BYTES) != hipSuccess) { fprintf(stderr, "kernel_launch: hipFuncSetAttribute failed\n"); grid = -1; return; }
        if (hipOccupancyMaxActiveBlocksPerMultiprocessor(&per_cu, (const void*)fwd_kernel, NTHR, LDS_BYTES) != hipSuccess || per_cu < 1) { fprintf(stderr, "kernel_launch: occupancy query says %d\n", per_cu); }
        (void)hipGetLastError();
        grid = cus;
    }
    if (grid < 0) return;
    (void)hipMemsetAsync((char*)d_ws + WS_CTL, 0, CTL_ZERO_BYTES, stream);
    Args a{};
    for (int i = 0; i < 28; ++i) a.in[i] = (const float*)d_in[i];
    a.out = (float*)d_out; a.ws = (unsigned char*)d_ws;
#if MK_PER_PHASE
    for (int p = 0; p < NPHASE; ++p) { a.ph_lo = p; a.ph_hi = p + 1; a.li = p; hipLaunchKernelGGL(fwd_kernel, dim3(grid), dim3(NTHR), LDS_BYTES, stream, a); }
#else
    a.ph_lo = 0; a.ph_hi = NPHASE; a.li = 0;
    hipLaunchKernelGGL(fwd_kernel, dim3(grid), dim3(NTHR), LDS_BYTES, stream, a);
#endif
}
```

```cpp
#define REPMASK 0x00
#define BARX 1
#include <hip/hip_runtime.h>
#ifdef MK_PER_PHASE
#define MK_PER_PHASE_ MK_PER_PHASE
#else
#define MK_PER_PHASE_ 0
#endif
#include <cstdio>
#include <cstdint>

#define GAS __attribute__((address_space(1)))
#define LAS __attribute__((address_space(3)))
typedef unsigned short bf16;
typedef short bf16x8 __attribute__((ext_vector_type(8)));
typedef short s16x4 __attribute__((ext_vector_type(4)));
typedef float f32x2 __attribute__((ext_vector_type(2)));
typedef float f32x4 __attribute__((ext_vector_type(4)));
typedef float f32x16 __attribute__((ext_vector_type(16)));
typedef unsigned u32x2 __attribute__((ext_vector_type(2)));
typedef unsigned u32x4 __attribute__((ext_vector_type(4)));

constexpr int DM = 1024, NB = 4, SEQ = 4096, CTXL = 256, NLAYER = 2;
constexpr int TC = NB * CTXL;
constexpr int TL = NB * SEQ;
constexpr int T = TC + TL;
constexpr int LK = CTXL + SEQ;
constexpr int INC = 3232, INCP = 3328;
constexpr int C_CQ = 0, C_CKV = 256, C_KR = 384, C_QB = 416, C_KB = 928, C_VB = 1056, C_GA = 1184, C_GB = 2208;
constexpr int PQ8 = 1024, PK8 = 1536, PV8 = 1664;
constexpr int PROW = INCP * 2, GA8 = 2560, GB8 = 3584;
constexpr int NEXP = 16, FF = 512;
constexpr float EPS = 1e-6f;
constexpr float LOG2E = 1.4426950408889634f;
constexpr float SCA = 0.10206207261596575f * LOG2E;
constexpr float SCB = 0.125f * LOG2E;
constexpr int NWAVES = 8, NTHR = 512;

constexpr size_t MiB = 1u << 20;
constexpr size_t WS_CTL = 0, CTL_ZERO_BYTES = (MK_PER_PHASE_ ? 1024 : 64) * 1024;
constexpr size_t WS_MISC = 1 * MiB;
constexpr size_t WS_CTXS = 2 * MiB;
constexpr size_t WS_ROUTE = 6 * MiB;
constexpr size_t WS_W = 9 * MiB;
constexpr size_t WS_R1 = 73 * MiB;
constexpr size_t WS_R2 = 107 * MiB;
constexpr size_t WS_R3 = 218 * MiB;
constexpr size_t WS_R4 = 286 * MiB;
constexpr size_t WS_R5 = 312 * MiB;
constexpr size_t WS_END = 346 * MiB;
constexpr size_t MO_MODV = 0;
constexpr size_t MO_TABA = 256 * 1024;
constexpr size_t MO_TABB = MO_TABA + 4096;
constexpr size_t MO_CB = MO_TABB + 8192;
constexpr size_t RO_LISTE = 0;
constexpr size_t RO_ROWW = (size_t)NEXP * T * 4;
constexpr size_t RO_TOKPOS = 2 * RO_ROWW;
constexpr size_t WO_IN = 0;
constexpr size_t WO_UQ = WO_IN + (size_t)INCP * 1024 / 2;
constexpr size_t WO_UKV = WO_UQ + 768 * 256;
constexpr size_t WO_OA = WO_UKV + 1024 * 256;
constexpr size_t WO_OUT = WO_OA + 1024 * 1024 / 2;
constexpr size_t WO_GU = WO_OUT + 1024 * 1024 / 2;
constexpr size_t WO_DN = WO_GU + (size_t)17 * 1024 * 1024 / 2;
constexpr size_t WO_END = WO_DN + (size_t)17 * 1024 * 512 / 2;
constexpr size_t WL_STRIDE = 16 * MiB;
static_assert(WO_END <= WL_STRIDE && WS_W + 2 * WL_STRIDE * 2 <= WS_R1, "weights region");
constexpr size_t R3_KA = 0, R3_VA = (size_t)T * 1024, R3_QB = R3_VA + (size_t)T * 512 * 2, R3_KB = R3_QB + (size_t)T * 512, R3_VB = R3_KB + (size_t)T * 128, R3_QA = R3_VB + (size_t)T * 128 * 2;
constexpr size_t R3_Y1 = 0, R3_Y = (size_t)T * 1024 * 2, R3_HH = 0;
constexpr int HHROWS = 3 * T + 17 * 256;
static_assert(R3_QA + (size_t)T * 1024 <= 68 * MiB && (size_t)HHROWS * 512 * 2 <= 68 * MiB && (size_t)HHROWS * 1024 * 2 <= 111 * MiB, "regions");
constexpr int CW_STEAL = 512;
constexpr int CW_CNT = 1024;
constexpr int CW_BAR = 4096;

constexpr int RING_BYTES = 131072;
constexpr int LDSX_OFF = RING_BYTES;
constexpr int LDSX_GTAB = LDSX_OFF;
constexpr int LDSX_PFX = LDSX_OFF + 8192;
constexpr int LDSX_MISC = LDSX_OFF + 8192 + 256;
constexpr int LDS_BYTES = 147456;

__device__ __forceinline__ unsigned f2bf(float f) { unsigned u = __builtin_bit_cast(unsigned, f); return (u + 0x7fffu + ((u >> 16) & 1u)) >> 16; }
typedef __bf16 bf16x2_hw __attribute__((ext_vector_type(2)));
__device__ __forceinline__ unsigned pk2(float lo, float hi) { const f32x2 v = {lo, hi}; return __builtin_bit_cast(unsigned, __builtin_convertvector(v, bf16x2_hw)); }
__device__ __forceinline__ unsigned pk4_fp8(float a, float b, float c, float d) { int w = 0; w = __builtin_amdgcn_cvt_pk_fp8_f32(a, b, w, false); w = __builtin_amdgcn_cvt_pk_fp8_f32(c, d, w, true); return (unsigned)w; }
constexpr int I8_AEXP = 4, I8_WEXP = 9;
__device__ __forceinline__ unsigned pk4_i8(float a, float b, float c, float d, float scl) {
    const float M = 12582912.0f;
    const unsigned qa = __builtin_bit_cast(unsigned, __builtin_amdgcn_fmed3f(a * scl, -127.f, 127.f) + M), qb = __builtin_bit_cast(unsigned, __builtin_amdgcn_fmed3f(b * scl, -127.f, 127.f) + M);
    const unsigned qc = __builtin_bit_cast(unsigned, __builtin_amdgcn_fmed3f(c * scl, -127.f, 127.f) + M), qd = __builtin_bit_cast(unsigned, __builtin_amdgcn_fmed3f(d * scl, -127.f, 127.f) + M);
    const unsigned lo = __builtin_amdgcn_perm(qb, qa, 0x0c0c0400u), hi = __builtin_amdgcn_perm(qd, qc, 0x0c0c0400u);
    return __builtin_amdgcn_perm(hi, lo, 0x05040100u);
}
__device__ __forceinline__ unsigned pk4_fp8_sat(float a, float b, float c, float d) {
    return pk4_fp8(__builtin_amdgcn_fmed3f(a, -448.f, 448.f), __builtin_amdgcn_fmed3f(b, -448.f, 448.f), __builtin_amdgcn_fmed3f(c, -448.f, 448.f), __builtin_amdgcn_fmed3f(d, -448.f, 448.f)); }
constexpr int FP8_WEXP = 5;
constexpr int FP8_AEXP = 3;
__device__ __forceinline__ float bflo(unsigned w) { return __builtin_bit_cast(float, w << 16); }
__device__ __forceinline__ float bfhi(unsigned w) { return __builtin_bit_cast(float, w & 0xffff0000u); }
template <int CTRL> __device__ __forceinline__ float dppf(float v) { return __builtin_bit_cast(float, __builtin_amdgcn_update_dpp(0, __builtin_bit_cast(int, v), CTRL, 0xF, 0xF, true)); }
#define DPP_X1 0xB1
#define DPP_X2 0x4E
#define DPP_HM 0x141
#define DPP_RM 0x140
__device__ __forceinline__ float rlane(float v, int l) { return __builtin_bit_cast(float, __builtin_amdgcn_readlane(__builtin_bit_cast(int, v), l)); }
__device__ __forceinline__ float row_sum16(float v) { v += dppf<DPP_X1>(v); v += dppf<DPP_X2>(v); v += dppf<DPP_HM>(v); v += dppf<DPP_RM>(v); return v; }
__device__ __forceinline__ float wave_sum(float v, int) { v = row_sum16(v); return (rlane(v, 0) + rlane(v, 16)) + (rlane(v, 32) + rlane(v, 48)); }
__device__ __forceinline__ float sum8(float v, int) { v += dppf<DPP_X1>(v); v += dppf<DPP_X2>(v); v += dppf<DPP_HM>(v); return v; }
__device__ __forceinline__ float shx(float v, int lane, int o) { return __builtin_bit_cast(float, __builtin_amdgcn_ds_bpermute((lane ^ o) << 2, __builtin_bit_cast(int, v))); }
__device__ __forceinline__ float sigmoidf_(float x) { return __builtin_amdgcn_rcpf(1.0f + __builtin_amdgcn_exp2f(-x * LOG2E)); }
__device__ __forceinline__ f32x4 sigmoid4(f32x4 x) {
    const f32x4 t = x * (-LOG2E); f32x4 e; e.x = __builtin_amdgcn_exp2f(t.x); e.y = __builtin_amdgcn_exp2f(t.y); e.z = __builtin_amdgcn_exp2f(t.z); e.w = __builtin_amdgcn_exp2f(t.w);
    const f32x4 d = e + 1.0f; f32x4 r; r.x = __builtin_amdgcn_rcpf(d.x); r.y = __builtin_amdgcn_rcpf(d.y); r.z = __builtin_amdgcn_rcpf(d.z); r.w = __builtin_amdgcn_rcpf(d.w); return r;
}
#define LDS_WAIT() asm volatile("s_waitcnt lgkmcnt(0)" ::: "memory")
#define VM_WAIT() asm volatile("s_waitcnt vmcnt(0)" ::: "memory")

namespace pg8 {
constexpr int BM = 256, BK = 64, HALF = 128, HTB = HALF * BK * 2, STAGE_BYTES = 8 * HTB, NXCD = 8, WGM = 8;
__device__ __forceinline__ int lds_byte(int r, int c) { const int st = (r >> 4) * 2 + (c >> 5), rr = r & 15, cc = c & 31, ob = rr * 64 + cc * 2; return st * 1024 + (ob ^ (((ob >> 9) & 1) << 5)); }
__device__ __forceinline__ void stage_rc(int b, int& R, int& C) { const int st = b / 1024, sb = b % 1024, swz = sb ^ (((sb >> 9) & 1) << 5); R = (st >> 1) * 16 + swz / 64; C = (st & 1) * 32 + (swz % 64) / 2; }
__device__ __forceinline__ int perm32(int rho) { const int n = rho >> 4, i = rho & 15; return 8 * (i >> 2) + 4 * n + (i & 3); }

struct Unit { int pm, pn, e, lt; };

struct StaticOrder {
    int nM, nN, nwg, G, c, lda, K;
    __device__ __forceinline__ void init(int M, int N, int G_, int c_, int lda_, int K_) { nM = M / BM; nN = N / BM; nwg = nM * nN; G = G_; c = c_; lda = lda_; K = K_; }
    __device__ __forceinline__ bool next(int i, Unit& u) const {
        const long L = (long)i * G + c; if (L >= nwg) return false;
        int wgid = (int)L; { const int q = nwg / NXCD, r = nwg % NXCD, xcd = wgid % NXCD, off = wgid / NXCD; wgid = (xcd < r ? xcd * (q + 1) : r * (q + 1) + (xcd - r) * q) + off; }
        const int nig = WGM * nN, gid = wgid / nig, fm = gid * WGM, gsz = (nM - fm) < WGM ? (nM - fm) : WGM;
        u.pm = fm + ((wgid % nig) % gsz); u.pn = (wgid % nig) / gsz; u.e = 0; u.lt = 0; return true;
    }
    __device__ __forceinline__ size_t a_off(const Unit& u) const { return (size_t)u.pm * BM * lda * 2; }
    __device__ __forceinline__ size_t b_off(const Unit& u) const { return (size_t)u.pn * BM * K * 2; }
};
struct GroupedOrder {
    const LAS int* pfx; int G, vcu, K; size_t estride;
    size_t a_stride;
    __device__ __forceinline__ bool next(int i, Unit& u) const {
        const int U = i * G + vcu, ntl = __builtin_amdgcn_readfirstlane(pfx[17]);
        if (U >= ntl * 4) return false;
        const int rt = U >> 2; int e = 0;
#pragma unroll
        for (int k = 1; k < 17; ++k) e += (rt >= __builtin_amdgcn_readfirstlane(pfx[k])) ? 1 : 0;
        u.pm = rt; u.pn = U & 3; u.e = e; u.lt = rt - __builtin_amdgcn_readfirstlane(pfx[e]); return true;
    }
    __device__ __forceinline__ size_t a_off(const Unit& u) const { return (size_t)u.pm * a_stride; }
    __device__ __forceinline__ size_t b_off(const Unit& u) const { return (size_t)u.e * estride + (size_t)u.pn * BM * K * 2; }
};

__device__ __forceinline__ unsigned cvt_pk_bf16(float lo, float hi) { unsigned r; asm volatile("v_cvt_pk_bf16_f32 %0, %1, %2" : "=v"(r) : "v"(lo), "v"(hi)); return r; }

#define OPAQ(x) asm volatile("" : "+v"(x))
struct EpiBf16 {
    static constexpr bool PERM = true, WIDE = false; static constexpr int NPRE = 0;
    bf16* O; int ldc;
    __device__ __forceinline__ void operator()(const f32x4 (&acc)[2][2][4][2], const Unit& u, int wr, int wc, int fr, int fq) const {
        char* base = (char*)(O + (size_t)u.pm * BM * ldc + u.pn * BM);
        unsigned off = (unsigned)((wr * 64 + fr) * ldc + wc * 32 + 8 * fq) * 2u; OPAQ(off);
#pragma unroll
        for (int ai = 0; ai < 2; ++ai)
#pragma unroll
          for (int m = 0; m < 4; ++m) {
#pragma unroll
            for (int bj = 0; bj < 2; ++bj) { const f32x4 v0 = acc[ai][bj][m][0], v1 = acc[ai][bj][m][1];
                u32x4 w; w.x = cvt_pk_bf16(v0[0], v0[1]); w.y = cvt_pk_bf16(v0[2], v0[3]); w.z = cvt_pk_bf16(v1[0], v1[1]); w.w = cvt_pk_bf16(v1[2], v1[3]);
                *(u32x4*)(base + off + bj * HALF * 2) = w; }
            off += (unsigned)((m == 3 ? 80 : 16) * ldc) * 2u; OPAQ(off); }
    }
};
struct EpiF8 {
    static constexpr bool PERM = true, WIDE = true; static constexpr int NPRE = 0;
    unsigned char* O; int ldc;
    __device__ __forceinline__ void operator()(const f32x4 (&acc)[2][2][4][2], const Unit& u, int wr, int wc, int fr, int fq) const {
        char* base = (char*)O + (size_t)u.pm * BM * ldc + u.pn * BM;
        unsigned off = (unsigned)((wr * 64 + fr) * ldc + wc * 64 + 16 * fq); OPAQ(off);
        constexpr float sa = (float)(1 << FP8_AEXP);
#pragma unroll
        for (int ai = 0; ai < 2; ++ai)
#pragma unroll
          for (int m = 0; m < 4; ++m) {
            const f32x4 v0 = acc[ai][0][m][0] * sa, v1 = acc[ai][0][m][1] * sa, v2 = acc[ai][1][m][0] * sa, v3 = acc[ai][1][m][1] * sa;
            u32x4 w; w.x = pk4_fp8_sat(v0[0], v0[1], v0[2], v0[3]); w.y = pk4_fp8_sat(v1[0], v1[1], v1[2], v1[3]); w.z = pk4_fp8_sat(v2[0], v2[1], v2[2], v2[3]); w.w = pk4_fp8_sat(v3[0], v3[1], v3[2], v3[3]);
            *(u32x4*)(base + off) = w;
            off += (unsigned)((m == 3 ? 80 : 16) * ldc); OPAQ(off); }
    }
};
struct EpiProj {
    static constexpr bool PERM = true, WIDE = false; static constexpr int NPRE = 0;
    bf16* O;
    __device__ __forceinline__ void operator()(const f32x4 (&acc)[2][2][4][2], const Unit& u, int wr, int wc, int fr, int fq) const {
        if (u.pn >= 2 && u.pn < 5) {
            char* base = (char*)O + (size_t)u.pm * BM * PROW + PQ8 + (u.pn - 2) * BM;
            unsigned off = (unsigned)((wr * 64 + fr) * PROW + wc * 32 + 8 * fq); OPAQ(off);
            constexpr float sa = (float)(1 << FP8_AEXP);
#pragma unroll
            for (int ai = 0; ai < 2; ++ai)
#pragma unroll
              for (int m = 0; m < 4; ++m) {
#pragma unroll
                for (int bj = 0; bj < 2; ++bj) { const f32x4 v0 = acc[ai][bj][m][0] * sa, v1 = acc[ai][bj][m][1] * sa;
                    u32x2 w; w.x = pk4_fp8_sat(v0[0], v0[1], v0[2], v0[3]); w.y = pk4_fp8_sat(v1[0], v1[1], v1[2], v1[3]);
                    *(u32x2*)(base + off + bj * HALF) = w; }
                off += (unsigned)((m == 3 ? 80 : 16) * PROW); OPAQ(off); }
        } else if (u.pn < 2) {
            char* base = (char*)(O + (size_t)u.pm * BM * INCP + u.pn * BM);
            unsigned off = (unsigned)((wr * 64 + fr) * INCP + wc * 32 + 8 * fq) * 2u; OPAQ(off);
#pragma unroll
            for (int ai = 0; ai < 2; ++ai)
#pragma unroll
              for (int m = 0; m < 4; ++m) {
#pragma unroll
                for (int bj = 0; bj < 2; ++bj) { const f32x4 v0 = acc[ai][bj][m][0], v1 = acc[ai][bj][m][1];
                    u32x4 w; w.x = cvt_pk_bf16(v0[0], v0[1]); w.y = cvt_pk_bf16(v0[2], v0[3]); w.z = cvt_pk_bf16(v1[0], v1[1]); w.w = cvt_pk_bf16(v1[2], v1[3]);
                    *(u32x4*)(base + off + bj * HALF * 2) = w; }
                off += (unsigned)((m == 3 ? 80 : 16) * INCP) * 2u; OPAQ(off); }
        } else {
            char* base = (char*)O + (size_t)u.pm * BM * PROW + GA8 + (u.pn - 5) * BM;
            unsigned off = (unsigned)((wr * 64 + fr) * PROW + wc * 32 + 8 * fq); OPAQ(off);
#pragma unroll
            for (int ai = 0; ai < 2; ++ai)
#pragma unroll
              for (int m = 0; m < 4; ++m) {
#pragma unroll
                for (int bj = 0; bj < 2; ++bj) { u32x2 w;
#pragma unroll
                    for (int n = 0; n < 2; ++n) { const f32x4 y = sigmoid4(acc[ai][bj][m][n]) * 255.0f + 0.5f;
                        const unsigned pk = (unsigned)y.x | ((unsigned)y.y << 8) | ((unsigned)y.z << 16) | ((unsigned)y.w << 24); if (n == 0) w.x = pk; else w.y = pk; }
                    *(u32x2*)(base + off + bj * HALF) = w; }
                off += (unsigned)((m == 3 ? 80 : 16) * PROW); OPAQ(off); }
        }
    }
};
template <bool SECOND> struct EpiGate {
    static constexpr bool PERM = true, WIDE = false; static constexpr int NPRE = 0;
    bf16* O; const bf16* Gt; const bf16* Y1;
    __device__ __forceinline__ void operator()(const f32x4 (&acc)[2][2][4][2], const Unit& u, int wr, int wc, int fr, int fq) const {
        char* obase = SECOND ? (char*)O + (size_t)u.pm * BM * DM + u.pn * BM : (char*)(O + (size_t)u.pm * BM * DM + u.pn * BM); const char* ybase = (const char*)(Y1 + (size_t)u.pm * BM * DM + u.pn * BM);
        const char* gbase = (const char*)(Gt + (size_t)u.pm * BM * INCP + u.pn * BM);
        unsigned off = (unsigned)((wr * 64 + fr) * DM + wc * 32 + 8 * fq) * 2u, goff = (unsigned)((wr * 64 + fr) * INCP + wc * 32 + 8 * fq) * 2u; OPAQ(off); OPAQ(goff);
#pragma unroll
        for (int ai = 0; ai < 2; ++ai)
#pragma unroll
          for (int m = 0; m < 4; ++m) {
#pragma unroll
            for (int bj = 0; bj < 2; ++bj) { const f32x4 v0 = acc[ai][bj][m][0], v1 = acc[ai][bj][m][1];
                const u32x4 g = *(const u32x4*)(gbase + goff + bj * HALF * 2);
                float r[8];
                r[0] = v0[0] * sigmoidf_(bflo(g.x)); r[1] = v0[1] * sigmoidf_(bfhi(g.x)); r[2] = v0[2] * sigmoidf_(bflo(g.y)); r[3] = v0[3] * sigmoidf_(bfhi(g.y));
                r[4] = v1[0] * sigmoidf_(bflo(g.z)); r[5] = v1[1] * sigmoidf_(bfhi(g.z)); r[6] = v1[2] * sigmoidf_(bflo(g.w)); r[7] = v1[3] * sigmoidf_(bfhi(g.w));
                if (SECOND) { const u32x4 y = *(const u32x4*)(ybase + off + bj * HALF * 2);
                    r[0] += bflo(y.x); r[1] += bfhi(y.x); r[2] += bflo(y.y); r[3] += bfhi(y.y); r[4] += bflo(y.z); r[5] += bfhi(y.z); r[6] += bflo(y.w); r[7] += bfhi(y.w); }
                if (SECOND) { constexpr float sa = (float)(1 << FP8_AEXP); u32x2 w; w.x = pk4_fp8(r[0] * sa, r[1] * sa, r[2] * sa, r[3] * sa); w.y = pk4_fp8(r[4] * sa, r[5] * sa, r[6] * sa, r[7] * sa);
                    *(u32x2*)(obase + (off >> 1) + bj * HALF) = w; }
                else { u32x4 w; w.x = cvt_pk_bf16(r[0], r[1]); w.y = cvt_pk_bf16(r[2], r[3]); w.z = cvt_pk_bf16(r[4], r[5]); w.w = cvt_pk_bf16(r[6], r[7]);
                    *(u32x4*)(obase + off + bj * HALF * 2) = w; } }
            off += (unsigned)((m == 3 ? 80 : 16) * DM) * 2u; goff += (unsigned)((m == 3 ? 80 : 16) * INCP) * 2u; OPAQ(off); OPAQ(goff); }
    }
};
struct EpiGateF {
    static constexpr bool PERM = true, WIDE = true; static constexpr int NPRE = 0;
    unsigned char* O; const unsigned char* G;
    __device__ __forceinline__ static float ub(unsigned w, int i) { return (float)((w >> (8 * i)) & 0xffu); }
    __device__ __forceinline__ void mid(f32x4 (&acc)[2][2][4][2], const Unit& u, int wr, int wc, int fr, int fq) const {
        const char* gbase = (const char*)G + (size_t)u.pm * BM * PROW + u.pn * BM;
        unsigned gl = (unsigned)((wr * 64 + fr) * PROW + wc * 64 + 16 * fq); OPAQ(gl);
        u32x4 ra[8], rb[8];
#pragma unroll
        for (int g = 0; g < 8; ++g) { ra[g] = *(const u32x4*)(gbase + GA8 + gl); rb[g] = *(const u32x4*)(gbase + GB8 + gl);
            gl += (unsigned)(((g & 3) == 3 ? 80 : 16) * PROW); OPAQ(gl); }
#pragma unroll
        for (int g = 0; g < 8; ++g) { const int ai = g >> 2, m = g & 3;
            const u32x4 a = ra[g], b = rb[g];
#pragma unroll
            for (int bj = 0; bj < 2; ++bj)
#pragma unroll
                for (int n = 0; n < 2; ++n) { const unsigned wa = a[2 * bj + n], wb = b[2 * bj + n];
#pragma unroll
                    for (int k = 0; k < 4; ++k) acc[ai][bj][m][n][k] *= ub(wa, k) * __builtin_amdgcn_rcpf(fmaxf(ub(wb, k), 1.0f)); } }
    }
    __device__ __forceinline__ void operator()(const f32x4 (&acc)[2][2][4][2], const Unit& u, int wr, int wc, int fr, int fq) const {
        char* obase = (char*)O + (size_t)u.pm * BM * DM + u.pn * BM; const char* gbase = (const char*)G + (size_t)u.pm * BM * PROW + GB8 + u.pn * BM;
        unsigned off = (unsigned)((wr * 64 + fr) * DM + wc * 64 + 16 * fq), gl = (unsigned)((wr * 64 + fr) * PROW + wc * 64 + 16 * fq); OPAQ(off); OPAQ(gl);
        constexpr float sa = (float)(1 << FP8_AEXP) / 255.0f;
        u32x4 rb[8];
#pragma unroll
        for (int g = 0; g < 8; ++g) { rb[g] = *(const u32x4*)(gbase + gl); gl += (unsigned)(((g & 3) == 3 ? 80 : 16) * PROW); OPAQ(gl); }
#pragma unroll
        for (int g = 0; g < 8; ++g) { const int ai = g >> 2, m = g & 3;
            const u32x4 b = rb[g]; u32x4 w4;
#pragma unroll
            for (int bj = 0; bj < 2; ++bj)
#pragma unroll
                for (int n = 0; n < 2; ++n) { const unsigned wb = b[2 * bj + n]; const f32x4 v = acc[ai][bj][m][n];
                    w4[2 * bj + n] = pk4_fp8_sat(v[0] * sa * fmaxf(ub(wb, 0), 1.0f), v[1] * sa * fmaxf(ub(wb, 1), 1.0f), v[2] * sa * fmaxf(ub(wb, 2), 1.0f), v[3] * sa * fmaxf(ub(wb, 3), 1.0f)); }
            *(u32x4*)(obase + off) = w4;
            off += (unsigned)((m == 3 ? 80 : 16) * DM); OPAQ(off); }
    }
};
struct EpiRes {
    static constexpr bool PERM = true, WIDE = false; static constexpr int NPRE = 0;
    bf16* xs; const float* gtv;
    int rowbase, gch;
    __device__ __forceinline__ void operator()(const f32x4 (&acc)[2][2][4][2], const Unit& u, int wr, int wc, int fr, int fq) const {
        const int lrow = rowbase + u.pm * BM;
        const int which = (lrow < TC) ? 4 : ((lrow - TC) >> 12);
        const char* gt = (const char*)(gtv + ((size_t)which * 6 + gch) * DM + u.pn * BM);
        char* ob = (char*)(xs + (size_t)lrow * DM + u.pn * BM);
        unsigned off = (unsigned)((wr * 64 + fr) * DM + wc * 32 + 8 * fq) * 2u; const unsigned goff = (unsigned)(wc * 32 + 8 * fq) * 4u; OPAQ(off);
        f32x4 gv[2][2];
#pragma unroll
        for (int bj = 0; bj < 2; ++bj)
#pragma unroll
            for (int n = 0; n < 2; ++n) gv[bj][n] = *(const f32x4*)(gt + goff + (bj * HALF + n * 4) * 4);
        u32x4 rr[8][2]; unsigned ol = off;
#pragma unroll
        for (int g = 0; g < 8; ++g) {
#pragma unroll
            for (int bj = 0; bj < 2; ++bj) rr[g][bj] = *(const u32x4*)(ob + ol + bj * HALF * 2);
            ol += (unsigned)(((g & 3) == 3 ? 80 : 16) * DM) * 2u; OPAQ(ol); }
#pragma unroll
        for (int g = 0; g < 8; ++g) { const int ai = g >> 2, m = g & 3;
#pragma unroll
            for (int bj = 0; bj < 2; ++bj) { const u32x4 w_ = rr[g][bj];
                const f32x4 c0 = (f32x4){bflo(w_.x), bfhi(w_.x), bflo(w_.y), bfhi(w_.y)}, c1 = (f32x4){bflo(w_.z), bfhi(w_.z), bflo(w_.w), bfhi(w_.w)};
                const f32x4 o0 = c0 + gv[bj][0] * acc[ai][bj][m][0], o1 = c1 + gv[bj][1] * acc[ai][bj][m][1];
                u32x4 w; w.x = cvt_pk_bf16(o0[0], o0[1]); w.y = cvt_pk_bf16(o0[2], o0[3]); w.z = cvt_pk_bf16(o1[0], o1[1]); w.w = cvt_pk_bf16(o1[2], o1[3]); *(u32x4*)(ob + off + bj * HALF * 2) = w; }
            off += (unsigned)((m == 3 ? 80 : 16) * DM) * 2u; OPAQ(off); }
    }
};
struct EpiGlu {
    static constexpr bool PERM = true, WIDE = false; static constexpr int NPRE = 0;
    bf16* HH;
    __device__ __forceinline__ void operator()(const f32x4 (&acc)[2][2][4][2], const Unit& u, int wr, int wc, int fr, int fq) const {
        char* base = (char*)HH + (size_t)u.pm * BM * FF + u.pn * HALF;
        unsigned off = (unsigned)((wr * 64 + fr) * FF + wc * 32 + 8 * fq); OPAQ(off);
#pragma unroll
        for (int ai = 0; ai < 2; ++ai)
#pragma unroll
          for (int m = 0; m < 4; ++m) {
            constexpr float sa = (float)(1 << FP8_AEXP);
            const f32x4 g0 = acc[ai][0][m][0], g1 = acc[ai][0][m][1];
            const f32x4 r0 = (g0 * sigmoid4(g0)) * (acc[ai][1][m][0] * sa), r1 = (g1 * sigmoid4(g1)) * (acc[ai][1][m][1] * sa);
            u32x2 w; w.x = pk4_fp8_sat(r0.x, r0.y, r0.z, r0.w); w.y = pk4_fp8_sat(r1.x, r1.y, r1.z, r1.w);
            *(u32x2*)(base + off) = w;
            off += (unsigned)((m == 3 ? 80 : 16) * FF); OPAQ(off); }
    }
};
struct EpiDown {
    static constexpr bool PERM = true, WIDE = true; static constexpr int NPRE = 1;
    unsigned char* YE; const float* roww;
    __device__ __forceinline__ void pre(const Unit& u, int wr, int wid, int lane, LAS unsigned char* lds) const {
        if (u.e == 16) return;
        const float* rw = roww + (size_t)(u.e & 15) * T + u.lt * BM + wr * 64 + lane;
        LAS unsigned* dst = (LAS unsigned*)(lds + LDSX_OFF + 12288) + wid * 128;
        __builtin_amdgcn_global_load_lds((const unsigned*)rw, dst, 4, 0, 0);
        __builtin_amdgcn_global_load_lds((const unsigned*)(rw + HALF), dst + 64, 4, 0, 0);
    }
    __device__ __forceinline__ void operator()(const f32x4 (&acc)[2][2][4][2], const Unit& u, int wr, int wc, int fr, int fq, int wid, LAS unsigned char* lds) const {
        char* base = (char*)YE + (size_t)u.pm * BM * DM + u.pn * BM;
        unsigned off = (unsigned)((wr * 64 + fr) * DM + wc * 64 + 16 * fq); OPAQ(off);
        const LAS float* wl = (const LAS float*)(lds + LDSX_OFF + 12288) + wid * 128 + fr;
        float wts[8];
        asm volatile("" ::: "memory");
#pragma unroll
        for (int g = 0; g < 8; ++g) wts[g] = (u.e == 16) ? 1.0f : *(const volatile LAS float*)(wl + (g >> 2) * 64 + (g & 3) * 16);
#pragma unroll
        for (int ai = 0; ai < 2; ++ai)
#pragma unroll
          for (int m = 0; m < 4; ++m) {
            const float wt = wts[ai * 4 + m] * (float)(1 << FP8_AEXP);
            { const f32x4 v0 = acc[ai][0][m][0] * wt, v1 = acc[ai][0][m][1] * wt, v2 = acc[ai][1][m][0] * wt, v3 = acc[ai][1][m][1] * wt;
                u32x4 w; w.x = pk4_fp8_sat(v0[0], v0[1], v0[2], v0[3]); w.y = pk4_fp8_sat(v1[0], v1[1], v1[2], v1[3]); w.z = pk4_fp8_sat(v2[0], v2[1], v2[2], v2[3]); w.w = pk4_fp8_sat(v3[0], v3[1], v3[2], v3[3]);
                *(u32x4*)(base + off) = w; }
            off += (unsigned)((m == 3 ? 80 : 16) * DM); OPAQ(off); }
    }
};

typedef int i32x4v __attribute__((ext_vector_type(4)));
typedef int i32x8v __attribute__((ext_vector_type(8)));
template <class Epi, class Sched, bool GATHER, int MODE = 0, bool MIDK = false>
__device__ __forceinline__ void gemm_phase(LAS unsigned char* lds, const bf16* A, int lda, const bf16* Bt, int K, const Sched& S, const Epi& E, const LAS int* gtab, int sclW = 0x7f7f7f7f, int sclA = 0x7f7f7f7f, float deq = 1.0f) {
    constexpr bool FP8 = (MODE == 1), I8 = (MODE == 2);
    int tid_ = threadIdx.x; asm volatile("" : "+v"(tid_));
    const int tid = tid_, wid = __builtin_amdgcn_readfirstlane(tid >> 6), lane = tid & 63, wr = wid >> 2, wc = wid & 3, fr = lane & 15, fq = lane >> 4;
    const int nt = K / BK;
    int RA[2], CA[2];
    unsigned voffA[2][2], voffB[2];
#pragma unroll
    for (int i = 0; i < 2; ++i) { int R, C; stage_rc(tid * 16 + i * 8192, R, C); const int Rb = Epi::WIDE ? (64 * (R >> 5) + 16 * ((R & 15) >> 2) + 4 * ((R >> 4) & 1) + (R & 3)) : (Epi::PERM ? ((R & ~31) + perm32(R & 31)) : R);
        RA[i] = R; CA[i] = C; voffB[i] = (unsigned)(Rb * K + C) * 2u;
        voffA[0][i] = (unsigned)(R * lda + C) * 2u; voffA[1][i] = 0u; }
    const size_t kstep = (size_t)(BK * 2);
    const size_t hstepB = Epi::WIDE ? (size_t)8 * K * 2 : (size_t)HALF * K * 2;
    const size_t hstepA = GATHER ? (size_t)0 : (size_t)HALF * lda * 2;
    const unsigned ldsw = (unsigned)wid * 1024u;
    const int aoff = lds_byte(wr * 64 + fr, fq * 8), boff = lds_byte(wc * 32 + fr, fq * 8);
#define PG8_SA(b, h) (((b) * 2 + (h)) * HTB)
#define PG8_SB(b, h) ((4 + (b) * 2 + (h)) * HTB)
#define PG8_STA(b, h, gbase) do { _Pragma("unroll") for (int _i = 0; _i < 2; ++_i) \
        __builtin_amdgcn_global_load_lds((const unsigned*)((const char*)(gbase) + (h) * hstepA + voffA[GATHER ? (h) : 0][_i]), (LAS unsigned*)(lds + PG8_SA(b, h) + ldsw + _i * 8192), 16, 0, 0); } while (0)
#define PG8_STB(b, h, gbase) do { _Pragma("unroll") for (int _i = 0; _i < 2; ++_i) \
        __builtin_amdgcn_global_load_lds((const unsigned*)((const char*)(gbase) + (h) * hstepB + voffB[_i]), (LAS unsigned*)(lds + PG8_SB(b, h) + ldsw + _i * 8192), 16, 0, 0); } while (0)
#define PG8_LDA(dst, b, h) do { _Pragma("unroll") for (int m = 0; m < 4; ++m) _Pragma("unroll") for (int k = 0; k < 2; ++k) dst[m][k] = *(const LAS bf16x8*)(lds + PG8_SA(b, h) + aoff + m * 2048 + k * 1024); } while (0)
#define PG8_LDB(dst, b, h) do { _Pragma("unroll") for (int n = 0; n < 2; ++n) _Pragma("unroll") for (int k = 0; k < 2; ++k) dst[n][k] = *(const LAS bf16x8*)(lds + PG8_SB(b, h) + boff + n * 2048 + k * 1024); } while (0)
#define PG8_CAT(x) __builtin_shufflevector(__builtin_bit_cast(i32x4v, x[0]), __builtin_bit_cast(i32x4v, x[1]), 0, 1, 2, 3, 4, 5, 6, 7)
#define PG8_MMA(ai, bj, At, Bt_) do { __builtin_amdgcn_s_setprio(1); _Pragma("unroll") for (int m = 0; m < 4; ++m) _Pragma("unroll") for (int n = 0; n < 2; ++n) { \
        if constexpr (FP8) { const i32x8v a8_ = PG8_CAT(Bt_[n]), b8_ = PG8_CAT(At[m]);   \
            asm volatile("v_mfma_scale_f32_16x16x128_f8f6f4 %0, %1, %2, %0, %3, %4 op_sel_hi:[0,0,0]" : "+v"(acc[ai][bj][m][n]) : "v"(a8_), "v"(b8_), "v"(sclW), "v"(sclA)); } \
        else if constexpr (I8) { _Pragma("unroll") for (int k = 0; k < 2; ++k) acc[ai][bj][m][n] = __builtin_bit_cast(f32x4, __builtin_amdgcn_mfma_i32_16x16x64_i8(__builtin_bit_cast(i32x4v, Bt_[n][k]), __builtin_bit_cast(i32x4v, At[m][k]), __builtin_bit_cast(i32x4v, acc[ai][bj][m][n]), 0, 0, 0)); } \
        else { _Pragma("unroll") for (int k = 0; k < 2; ++k) acc[ai][bj][m][n] = __builtin_amdgcn_mfma_f32_16x16x32_bf16(Bt_[n][k], At[m][k], acc[ai][bj][m][n], 0, 0, 0); } } \
        __builtin_amdgcn_s_setprio(0); } while (0)
#define PG8_WAIT_V(n) asm volatile("s_waitcnt vmcnt(" #n ")" ::: "memory")
#define PG8_WAIT_L(n) asm volatile("s_waitcnt lgkmcnt(" #n ")" ::: "memory")
#define PG8_BAR __builtin_amdgcn_s_barrier()
#define PG8_SCHED __builtin_amdgcn_sched_barrier(0)
#define PG8_GLOAD(ui_) do { _Pragma("unroll") for (int _h = 0; _h < 2; ++_h) _Pragma("unroll") for (int _i = 0; _i < 2; ++_i) \
        voffA[_h][_i] = (unsigned)(gtab[(ui_) * 256 + _h * HALF + RA[_i]] * lda + CA[_i]) * 2u; } while (0)
    Unit cur, nxt; int ui = 0;
    if (!S.next(0, cur)) return;
    f32x4 acc[2][2][4][2];
#pragma unroll
    for (int a = 0; a < 2; ++a)
#pragma unroll
        for (int b = 0; b < 2; ++b)
#pragma unroll
            for (int m = 0; m < 4; ++m)
#pragma unroll
                for (int n = 0; n < 2; ++n) acc[a][b][m][n] = (f32x4){0.f, 0.f, 0.f, 0.f};
    bf16x8 At[4][2], B0[2][2], B1[2][2];
    if constexpr (GATHER) { PG8_GLOAD(0); }
    const char* cA = (const char*)A + S.a_off(cur); const char* cB = (const char*)Bt + S.b_off(cur);
    PG8_STB(0, 0, cB); PG8_STB(0, 1, cB); PG8_STA(0, 0, cA); PG8_STA(0, 1, cA);
    if (wr == 1) PG8_BAR;
    PG8_WAIT_V(2); PG8_BAR;
    PG8_STB(1, 0, cB + kstep); PG8_STA(1, 0, cA + kstep); PG8_STB(1, 1, cB + kstep);
    PG8_WAIT_V(6); PG8_BAR;
    for (;;) {
        const bool has_next = S.next(ui + 1, nxt);
        const char* nA = has_next ? (const char*)A + S.a_off(nxt) : cA; const char* nB = has_next ? (const char*)Bt + S.b_off(nxt) : cB;
#pragma unroll 1
        for (int t = 0; t < nt; t += 2) {
            const bool last = (t == nt - 2);
            if constexpr (MIDK) { if (t == nt / 2) { if constexpr (FP8) asm volatile("s_nop 15\n\ts_nop 15\n\ts_nop 15\n\ts_nop 15" ::: "memory"); E.mid(acc, cur, wr, wc, fr, fq); } }
            if constexpr (Epi::NPRE > 0) { if (last) E.pre(cur, wr, wid, lane, lds); }
            const char* a1 = cA + (size_t)(t + 1) * kstep;
            const char* a2 = last ? nA : cA + (size_t)(t + 2) * kstep; const char* b2 = last ? nB : cB + (size_t)(t + 2) * kstep;
            const char* a3 = a2 + kstep; const char* b3 = b2 + kstep;
            PG8_LDB(B0, 0, 0); PG8_LDB(B1, 0, 1); PG8_SCHED; PG8_LDA(At, 0, 0); PG8_STA(1, 1, a1);
            if constexpr (GATHER) { if (last && has_next) { PG8_GLOAD(ui + 1); } }
            PG8_WAIT_V(8); PG8_WAIT_L(0); PG8_BAR; PG8_MMA(0, 0, At, B0); PG8_MMA(0, 1, At, B1); PG8_BAR; PG8_SCHED;
            PG8_LDA(At, 0, 1); PG8_STB(0, 0, b2); PG8_STB(0, 1, b2); PG8_STA(0, 0, a2);
            PG8_WAIT_V(8); PG8_WAIT_L(0); PG8_BAR; PG8_MMA(1, 0, At, B0); PG8_MMA(1, 1, At, B1); PG8_BAR; PG8_SCHED;
            PG8_LDB(B0, 1, 0); PG8_LDB(B1, 1, 1); PG8_SCHED; PG8_LDA(At, 1, 0); PG8_STA(0, 1, a2);
            PG8_WAIT_V(8); PG8_WAIT_L(0); PG8_BAR; PG8_MMA(0, 0, At, B0); PG8_MMA(0, 1, At, B1); PG8_BAR; PG8_SCHED;
            PG8_LDA(At, 1, 1); PG8_STB(1, 0, b3); PG8_STB(1, 1, b3); PG8_STA(1, 0, a3);
            PG8_WAIT_V(8); PG8_WAIT_L(0); PG8_BAR; PG8_MMA(1, 0, At, B0); PG8_MMA(1, 1, At, B1); PG8_BAR; PG8_SCHED;
        }
        if (wr == 0) PG8_BAR;
        if constexpr (FP8) asm volatile("s_nop 15\n\ts_nop 15\n\ts_nop 15\n\ts_nop 15" ::: "memory");
        if constexpr (I8) {
#pragma unroll
            for (int a = 0; a < 2; ++a)
#pragma unroll
                for (int b = 0; b < 2; ++b)
#pragma unroll
                    for (int m = 0; m < 4; ++m)
#pragma unroll
                        for (int n = 0; n < 2; ++n) { const i32x4v q = __builtin_bit_cast(i32x4v, acc[a][b][m][n]); acc[a][b][m][n] = (f32x4){(float)q[0] * deq, (float)q[1] * deq, (float)q[2] * deq, (float)q[3] * deq}; } }
        if constexpr (Epi::NPRE > 0) E(acc, cur, wr, wc, fr, fq, wid, lds); else E(acc, cur, wr, wc, fr, fq);
        if (!has_next) break;
#pragma unroll
        for (int a = 0; a < 2; ++a)
#pragma unroll
            for (int b = 0; b < 2; ++b)
#pragma unroll
                for (int m = 0; m < 4; ++m)
#pragma unroll
                    for (int n = 0; n < 2; ++n) acc[a][b][m][n] = (f32x4){0.f, 0.f, 0.f, 0.f};
        cur = nxt; cA = nA; cB = nB; ++ui;
        if (wr == 1) PG8_BAR;
    }
    PG8_WAIT_V(0);
    PG8_BAR;
#undef PG8_SA
#undef PG8_SB
#undef PG8_STA
#undef PG8_STB
#undef PG8_LDA
#undef PG8_LDB
#undef PG8_MMA
#undef PG8_CAT
#undef PG8_WAIT_V
#undef PG8_WAIT_L
#undef PG8_BAR
#undef PG8_SCHED
#undef PG8_GLOAD
}
}

namespace att {
constexpr int KSLOT = 8192, VSLOT = 8192, NSLOT = 3;
constexpr int L_K = 0, L_V = NSLOT * KSLOT, L_OST = L_V + NSLOT * VSLOT, L_BYTES = L_OST + NWAVES * 2048;
constexpr int QEXP = 3;
static_assert(L_BYTES <= RING_BYTES, "attention LDS");
#define SBAR() __builtin_amdgcn_sched_barrier(0)
typedef int i32x4a __attribute__((ext_vector_type(4)));
typedef int i32x8a __attribute__((ext_vector_type(8)));
__device__ __forceinline__ int crow(int r, int hi) { return (r & 3) + 8 * (r >> 2) + 4 * hi; }
__device__ __forceinline__ void glds16(const void* gsrc, unsigned lds_dst) { unsigned keep;
    asm volatile("s_mov_b32 %0, m0\n\ts_mov_b32 m0, %2\n\ts_nop 0\n\tglobal_load_lds_dwordx4 %1, off\n\ts_mov_b32 m0, %0" : "=&s"(keep) : "v"(gsrc), "s"(lds_dst) : "memory"); }
typedef float f32x2_t __attribute__((ext_vector_type(2))); typedef __bf16 bf16x2_t __attribute__((ext_vector_type(2)));
__device__ __forceinline__ unsigned cvtpk_s(float lo, float hi) { f32x2_t v = {lo, hi}; bf16x2_t b = __builtin_convertvector(v, bf16x2_t); return __builtin_bit_cast(unsigned, b); }
typedef __attribute__((address_space(3))) const char* lds_cptr;
typedef short v4i16_t __attribute__((ext_vector_type(4)));
__device__ __forceinline__ s16x4 vtr(lds_cptr p) { return __builtin_bit_cast(s16x4, __builtin_amdgcn_ds_read_tr16_b64_v4i16((LAS v4i16_t*)p)); }
__device__ __forceinline__ i32x8a kfrag(lds_cptr kp, int idx) {
    const i32x4a a = *(const LAS i32x4a*)(kp + (idx >> 1) * 4096 + (idx & 1) * 512), b = *(const LAS i32x4a*)(kp + (idx >> 1) * 4096 + (idx & 1) * 512 + 1024);
    return __builtin_shufflevector(a, b, 0, 1, 2, 3, 4, 5, 6, 7);
}
template <int DQK>
__device__ __forceinline__ void attn_unit(const unsigned char* Qw, int qpitch, const unsigned char* Kh, int kpitch, const bf16* Vh, int vpitch, unsigned char* Ow, int NT, float negc, LAS unsigned char* shm) {
    constexpr int NG = (DQK == 96) ? 2 : 1;
    int tid_ = threadIdx.x; asm volatile("" : "+v"(tid_));
    const int tid = tid_, lane = tid & 63, r32 = lane & 31, hi = lane >> 5; const int wid = __builtin_amdgcn_readfirstlane(tid >> 6);
    const unsigned lds0 = (unsigned)(uintptr_t)shm;
    i32x8a qr8[NG];
#pragma unroll
    for (int g = 0; g < NG; ++g) { const unsigned char* qp = Qw + (size_t)r32 * qpitch + g * 64 + hi * 32;
        const i32x4a a = *(const i32x4a*)qp, b = *(const i32x4a*)(qp + 16); qr8[g] = __builtin_shufflevector(a, b, 0, 1, 2, 3, 4, 5, 6, 7); }
    const bool kw = (NG == 2) || (wid < 4);
    const unsigned char* ksrc = Kh + (size_t)lane * kpitch + wid * 16;
    const bf16* vsrc = Vh + (size_t)(16 * (wid & 3) + (lane >> 2)) * vpitch + (wid >> 2) * 32 + (lane & 3) * 8;
    const unsigned kdst = lds0 + L_K + wid * 1024, vdst = lds0 + L_V + wid * 1024;
#define DMA_K(t, ks) do { if (kw) glds16(ksrc + (size_t)(t) * 64 * kpitch, (unsigned)__builtin_amdgcn_readfirstlane(kdst + (ks))); } while (0)
#define DMA_V(t, vs) glds16(vsrc + (size_t)(t) * 64 * vpitch, (unsigned)__builtin_amdgcn_readfirstlane(vdst + (vs)))
#define WAIT_BAR(NV, NK) do { if (kw) asm volatile("s_waitcnt vmcnt(%0) lgkmcnt(0)\n\ts_barrier" :: "n"((NV) + (NK)) : "memory"); \
                              else    asm volatile("s_waitcnt vmcnt(%0) lgkmcnt(0)\n\ts_barrier" :: "n"(NV) : "memory"); } while (0)
    DMA_K(0, 0); DMA_V(0, 0); DMA_K(1, KSLOT); DMA_K(2, 2 * KSLOT);
    f32x16 o[2]; o[0] = f32x16{}; o[1] = f32x16{}; f32x4 o2 = (f32x4){0.f, 0.f, 0.f, 0.f};
    f32x16 negm;
#pragma unroll
    for (int r = 0; r < 16; ++r) negm[r] = negc;
    if constexpr (NG == 1) asm volatile("" : "+v"(negm));
    int sclK = 0x7f7f7f7f, sclQ = 0x01010101 * (127 - QEXP); asm volatile("" : "+v"(sclK), "+v"(sclQ));
    const short ind1 = ((((lane & 15) == 0) && (((lane >> 4) & 1) == 0)) || (((lane & 15) == 1) && (((lane >> 4) & 1) == 1))) ? (short)0x3F80 : (short)0;
    const bf16x8 ones = (bf16x8){ind1, ind1, ind1, ind1, ind1, ind1, ind1, ind1};
#define MFSUM(a, c) __builtin_amdgcn_mfma_f32_16x16x32_bf16(a, ones, c, 0, 0, 0)
    const lds_cptr shm3 = (lds_cptr)shm; const lds_cptr kp0 = shm3 + L_K + (2 * hi) * 1024 + r32 * 16;
    const lds_cptr vp0 = shm3 + L_V + ((lane >> 4) & 1) * 32 + (lane & 3) * 8 + (4 * hi + ((lane & 15) >> 2)) * 64;
    f32x16 pA0, pA1, pB0, pB1; i32x8a kf[2 * NG];
    int kprev = 0, kcur = 0, knext = KSLOT, vprev = 0, vcur = 0, vnext = VSLOT;
#define ROT() do { kprev = kcur; kcur = knext; knext = (knext == 2 * KSLOT) ? 0 : knext + KSLOT; vprev = vcur; vcur = vnext; vnext = (vnext == 2 * VSLOT) ? 0 : vnext + VSLOT; } while (0)
#define MF32(a, b, c) __builtin_amdgcn_mfma_f32_32x32x16_bf16(a, b, c, 0, 0, 0)
#define QK_FIRST(D, A, B) do { if constexpr (NG == 1) D = __builtin_amdgcn_mfma_scale_f32_32x32x64_f8f6f4(A, B, negm, 0, 0, 0, sclK, 0, sclQ); \
                               else D = __builtin_amdgcn_mfma_scale_f32_32x32x64_f8f6f4(A, B, f32x16{}, 0, 0, 0, sclK, 0, sclQ); } while (0)
#define QK_ACC(D, A, B) D = __builtin_amdgcn_mfma_scale_f32_32x32x64_f8f6f4(A, B, D, 0, 0, 0, sclK, 0, sclQ)
#define QK_SETTLE(X, Y) do { PIN(X); PIN(Y); } while (0)
#define KEEP(x) asm volatile("" :: "v"(x))
    WAIT_BAR(1, 2);
#pragma unroll
    for (int i = 0; i < 2 * NG; ++i) kf[i] = kfrag(kp0, i);
    QK_FIRST(pA0, kf[0], qr8[0]); QK_FIRST(pA1, kf[1], qr8[0]);
    if constexpr (NG == 2) { QK_ACC(pA0, kf[2], qr8[1]); QK_ACC(pA1, kf[3], qr8[1]); }
#pragma unroll
    for (int r = 0; r < 16; ++r) { pA0[r] = __builtin_amdgcn_exp2f(pA0[r]); pA1[r] = __builtin_amdgcn_exp2f(pA1[r]); }
    WAIT_BAR(0, 0);
    DMA_K(3, 0); DMA_V(1, VSLOT);
    ROT();
#pragma unroll
    for (int i = 0; i < 2 * NG; ++i) kf[i] = kfrag(kp0 + kcur, i);
    WAIT_BAR(1, 1);
    s16x4 vlo[8], vhi[8]; u32x4 pw0, pw1, pw2, pw3;
#define PKW(P, B) cvtpk_s(P[B], P[B + 1])
#define PAF(k) __builtin_bit_cast(bf16x8, pw##k)
#define VFR(i) (bf16x8){vlo[i][0], vlo[i][1], vlo[i][2], vlo[i][3], vhi[i][0], vhi[i][1], vhi[i][2], vhi[i][3]}
#define PIN(x) asm volatile("" : "+v"(x))
#define EX(v) __builtin_amdgcn_exp2f(v)
#define VRD(i) do { vlo[i] = vtr(vp_ + (((i) >> 2) * 4096 + ((i) & 3) * 1024)); vhi[i] = vtr(vp_ + (((i) >> 2) * 4096 + ((i) & 3) * 1024 + 512)); } while (0)
#define PACK4(PW, P, B) do { PW[0] = PKW(P, B); PW[1] = PKW(P, (B) + 2); PW[2] = PKW(P, (B) + 4); PW[3] = PKW(P, (B) + 6); PIN(PW); } while (0)
#define KRD(G, i) do { if (G) { kf[i] = kfrag(kp0 + knext, i); SBAR(); } } while (0)
#define EXI(C0, C1, i) do { if ((i) < 16) C0[(i) & 15] = EX(C0[(i) & 15]); else C1[(i) & 15] = EX(C1[(i) & 15]); } while (0)
#define GAPB3(MF, C0, C1, I0) do { MF; EXI(C0, C1, I0); EXI(C0, C1, (I0) + 1); EXI(C0, C1, (I0) + 2); PIN(C0); PIN(C1); SBAR(); } while (0)
#define GAPB2(MF, C0, C1, I0) do { MF; EXI(C0, C1, I0); EXI(C0, C1, (I0) + 1); PIN(C0); PIN(C1); SBAR(); } while (0)
#define STEP(C0, C1, P0, P1, t, GK, GV, GL) do { SBAR(); \
    const lds_cptr vp_ = vp0 + vprev; \
      \
    VRD(0); VRD(4); SBAR(); \
    QK_FIRST(C0, kf[0], qr8[0]); PACK4(pw0, P0, 0); VRD(1); VRD(5); SBAR(); \
    QK_FIRST(C1, kf[1], qr8[0]); KEEP(kf[0]); PACK4(pw1, P0, 8); VRD(2); VRD(6); SBAR(); \
    if constexpr (NG == 2) { QK_ACC(C0, kf[2], qr8[1]); KEEP(kf[1]); PACK4(pw2, P1, 0); VRD(3); VRD(7); SBAR(); \
                             QK_ACC(C1, kf[3], qr8[1]); KEEP(kf[2]); PACK4(pw3, P1, 8); SBAR(); } \
    else { PACK4(pw2, P1, 0); VRD(3); VRD(7); PACK4(pw3, P1, 8); SBAR(); } \
    if (GK) { DMA_K((t) + 3, kcur); } if (GV) { DMA_V((t) + 1, vnext); } \
    QK_SETTLE(C0, C1); KEEP(kf[2 * NG - 1]); SBAR(); \
      \
    GAPB3(o[0] = MF32(PAF(0), VFR(0), o[0]), C0, C1, 0); \
    KRD(GL, 0); GAPB3(o[1] = MF32(PAF(0), VFR(4), o[1]), C0, C1, 3); \
    KRD(GL, 1); GAPB3(o2 = MFSUM(PAF(0), o2), C0, C1, 6); \
    KRD(GL && NG == 2, 2); GAPB3(o[0] = MF32(PAF(1), VFR(1), o[0]), C0, C1, 9); \
    KRD(GL && NG == 2, 3); GAPB3(o[1] = MF32(PAF(1), VFR(5), o[1]), C0, C1, 12); \
    GAPB3(o2 = MFSUM(PAF(1), o2), C0, C1, 15); \
    GAPB3(o[0] = MF32(PAF(2), VFR(2), o[0]), C0, C1, 18); \
    GAPB3(o[1] = MF32(PAF(2), VFR(6), o[1]), C0, C1, 21); \
    GAPB2(o2 = MFSUM(PAF(2), o2), C0, C1, 24); \
    GAPB2(o[0] = MF32(PAF(3), VFR(3), o[0]), C0, C1, 26); \
    GAPB2(o[1] = MF32(PAF(3), VFR(7), o[1]), C0, C1, 28); \
    GAPB2(o2 = MFSUM(PAF(3), o2), C0, C1, 30); \
    } while (0)
#define ENDW(tt) do { if ((tt) + 3 < NT) { WAIT_BAR(1, 1); } else if ((tt) + 2 < NT) { WAIT_BAR(1, 0); } else { WAIT_BAR(0, 0); } } while (0)
    int t = 1;
    for (; t + 5 < NT; t += 2) {
        STEP(pB0, pB1, pA0, pA1, t, true, true, true);     WAIT_BAR(1, 1); ROT();
        STEP(pA0, pA1, pB0, pB1, t + 1, true, true, true); WAIT_BAR(1, 1); ROT();
    }
    for (; t + 1 < NT; t += 2) {
        STEP(pB0, pB1, pA0, pA1, t, (t + 3 < NT), (t + 1 < NT), (t + 1 < NT));         ENDW(t);     ROT();
        STEP(pA0, pA1, pB0, pB1, t + 1, (t + 4 < NT), (t + 2 < NT), (t + 2 < NT));     ENDW(t + 1); ROT();
    }
    STEP(pB0, pB1, pA0, pA1, NT - 1, false, false, false);
    { PACK4(pw0, pB0, 0); PACK4(pw1, pB0, 8); PACK4(pw2, pB1, 0); PACK4(pw3, pB1, 8);
      const lds_cptr vp_ = vp0 + vcur;
      VRD(0); VRD(1); VRD(2); VRD(3); VRD(4); VRD(5); VRD(6); VRD(7);
      o[0] = MF32(PAF(0), VFR(0), o[0]); o[1] = MF32(PAF(0), VFR(4), o[1]); o2 = MFSUM(PAF(0), o2);
      o[0] = MF32(PAF(1), VFR(1), o[0]); o[1] = MF32(PAF(1), VFR(5), o[1]); o2 = MFSUM(PAF(1), o2);
      o[0] = MF32(PAF(2), VFR(2), o[0]); o[1] = MF32(PAF(2), VFR(6), o[1]); o2 = MFSUM(PAF(2), o2);
      o[0] = MF32(PAF(3), VFR(3), o[0]); o[1] = MF32(PAF(3), VFR(7), o[1]); o2 = MFSUM(PAF(3), o2); }
#undef DMA_K
#undef DMA_V
#undef WAIT_BAR
#undef ROT
#undef MF32
#undef MFSUM
#undef QK_FIRST
#undef QK_ACC
#undef QK_SETTLE
#undef KEEP
#undef PKW
#undef PAF
#undef VFR
#undef PIN
#undef EX
#undef VRD
#undef PACK4
#undef KRD
#undef EXI
#undef GAPB3
#undef GAPB2
#undef STEP
#undef ENDW
    { LAS unsigned char* stg = (LAS unsigned char*)(shm + L_OST) + wid * 2048;
      LAS float* lq = (LAS float*)stg;
      if ((lane & 15) < 2) { const int q0 = 16 * (lane & 15) + 4 * (lane >> 4);
#pragma unroll
          for (int k = 0; k < 4; ++k) lq[q0 + k] = o2[k]; }
      asm volatile("s_waitcnt lgkmcnt(0)" ::: "memory");
      float rl[16];
#pragma unroll
      for (int r = 0; r < 16; ++r) rl[r] = lq[crow(r, hi)];
      asm volatile("s_waitcnt lgkmcnt(0)" ::: "memory");
      constexpr float sa = (float)(1 << FP8_AEXP);
#pragma unroll
      for (int r = 0; r < 16; ++r) { const int orow = crow(r, hi); const float sc = __builtin_amdgcn_rcpf(rl[r]) * sa;
#pragma unroll
        for (int d0 = 0; d0 < 2; ++d0) stg[orow * 64 + d0 * 32 + r32] = (unsigned char)(pk4_fp8(__builtin_amdgcn_fmed3f(o[d0][r] * sc, -448.f, 448.f), 0.f, 0.f, 0.f) & 0xffu); }
      asm volatile("s_waitcnt lgkmcnt(0)" ::: "memory");
#pragma unroll
      for (int i = 0; i < 2; ++i) { const int row = i * 16 + (lane >> 2), ch = lane & 3; const u32x4 v = *(const LAS u32x4*)(stg + row * 64 + ch * 16); *(u32x4*)(Ow + (size_t)row * DM + ch * 16) = v; } }
    asm volatile("s_waitcnt lgkmcnt(0)\n\ts_barrier" ::: "memory");
}
#undef SBAR
}

#define XB_TMO      128
#define XB_XCNT(j)  (256  + 64 * (j))
#define XB_XSUB(j)  (1280 + 64 * (j))
#define XB_XGEN(j)  (2304 + 64 * (j))
#define XB_TOP      3328
#define XB_TOPGEN   3392
#define XCD_BAR_WORDS 3456
#define XB_SPIN_CAP (1u << 18)
__device__ __forceinline__ unsigned xb_ld(unsigned* p)              { return __hip_atomic_load(p, __ATOMIC_RELAXED, __HIP_MEMORY_SCOPE_AGENT); }
__device__ __forceinline__ unsigned xb_add(unsigned* p, unsigned v) { return __hip_atomic_fetch_add(p, v, __ATOMIC_RELAXED, __HIP_MEMORY_SCOPE_AGENT); }
__device__ __forceinline__ unsigned xb_xcc_id() { return (unsigned)__builtin_amdgcn_s_getreg((3 << 11) | 20) & 0xFu; }
#define XB_SPIN(cond, bar) do { unsigned _sp = 0; while (cond) { __builtin_amdgcn_s_sleep(1); \
    if ((++_sp & 255u) == 0u) { if (xb_ld(&(bar)[XB_TMO])) break; if (_sp > XB_SPIN_CAP) { atomicAdd(&(bar)[XB_TMO], 1u); break; } } } } while (0)
struct XcdBarrier { unsigned* bar; unsigned x; volatile LAS unsigned* st; };
__device__ __forceinline__ XcdBarrier xcd_barrier_post(unsigned* bar, volatile LAS unsigned* st) {
    XcdBarrier b; b.bar = bar; b.x = xb_xcc_id(); b.st = st;
    if (threadIdx.x == 0) (void)xb_add(&bar[XB_XCNT(b.x)], 1u);
    return b;
}
__device__ __forceinline__ void xcd_barrier_complete(unsigned* bar, unsigned x, unsigned& nloc, unsigned& nx) {
    const unsigned G = gridDim.x * gridDim.y * gridDim.z;
    unsigned sum, cnt, mine, sp = 0u;
    for (;;) {
        sum = 0u; cnt = 0u; mine = 0u;
#pragma unroll
        for (unsigned j = 0; j < 16; ++j) { const unsigned c = xb_ld(&bar[XB_XCNT(j)]); sum += c; cnt += (c > 0u) ? 1u : 0u; mine = (j == x) ? c : mine; }
        if (sum == G) break;
        __builtin_amdgcn_s_sleep(1);
        if ((++sp & 255u) == 0u) { if (xb_ld(&bar[XB_TMO])) break; if (sp > XB_SPIN_CAP) { atomicAdd(&bar[XB_TMO], 1u); break; } }
    }
    nloc = mine > 0u ? mine : 1u; nx = cnt > 0u ? cnt : 1u;
}
__device__ __forceinline__ void xcd_barrier(const XcdBarrier& b) {
    asm volatile("s_waitcnt vmcnt(0)" ::: "memory");
    __syncthreads();
    if (threadIdx.x == 0) {
        unsigned* bar = b.bar;
        __builtin_amdgcn_s_waitcnt(0);
        unsigned nloc = b.st[0], nx = b.st[1];
        if (nloc == 0u) { xcd_barrier_complete(bar, b.x, nloc, nx); b.st[0] = nloc; b.st[1] = nx; }
        const unsigned old = xb_add(&bar[XB_XSUB(b.x)], 1u);
        const unsigned gen = old / nloc;
        if (old + 1u == (gen + 1u) * nloc) {
            __builtin_amdgcn_fence(__ATOMIC_RELEASE, "agent");
            asm volatile("s_waitcnt vmcnt(0)" ::: "memory");
            const unsigned og = xb_add(&bar[XB_TOP], 1u);
            const unsigned tg = og / nx;
            if (og + 1u == (tg + 1u) * nx) xb_add(&bar[XB_TOPGEN], 1u);
            else XB_SPIN(xb_ld(&bar[XB_TOPGEN]) == tg, bar);
            __builtin_amdgcn_fence(__ATOMIC_ACQUIRE, "agent");
            xb_add(&bar[XB_XGEN(b.x)], 1u);
            asm volatile("s_waitcnt vmcnt(0)" ::: "memory");
        } else {
            XB_SPIN(xb_ld(&bar[XB_XGEN(b.x)]) == gen, bar);
            __builtin_amdgcn_fence(__ATOMIC_ACQUIRE, "agent");
            asm volatile("s_waitcnt vmcnt(0)" ::: "memory");
        }
    }
    __syncthreads();
}

struct Args { const float* in[28]; float* out; unsigned char* ws; int ph_lo, ph_hi, li, pad; };
typedef const __attribute__((address_space(4))) Args* ArgsP;
struct Ctx {
    LAS unsigned char* lds; int tid, lane, wave, vcu, G, gw, NGW;
    ArgsP ap;
};
#define CIN(k) (C.ap->in[k])
#define CWS (C.ap->ws)
#define COUT (C.ap->out)
template <bool MERGE>
__device__ __forceinline__ void ctx_mini_gemm(const Ctx& C, const unsigned char* A8, const unsigned char* W8, int sclW, int sclA,
                                              unsigned char* Y8, const unsigned char* G8, const float* xin, bf16* xs, const float* gt) {
    const int fr = C.lane & 15, fq = C.lane >> 4;
#pragma unroll 1
    for (int t = C.vcu; t < 256; t += C.G) {
        const int m = (t >> 4) * 64 + (C.wave & 3) * 16 + fr, n0 = (t & 15) * 64 + (C.wave >> 2) * 32;
        const unsigned char* ap = A8 + (size_t)m * DM + fq * 32;
        const unsigned char* bp = W8 + (size_t)(n0 + fr) * DM + fq * 32;
        const int nc = n0 + 4 * fq;
        unsigned ga[2], gb[2]; f32x4 xv[2], gv[2];
        if (MERGE) {
#pragma unroll
            for (int nb = 0; nb < 2; ++nb) { ga[nb] = *(const unsigned*)(G8 + (size_t)m * PROW + GA8 + nc + nb * 16); gb[nb] = *(const unsigned*)(G8 + (size_t)m * PROW + GB8 + nc + nb * 16); }
        } else {
#pragma unroll
            for (int nb = 0; nb < 2; ++nb) { const u32x2 w_ = *(const u32x2*)(xs + (size_t)m * DM + nc + nb * 16); xv[nb] = (f32x4){bflo(w_.x), bfhi(w_.x), bflo(w_.y), bfhi(w_.y)}; gv[nb] = *(const f32x4*)(gt + nc + nb * 16); }
        }
        f32x4 acc[2] = {(f32x4){0.f, 0.f, 0.f, 0.f}, (f32x4){0.f, 0.f, 0.f, 0.f}};
#pragma unroll
        for (int h = 0; h < 2; ++h) {
            u32x4 av[4][2], b0[4][2], b1[4][2];
#pragma unroll
            for (int k = 0; k < 4; ++k) { const int kb = (h * 4 + k) * 128;
                av[k][0] = *(const u32x4*)(ap + kb); av[k][1] = *(const u32x4*)(ap + kb + 16);
                b0[k][0] = *(const u32x4*)(bp + kb); b0[k][1] = *(const u32x4*)(bp + kb + 16);
                b1[k][0] = *(const u32x4*)(bp + 16 * DM + kb); b1[k][1] = *(const u32x4*)(bp + 16 * DM + kb + 16); }
#pragma unroll
            for (int k = 0; k < 4; ++k) {
                const pg8::i32x8v a8 = {(int)av[k][0].x, (int)av[k][0].y, (int)av[k][0].z, (int)av[k][0].w, (int)av[k][1].x, (int)av[k][1].y, (int)av[k][1].z, (int)av[k][1].w};
                const pg8::i32x8v w0 = {(int)b0[k][0].x, (int)b0[k][0].y, (int)b0[k][0].z, (int)b0[k][0].w, (int)b0[k][1].x, (int)b0[k][1].y, (int)b0[k][1].z, (int)b0[k][1].w};
                const pg8::i32x8v w1 = {(int)b1[k][0].x, (int)b1[k][0].y, (int)b1[k][0].z, (int)b1[k][0].w, (int)b1[k][1].x, (int)b1[k][1].y, (int)b1[k][1].z, (int)b1[k][1].w};
                acc[0] = __builtin_amdgcn_mfma_scale_f32_16x16x128_f8f6f4(w0, a8, acc[0], 0, 0, 0, sclW, 0, sclA);
                acc[1] = __builtin_amdgcn_mfma_scale_f32_16x16x128_f8f6f4(w1, a8, acc[1], 0, 0, 0, sclW, 0, sclA); }
            if (MERGE && h == 0) {
#pragma unroll
                for (int nb = 0; nb < 2; ++nb)
#pragma unroll
                    for (int k = 0; k < 4; ++k) acc[nb][k] *= pg8::EpiGateF::ub(ga[nb], k) * __builtin_amdgcn_rcpf(fmaxf(pg8::EpiGateF::ub(gb[nb], k), 1.0f));
            }
        }
        if (MERGE) { constexpr float sa = (float)(1 << FP8_AEXP) / 255.0f;
#pragma unroll
            for (int nb = 0; nb < 2; ++nb) { const f32x4 v = acc[nb]; const unsigned wb = gb[nb];
                *(unsigned*)(Y8 + (size_t)m * DM + nc + nb * 16) = pk4_fp8_sat(v[0] * sa * fmaxf(pg8::EpiGateF::ub(wb, 0), 1.0f), v[1] * sa * fmaxf(pg8::EpiGateF::ub(wb, 1), 1.0f), v[2] * sa * fmaxf(pg8::EpiGateF::ub(wb, 2), 1.0f), v[3] * sa * fmaxf(pg8::EpiGateF::ub(wb, 3), 1.0f)); }
        } else {
#pragma unroll
            for (int nb = 0; nb < 2; ++nb) { const f32x4 o = xv[nb] + gv[nb] * acc[nb];
                u32x2 w; w.x = pg8::cvt_pk_bf16(o[0], o[1]); w.y = pg8::cvt_pk_bf16(o[2], o[3]); *(u32x2*)(xs + (size_t)m * DM + nc + nb * 16) = w; }
        }
    }
}
__device__ __forceinline__ void transpose_item(const float* W, int N, bf16* WT, int ldo, int k0, int n0, int orow0, const float* gain, LAS float* scr, int lane) {
    float tv[32];
#pragma unroll
    for (int i = 0; i < 32; ++i) { const int kk = 2 * i + (lane >> 5); tv[i] = __builtin_nontemporal_load(W + (size_t)(k0 + kk) * N + n0 + (lane & 31)); }
#pragma unroll
    for (int i = 0; i < 32; ++i) { const int kk = 2 * i + (lane >> 5); float v = tv[i]; if (gain) v *= gain[k0 + kk]; scr[kk * 33 + (lane & 31)] = v; }
    LDS_WAIT(); asm volatile("" ::: "memory");
    const int c = lane & 7;
#pragma unroll
    for (int j = 0; j < 4; ++j) { const int n = (lane >> 3) + 8 * j; const LAS float* s = scr + (8 * c) * 33 + n;
        u32x4 o; o.x = pk2(s[0 * 33], s[1 * 33]); o.y = pk2(s[2 * 33], s[3 * 33]); o.z = pk2(s[4 * 33], s[5 * 33]); o.w = pk2(s[6 * 33], s[7 * 33]);
        *(GAS u32x4*)(WT + (size_t)(orow0 + n) * ldo + k0 + 8 * c) = o; }
    LDS_WAIT(); asm volatile("" ::: "memory");
}
template <bool I8>
__device__ __forceinline__ void transpose_item8(const float* W, int N, unsigned char* WT, int ldo, int k0, int n0, int orow0, float scl, LAS float* scr, int lane, int kdoff = 0) {
    float tv[32];
#pragma unroll
    for (int i = 0; i < 32; ++i) { const int kk = 2 * i + (lane >> 5); tv[i] = __builtin_nontemporal_load(W + (size_t)(k0 + kk) * N + n0 + (lane & 31)); }
#pragma unroll
    for (int i = 0; i < 32; ++i) { const int kk = 2 * i + (lane >> 5); scr[kk * 33 + (lane & 31)] = I8 ? tv[i] : tv[i] * scl; }
    LDS_WAIT(); asm volatile("" ::: "memory");
    const int c = lane & 7;
#pragma unroll
    for (int j = 0; j < 4; ++j) { const int n = (lane >> 3) + 8 * j; const LAS float* s = scr + (8 * c) * 33 + n;
        u32x2 o; if (I8) { o.x = pk4_i8(s[0 * 33], s[1 * 33], s[2 * 33], s[3 * 33], scl); o.y = pk4_i8(s[4 * 33], s[5 * 33], s[6 * 33], s[7 * 33], scl); }
        else { o.x = pk4_fp8(s[0 * 33], s[1 * 33], s[2 * 33], s[3 * 33]); o.y = pk4_fp8(s[4 * 33], s[5 * 33], s[6 * 33], s[7 * 33]); }
        *(GAS u32x2*)(WT + (size_t)(orow0 + n) * ldo + kdoff + k0 + 8 * c) = o; }
    LDS_WAIT(); asm volatile("" ::: "memory");
}
constexpr int CS_IN = 16 * 101, CS_UQ = 4 * 24, CS_UKV = 2 * 32, CS_OA = 8 * 32, CS_PAD = 96, CS_PAD2 = 0;
constexpr int CONV_NSTATIC = CS_IN + CS_UQ + CS_UKV + 2 * CS_OA + CS_PAD + CS_PAD2;
constexpr int CQ_OUT = 16 * 32, CQ_G = 16 * 16, CQ_D = 8 * 32;
constexpr int CONV_NQUEUE = CQ_OUT + 17 * 2 * CQ_G + 17 * CQ_D;
__device__ __forceinline__ void convert_static_item(const Ctx& C, int l, int it, LAS float* scr) {
    bf16* WB = (bf16*)(CWS + WS_W) + (size_t)l * WL_STRIDE;
    constexpr float WS8 = (float)(1 << FP8_WEXP), WI8 = (float)(1 << I8_WEXP);
    int r = it;
    if (r < CS_IN) { const int kb = r / 101, nb = r % 101; transpose_item8<true>(CIN(8) + (size_t)l * DM * INC, INC, (unsigned char*)(WB + WO_IN), 1024, 64 * kb, 32 * nb, (32 * nb < C_QB) ? 32 * nb : 32 * nb + 96, WI8, scr, C.lane); return; } r -= CS_IN;
    if (r < CS_UQ) { const int kb = r / 24, nb = r % 24; transpose_item(CIN(10) + (size_t)l * 256 * 768, 768, WB + WO_UQ, 256, 64 * kb, 32 * nb, 32 * nb, CIN(9) + l * 256, scr, C.lane); return; } r -= CS_UQ;
    if (r < CS_UKV) { const int kb = r / 32, nb = r % 32; transpose_item(CIN(12) + (size_t)l * 128 * 1024, 1024, WB + WO_UKV, 128, 64 * kb, 32 * nb, 32 * nb, CIN(11) + l * 128, scr, C.lane); return; } r -= CS_UKV;
    if (r < CS_OA) { const int kb = r / 32, nb = r % 32; transpose_item8<false>(CIN(17) + (size_t)l * 512 * DM, 1024, (unsigned char*)(WB + WO_OA), 1024, 64 * kb, 32 * nb, 32 * nb, WS8, scr, C.lane, 0); return; } r -= CS_OA;
    if (r < CS_OA) { const int kb = r / 32, nb = r % 32; transpose_item8<false>(CIN(18) + (size_t)l * 512 * DM, 1024, (unsigned char*)(WB + WO_OA), 1024, 64 * kb, 32 * nb, 32 * nb, WS8, scr, C.lane, 512); return; } r -= CS_OA;
    u32x4 zz = (u32x4){0u, 0u, 0u, 0u}; asm volatile("" : "+v"(zz));
    if (r < CS_PAD) { unsigned char* p = (unsigned char*)(WB + WO_IN) + (size_t)(C_QB + r) * 1024;
      *(GAS u32x4*)(p + C.lane * 16) = zz; return; } r -= CS_PAD;
    { const int row = r * 4 + (C.lane >> 4), ch = C.lane & 15;
      *(GAS u32x4*)(WB + WO_UKV + (size_t)row * 256 + 128 + ch * 8) = zz; }
}
__device__ __forceinline__ void convert_queue_item(const Ctx& C, int l, int it, LAS float* scr) {
    bf16* WB = (bf16*)(CWS + WS_W) + (size_t)l * WL_STRIDE;
    constexpr float WS8 = (float)(1 << FP8_WEXP), WI8 = (float)(1 << I8_WEXP);
    int r = it;
    if (r < CQ_OUT) { const int kb = r / 32, nb = r % 32; transpose_item8<false>(CIN(19) + (size_t)l * DM * DM, 1024, (unsigned char*)(WB + WO_OUT), 1024, 64 * kb, 32 * nb, 32 * nb, WS8, scr, C.lane); return; } r -= CQ_OUT;
    if (r < 17 * 2 * CQ_G) { const int e = r / (2 * CQ_G), q = r % (2 * CQ_G), up = q / CQ_G, sx = q % CQ_G, kb = sx / 16, nb = sx % 16;
        const float* src = (e < 16) ? ((up ? CIN(23) : CIN(22)) + ((size_t)l * NEXP + e) * DM * FF) : ((up ? CIN(26) : CIN(25)) + (size_t)l * DM * FF);
        const int n0 = 32 * nb, orow = (n0 >> 7) * 256 + up * 128 + (n0 & 127);
        transpose_item8<true>(src, FF, (unsigned char*)(WB + WO_GU) + (size_t)e * 1024 * 1024, 1024, 64 * kb, n0, orow, WI8, scr, C.lane); return; } r -= 17 * 2 * CQ_G;
    { const int e = r / CQ_D, sx = r % CQ_D, kb = sx / 32, nb = sx % 32;
        const float* src = (e < 16) ? (CIN(24) + ((size_t)l * NEXP + e) * FF * DM) : (CIN(27) + (size_t)l * FF * DM);
        transpose_item8<false>(src, 1024, (unsigned char*)(WB + WO_DN) + (size_t)e * 1024 * 512, 512, 64 * kb, 32 * nb, 32 * nb, WS8, scr, C.lane); }
}
__device__ __forceinline__ void convert_static(const Ctx& C, int l, int gw, int ngw) {
    LAS float* scr = (LAS float*)(C.lds + C.wave * 12288);
    for (int it = gw; it < CONV_NSTATIC; it += ngw) convert_static_item(C, l, it, scr);
}
__device__ __forceinline__ int convert_steal(const Ctx& C, int l, int limit, int max_grabs, bool precheck = false) {
    LAS float* scr = (LAS float*)(C.lds + C.wave * 12288);
    LAS int* sb = (LAS int*)(C.lds + LDSX_PFX + 128);
    unsigned* head = (unsigned*)(CWS + WS_CTL) + CW_STEAL + 64 * l;
    const int qoff = (l > 0) ? CONV_NSTATIC : 0;
    int g = 0;
    if (precheck) {
        __syncthreads();
        if (C.tid == 0) *sb = (int)__hip_atomic_load(head, __ATOMIC_RELAXED, __HIP_MEMORY_SCOPE_AGENT);
        __syncthreads();
        const int h0 = __builtin_amdgcn_readfirstlane(*sb);
        __syncthreads();
        if (h0 >= limit + qoff) return 0;
    }
    for (; g < max_grabs; ++g) {
        __syncthreads();
        if (C.tid == 0) *sb = (int)__hip_atomic_fetch_add(head, 16u, __ATOMIC_RELAXED, __HIP_MEMORY_SCOPE_AGENT);
        __syncthreads();
        const int base = __builtin_amdgcn_readfirstlane(*sb);
        if (base >= qoff + CONV_NQUEUE) break;
#pragma unroll 1
        for (int k = 0; k < 2; ++k) { const int it = base + C.wave * 2 + k; if (it < qoff) convert_static_item(C, l, it, scr); else if (it < qoff + CONV_NQUEUE) convert_queue_item(C, l, it - qoff, scr); }
        if (base + 16 >= limit + qoff) { ++g; break; }
    }
    __syncthreads();
    return g;
}
__device__ __forceinline__ unsigned queue_head_early(const Ctx& C, int l) {
    unsigned h = 0u; if (C.tid == 0) h = __hip_atomic_load((unsigned*)(CWS + WS_CTL) + CW_STEAL + 64 * l, __ATOMIC_RELAXED, __HIP_MEMORY_SCOPE_AGENT); return h; }
__device__ __forceinline__ void sweep_late(const Ctx& C, int l, int limit, unsigned hq) {
    LAS int* sb = (LAS int*)(C.lds + LDSX_PFX + 128);
    __syncthreads();
    if (C.tid == 0) *sb = (int)hq;
    __syncthreads();
    const int h0 = __builtin_amdgcn_readfirstlane(*sb);
    __syncthreads();
    if (h0 < limit + ((l > 0) ? CONV_NSTATIC : 0)) (void)convert_steal(C, l, limit, 1 << 20);
}
__device__ __forceinline__ void mod_gemv(const Ctx& C, int unit) {
    const int l = unit / 24, jb = unit % 24, j = jb * 256 + 4 * C.lane;
    const float* wm = CIN(4) + (size_t)l * DM * 6144 + j; const float* cc = CIN(1); const float* cx = CIN(3);
    f32x4 acc[5];
#pragma unroll
    for (int w = 0; w < 5; ++w) acc[w] = (f32x4){0.f, 0.f, 0.f, 0.f};
#pragma unroll
    for (int dc = 0; dc < 2; ++dc) { const int d0 = C.wave * 128 + dc * 64;
        float s[5];
#pragma unroll
        for (int w = 0; w < 5; ++w) { const float v = (w < 4) ? cc[w * DM + d0 + C.lane] : cx[d0 + C.lane]; s[w] = v * sigmoidf_(v); }
#pragma unroll
        for (int db = 0; db < 64; db += 16) { f32x4 wv[16];
#pragma unroll
            for (int dd = 0; dd < 16; ++dd) wv[dd] = __builtin_nontemporal_load((const f32x4*)(wm + (size_t)(d0 + db + dd) * 6144));
#pragma unroll
            for (int dd = 0; dd < 16; ++dd) asm volatile("" : "+v"(wv[dd]));
#pragma unroll
            for (int dd = 0; dd < 16; ++dd)
#pragma unroll
                for (int w = 0; w < 5; ++w) acc[w] = acc[w] + wv[dd] * rlane(s[w], db + dd); } }
    LAS f32x4* part = (LAS f32x4*)C.lds;
#pragma unroll
    for (int w = 0; w < 5; ++w) part[(C.wave * 5 + w) * 64 + C.lane] = acc[w];
    __syncthreads();
    if (C.wave < 5) { f32x4 t = (f32x4){0.f, 0.f, 0.f, 0.f};
#pragma unroll
        for (int k = 0; k < 8; ++k) t = t + part[(k * 5 + C.wave) * 64 + C.lane];
        float* mv = (float*)(CWS + WS_MISC + MO_MODV) + (size_t)l * 5 * 6144; *(f32x4*)(mv + C.wave * 6144 + j) = t + *(const f32x4*)(CIN(5) + l * 6144 + j); }
    __syncthreads();
}
__device__ __forceinline__ void make_tables(const Ctx& C) {
    float* ta = (float*)(CWS + WS_MISC + MO_TABA); float* tb = (float*)(CWS + WS_MISC + MO_TABB);
    for (int i = C.lane; i < 64 * 8; i += 64) { const int pos = i >> 3, f = i & 7; const float inv = exp2f(-13.287712379549449f * (float)(2 * f) / 16.0f); const float a = (float)pos * inv; ta[2 * i] = cosf(a); ta[2 * i + 1] = sinf(a); }
    for (int i = C.lane; i < 64 * 16; i += 64) { const int pos = i >> 4, f = i & 15; const float inv = exp2f(-13.287712379549449f * (float)(2 * f) / 32.0f); const float a = (float)pos * inv; tb[2 * i] = cosf(a); tb[2 * i + 1] = sinf(a); }
    float* cb = (float*)(CWS + WS_MISC + MO_CB);
    for (int l = 0; l < NLAYER; ++l) {
        float ma = 0.f, mb = 0.f, mc = 0.f, md = 0.f;
        for (int i = C.lane; i < 96; i += 64) { ma = fmaxf(ma, fabsf(CIN(13)[l * 96 + i])); mb = fmaxf(mb, fabsf(CIN(14)[l * 96 + i])); }
        { const int i = C.lane; mc = fabsf(CIN(15)[l * 64 + i]); md = fabsf(CIN(16)[l * 64 + i]); }
#pragma unroll
        for (int o = 1; o < 64; o <<= 1) { ma = fmaxf(ma, shx(ma, C.lane, o)); mb = fmaxf(mb, shx(mb, C.lane, o)); mc = fmaxf(mc, shx(mc, C.lane, o)); md = fmaxf(md, shx(md, C.lane, o)); }
        if (C.lane == 0) { cb[l * 2 + 0] = -(SCA * 96.0f * ma * mb * 1.02f + 0.5f); cb[l * 2 + 1] = -(SCB * 64.0f * mc * md * 1.02f + 0.5f); }
    }
}
__device__ __forceinline__ const float* stream_in(const Ctx& C, int l, int r) { return (r < TC) ? CIN(2) + (size_t)r * DM : CIN(0) + (size_t)(r - TC) * DM; }
__device__ __forceinline__ void xs_load(const bf16* row, int lane, f32x4 (&v)[4]) {
#pragma unroll
    for (int j = 0; j < 4; ++j) { const u32x2 w = *(const u32x2*)(row + j * 256 + 4 * lane); v[j] = (f32x4){bflo(w.x), bfhi(w.x), bflo(w.y), bfhi(w.y)}; }
}
__device__ __forceinline__ void xs_store(bf16* row, int lane, const f32x4 (&v)[4]) {
#pragma unroll
    for (int j = 0; j < 4; ++j) { u32x2 w; w.x = pk2(v[j].x, v[j].y); w.y = pk2(v[j].z, v[j].w); *(u32x2*)(row + j * 256 + 4 * lane) = w; }
}
__device__ __forceinline__ void expert_prefix(const unsigned* cnt, int srow0, LAS int* pfx, int tid) {
    if (tid == 0) { int s = 0;
#pragma unroll
        for (int e = 0; e < 16; ++e) { const int c = (int)cnt[64 * e]; pfx[e] = s; pfx[40 + e] = c; s += (c + 255) >> 8; }
        pfx[16] = s; s += (T - srow0) >> 8; pfx[17] = s; }
    __syncthreads();
}
__device__ __forceinline__ void wave_rows(int gw, int NGW, int lo, int hi, int& rb, int& re) { const int n = hi - lo, q = n / NGW, rem = n % NGW; rb = lo + gw * q + (gw < rem ? gw : rem); re = rb + q + (gw < rem ? 1 : 0); }
struct CombIdx { size_t r0, r1, r2; };
__device__ __forceinline__ CombIdx comb_idx(const Ctx& C, int r, const LAS int* pfx, int srow0) {
    const int* tp = (const int*)(CWS + WS_ROUTE + RO_TOKPOS) + 2 * r; const int t0 = tp[0], t1 = tp[1];
    CombIdx ci; ci.r0 = (size_t)pfx[16] * 256 + (r - srow0); ci.r1 = (size_t)pfx[t0 >> 20] * 256 + (t0 & 0xfffff); ci.r2 = (size_t)pfx[t1 >> 20] * 256 + (t1 & 0xfffff); return ci;
}
__device__ __forceinline__ void comb_load(const Ctx& C, const CombIdx& ci, unsigned (&y)[3][4]) {
    const unsigned char* YE = (const unsigned char*)(CWS + WS_R2);
#pragma unroll
    for (int j = 0; j < 4; ++j) { y[0][j] = __builtin_nontemporal_load((const unsigned*)(YE + ci.r0 * DM + j * 256 + 4 * C.lane)); y[1][j] = __builtin_nontemporal_load((const unsigned*)(YE + ci.r1 * DM + j * 256 + 4 * C.lane)); y[2][j] = __builtin_nontemporal_load((const unsigned*)(YE + ci.r2 * DM + j * 256 + 4 * C.lane)); }
}
__device__ __forceinline__ f32x4 fp8x4_to_f32(unsigned w) {
    const f32x2 lo = __builtin_amdgcn_cvt_pk_f32_fp8((int)w, false), hi = __builtin_amdgcn_cvt_pk_f32_fp8((int)w, true);
    return (f32x4){lo.x, lo.y, hi.x, hi.y};
}
__device__ __forceinline__ void comb_apply(const Ctx& C, const LAS float* gt2, const unsigned (&y)[3][4], f32x4 (&v)[4]) {
    constexpr float us = 1.0f / (float)(1 << FP8_AEXP);
#pragma unroll
    for (int j = 0; j < 4; ++j) { const f32x4 g = *(const LAS f32x4*)(gt2 + j * 256 + 4 * C.lane);
        const f32x4 t = (fp8x4_to_f32(y[0][j]) + fp8x4_to_f32(y[1][j]) + fp8x4_to_f32(y[2][j])) * us;
        v[j] = v[j] + g * t; }
}
__device__ __forceinline__ void mod_chunk_to_lds(LAS float* dst, const float* modv_layer, int chunk, int tid) {
#pragma unroll
    for (int q = 0; q < 10; ++q) { const int i = q * NTHR + tid, w = i >> 10, j = i & 1023; dst[i] = modv_layer[(size_t)(w * 6 + chunk) * DM + j]; }
}
__device__ __forceinline__ void norm_mod_row(const Ctx& C, const f32x4 (&v)[4], const f32x4 (&g)[4], const LAS float* sh, const LAS float* sc, unsigned char* orow, f32x4 (&f)[4]) {
    float s = 0.f;
#pragma unroll
    for (int j = 0; j < 4; ++j) s += (v[j].x * v[j].x + v[j].y * v[j].y) + (v[j].z * v[j].z + v[j].w * v[j].w);
    const float rstd = __builtin_amdgcn_rsqf(wave_sum(s, C.lane) * (1.0f / DM) + EPS);
#pragma unroll
    for (int j = 0; j < 4; ++j) { const int c = j * 256 + 4 * C.lane;
        const f32x4 a = *(const LAS f32x4*)(sc + c), b = *(const LAS f32x4*)(sh + c);
        f[j] = (v[j] * rstd) * g[j] * (a + 1.0f) + b;
        *(unsigned*)(orow + c) = pk4_i8(f[j].x, f[j].y, f[j].z, f[j].w, (float)(1 << I8_AEXP)); }
}

template <int KS, int NBW, int LDW, int NOUT, bool TOLDS>
__device__ __forceinline__ void local_upproj(const Ctx& C, const LAS unsigned char* la, int lpitch, const bf16* W, unsigned char* out, int RB, int RE, LAS unsigned char* stg) {
    const int fr = C.lane & 15, fq = C.lane >> 4;
    bf16x8 wf[2][2][KS];
#define LU_LOADW(buf, b_) do { const int nb_ = (C.wave + 8 * (b_)) * 2; _Pragma("unroll") for (int g = 0; g < 2; ++g) _Pragma("unroll") for (int ks = 0; ks < KS; ++ks) \
        wf[buf][g][ks] = *(const bf16x8*)(W + (size_t)((nb_ + g) * 16 + fr) * LDW + ks * 32 + fq * 8); } while (0)
    LU_LOADW(0, 0);
#pragma unroll
    for (int b = 0; b < NBW; ++b) {
        if (b + 1 < NBW) LU_LOADW((b + 1) & 1, b + 1);
        const int nb0 = (C.wave + 8 * b) * 2;
#define LU_LDA(dst, mb_) do { _Pragma("unroll") for (int ks = 0; ks < KS; ++ks) dst[ks] = *(const LAS bf16x8*)(la + ((mb_) * 16 + fr) * lpitch + ks * 64 + fq * 16); } while (0)
#define LU_MMA(src, mb_) do { f32x4 a0 = (f32x4){0.f, 0.f, 0.f, 0.f}, a1 = a0; \
            _Pragma("unroll") for (int ks = 0; ks < KS; ++ks) { a0 = __builtin_amdgcn_mfma_f32_16x16x32_bf16(wf[b & 1][0][ks], src[ks], a0, 0, 0, 0); a1 = __builtin_amdgcn_mfma_f32_16x16x32_bf16(wf[b & 1][1][ks], src[ks], a1, 0, 0, 0); } \
            constexpr float sa = (float)(1 << FP8_AEXP); const int rl_ = (mb_) * 16 + fr; \
            if (rl_ < 72) { if (TOLDS) { *(LAS unsigned*)(stg + rl_ * NOUT + nb0 * 16 + 4 * fq) = pk4_fp8_sat(a0[0] * sa, a0[1] * sa, a0[2] * sa, a0[3] * sa); \
                                         *(LAS unsigned*)(stg + rl_ * NOUT + nb0 * 16 + 16 + 4 * fq) = pk4_fp8_sat(a1[0] * sa, a1[1] * sa, a1[2] * sa, a1[3] * sa); } \
                            else { *(LAS unsigned*)(stg + rl_ * 32 + 4 * fq) = pk4_fp8_sat(a0[0] * sa, a0[1] * sa, a0[2] * sa, a0[3] * sa); \
                                   *(LAS unsigned*)(stg + rl_ * 32 + 16 + 4 * fq) = pk4_fp8_sat(a1[0] * sa, a1[1] * sa, a1[2] * sa, a1[3] * sa); } } } while (0)
        { bf16x8 afA[KS], afB[KS];
          LU_LDA(afA, 0);
          LU_LDA(afB, 1); LU_MMA(afA, 0);
          LU_LDA(afA, 2); LU_MMA(afB, 1);
          LU_LDA(afB, 3); LU_MMA(afA, 2);
          LU_LDA(afA, 4); LU_MMA(afB, 3);
          LU_MMA(afA, 4); }
#undef LU_LDA
#undef LU_MMA
        if (!TOLDS) {
        asm volatile("s_waitcnt lgkmcnt(0)" ::: "memory");
#pragma unroll
        for (int it = 0; it < 3; ++it) { const int c = it * 64 + C.lane, r_ = c >> 1, hf = c & 1;
            if (c < 144) { const u32x4 v = *(const LAS u32x4*)(stg + r_ * 32 + hf * 16); if (RB + r_ < RE) *(u32x4*)(out + (size_t)(RB + r_) * NOUT + nb0 * 16 + hf * 16) = v; } }
        asm volatile("s_waitcnt lgkmcnt(0)" ::: "memory"); }
    }
#undef LU_LOADW
}
constexpr int NPHASE = 1 + NLAYER * 10 + 1;

__global__ void __launch_bounds__(NTHR, 2) fwd_kernel(Args args) {
    extern __shared__ __attribute__((aligned(16))) unsigned char lds_raw[];
    Ctx C;
    C.lds = (LAS unsigned char*)lds_raw;
    C.tid = threadIdx.x; C.lane = C.tid & 63; C.wave = __builtin_amdgcn_readfirstlane(C.tid >> 6);
    C.G = gridDim.x; { const int bx = blockIdx.x; C.vcu = (C.G % 8 == 0) ? (bx % 8) * (C.G / 8) + bx / 8 : bx; }
    C.gw = C.vcu * NWAVES + C.wave; C.NGW = C.G * NWAVES;
    C.ap = (ArgsP)__builtin_amdgcn_kernarg_segment_ptr();
    unsigned char* ws = C.ap->ws;
    unsigned* ctl = (unsigned*)(ws + WS_CTL);
    volatile LAS unsigned* bst = (volatile LAS unsigned*)(C.lds + LDSX_MISC);
    if (C.tid < 4) bst[C.tid] = 0u;
    __syncthreads();
    XcdBarrier bar = xcd_barrier_post(ctl + CW_BAR + C.ap->li * XCD_BAR_WORDS, bst);
    const int lo = C.ap->ph_lo, hi = C.ap->ph_hi;
#ifndef PHMASK
#define PHMASK 0xfff
#endif
#define EN(kind) (((PHMASK) >> (kind)) & 1)
#ifndef REPMASK
#define REPMASK 0
#endif
#define NREP(kind) (1 + (((REPMASK) >> (kind)) & 1))
#define IN(k) (lo <= (k) && (k) < hi)
#ifndef BARX
#define BARX 1
#endif
#define SEAM(k) do { if (IN(k) && IN((k) + 1)) { _Pragma("unroll 1") for (int bx_ = 0; bx_ < BARX; ++bx_) { XcdBarrier b_ = bar; asm volatile("" : "+s"(b_.x)); xcd_barrier(b_); } } } while (0)
    LAS int* gtab = (LAS int*)(C.lds + LDSX_GTAB);
    LAS int* pfxl = (LAS int*)(C.lds + LDSX_PFX);
#define PH() { ArgsP _ap = C.ap; asm volatile("" : "+s"(_ap)); C.ap = _ap; int t_ = threadIdx.x; asm volatile("" : "+v"(t_)); C.tid = t_; C.lane = t_ & 63; C.wave = __builtin_amdgcn_readfirstlane(t_ >> 6); C.gw = C.vcu * NWAVES + C.wave; } \
    unsigned char* ws = C.ap->ws; unsigned* ctl = (unsigned*)(ws + WS_CTL); (void)ctl; \
    float* MODV = (float*)(ws + WS_MISC + MO_MODV); (void)MODV; bf16* WB = (bf16*)(ws + WS_W) + (size_t)l * WL_STRIDE; (void)WB; \
    bf16* R1 = (bf16*)(ws + WS_R1); (void)R1; bf16* PROJ = (bf16*)(ws + WS_R2); (void)PROJ; bf16* UQ = (bf16*)(ws + WS_R4); (void)UQ; bf16* QA = UQ; (void)QA; bf16* XS = (bf16*)(ws + WS_R5); (void)XS; \
    unsigned char* KA = ws + WS_R3 + R3_KA; (void)KA; bf16* VA = (bf16*)(ws + WS_R3 + R3_VA); (void)VA; unsigned char* QB = ws + WS_R3 + R3_QB; (void)QB; \
    unsigned char* KB = ws + WS_R3 + R3_KB; (void)KB; bf16* VB = (bf16*)(ws + WS_R3 + R3_VB); (void)VB; unsigned char* QA8 = ws + WS_R3 + R3_QA; (void)QA8; \
    bf16* Y1 = (bf16*)(ws + WS_R3 + R3_Y1); (void)Y1; bf16* YY = (bf16*)(ws + WS_R3 + R3_Y); (void)YY; bf16* HH = (bf16*)(ws + WS_R3 + R3_HH); (void)HH; \
    const float* modl = MODV + (size_t)l * 5 * 6144; (void)modl;

    if (EN(0) && IN(0)) {
#pragma unroll 1
      for (int rep = 0; rep < NREP(0); ++rep) {
        { ArgsP _ap = C.ap; asm volatile("" : "+s"(_ap)); C.ap = _ap; }
        const bool big = (C.G >= 250); const bool gemv_wg = big && (C.vcu % 5 == 0) && (C.vcu < 240);
        if (!big) { for (int u = C.vcu; u < 48; u += C.G) mod_gemv(C, u); } else if (gemv_wg) mod_gemv(C, C.vcu / 5);
        if (C.wave == 1 && C.vcu == 241 % C.G) make_tables(C);
        if (!big) convert_static(C, 0, C.gw, C.NGW); else if (!gemv_wg) { const int v3 = (C.vcu < 240) ? C.vcu - C.vcu / 5 - 1 : C.vcu - 48; convert_static(C, 0, v3 * NWAVES + C.wave, (C.G - 48) * NWAVES); }
        if (big && !gemv_wg) (void)convert_steal(C, 0, CONV_NQUEUE, 2);
        __syncthreads();
      }
    }
    SEAM(0);

    for (int l = 0; l < NLAYER; ++l) {
        const int P = 1 + l * 10;
        const bool lastl = (l == NLAYER - 1);
        const int mrow0 = lastl ? TC : 0;

        if (EN(1) && IN(P + 0)) {
#pragma unroll 1
          for (int rep = 0; rep < (NREP(1) > 1 && l == 0 ? 2 : 1); ++rep) {
            PH();
            const unsigned hqs = (l > 0) ? queue_head_early(C, l) : 0u;
            if (l > 0 && !IN(P - 2)) expert_prefix(ctl + CW_CNT + (l - 1) * 1024, 0, pfxl, C.tid);
            LAS float* mt = (LAS float*)C.lds;
            mod_chunk_to_lds(mt, modl, 0, C.tid); mod_chunk_to_lds(mt + 5 * DM, modl, 1, C.tid);
            if (l > 0) mod_chunk_to_lds(mt + 10 * DM, MODV + (size_t)(l - 1) * 5 * 6144, 5, C.tid);
            f32x4 gv[4];
#pragma unroll
            for (int j = 0; j < 4; ++j) gv[j] = *(const f32x4*)(CIN(6) + l * DM + j * 256 + 4 * C.lane);
            __syncthreads();
            int rb, re; wave_rows(C.gw, C.NGW, 0, T, rb, re);
            if (l == 0) {
                for (int r0 = rb; r0 < re; r0 += 4) {
                    f32x4 v[4][4], f[4];
#pragma unroll
                    for (int k = 0; k < 4; ++k) { const int r = (r0 + k < re) ? r0 + k : re - 1; const float* src = stream_in(C, 0, r);
#pragma unroll
                        for (int j = 0; j < 4; ++j) v[k][j] = __builtin_nontemporal_load((const f32x4*)(src + j * 256 + 4 * C.lane)); }
#pragma unroll
                    for (int k = 0; k < 4; ++k) if (r0 + k < re) { const int r = r0 + k, which = (r < TC) ? 4 : ((r - TC) >> 12);
                        xs_store(XS + (size_t)r * DM, C.lane, v[k]);
                        norm_mod_row(C, v[k], gv, mt + which * DM, mt + (5 + which) * DM, (unsigned char*)R1 + (size_t)r * DM, f); }
                }
            } else {
                constexpr int NB = 4;
                CombIdx cn[NB];
#pragma unroll
                for (int k = 0; k < NB; ++k) { const int r = (rb + k < re) ? rb + k : re - 1; cn[k] = comb_idx(C, r, pfxl, 0); }
                for (int r0 = rb; r0 < re; r0 += NB) {
                    f32x4 v[NB][4], f[4]; unsigned y[NB][3][4]; CombIdx ci[NB];
#pragma unroll
                    for (int k = 0; k < NB; ++k) { const int r = (r0 + k < re) ? r0 + k : re - 1; ci[k] = cn[k]; xs_load(XS + (size_t)r * DM, C.lane, v[k]); }
#pragma unroll
                    for (int k = 0; k < NB; ++k) comb_load(C, ci[k], y[k]);
#pragma unroll
                    for (int k = 0; k < NB; ++k) { const int r = (r0 + NB + k < re) ? r0 + NB + k : re - 1; cn[k] = comb_idx(C, r, pfxl, 0); }
#pragma unroll
                    for (int k = 0; k < NB; ++k) if (r0 + k < re) { const int r = r0 + k, which = (r < TC) ? 4 : ((r - TC) >> 12);
                        comb_apply(C, mt + (10 + which) * DM, y[k], v[k]); xs_store(XS + (size_t)r * DM, C.lane, v[k]);
                        norm_mod_row(C, v[k], gv, mt + which * DM, mt + (5 + which) * DM, (unsigned char*)R1 + (size_t)r * DM, f); }
                }
            }
            __syncthreads();
            if (l > 0) sweep_late(C, l, 0, hqs);
          }
        }
        SEAM(P + 0);

        if (EN(2) && IN(P + 1)) {
#pragma unroll 1
          for (int rep = 0; rep < NREP(2); ++rep) {
            PH();
            constexpr int SW = 0x01010101 * (127 - FP8_WEXP), SA0 = 0x7f7f7f7f;
            pg8::StaticOrder S; S.init(T, INCP, C.G, (int)blockIdx.x, DM / 2, DM / 2);
            pg8::EpiProj E{PROJ};
            pg8::gemm_phase<pg8::EpiProj, pg8::StaticOrder, false, 2>(C.lds, R1, DM / 2, WB + WO_IN, DM / 2, S, E, gtab, SW, SA0, 1.0f / (float)(1 << (I8_AEXP + I8_WEXP)));
            if ((S.nwg + C.G - 1 - S.c) / C.G < (S.nwg + C.G - 1) / C.G) (void)convert_steal(C, l, CONV_NQUEUE, 2);
          }
        }
        SEAM(P + 1);


        if (EN(4) && IN(P + 3)) {
#pragma unroll 1
          for (int rep = 0; rep < (NREP(4) > 1 ? 2 : 1); ++rep) {
            PH();
            const unsigned hq = queue_head_early(C, l);
            const float* g_qa = CIN(13) + l * 96; const float* g_ka = CIN(14) + l * 96; const float* g_qb = CIN(15) + l * 64; const float* g_kb = CIN(16) + l * 64;
            const float* tabA = (const float*)(ws + WS_MISC + MO_TABA); const float* tabB = (const float*)(ws + WS_MISC + MO_TABB);
            const int h = C.lane >> 3, j = C.lane & 7, ax = j >> 2, i0 = 2 * (j & 3);
            float gqa_n[8], gka_n[8], gqa_r[4], gka_r[4], gqb8[8], gkb8[8];
#pragma unroll
            for (int e = 0; e < 8; ++e) { gqa_n[e] = g_qa[8 * j + e]; gka_n[e] = g_ka[8 * j + e]; gqb8[e] = g_qb[8 * j + e]; gkb8[e] = g_kb[8 * j + e]; }
#pragma unroll
            for (int e = 0; e < 2; ++e) { gqa_r[e] = g_qa[64 + ax * 16 + i0 + e]; gqa_r[2 + e] = g_qa[64 + ax * 16 + 8 + i0 + e]; gka_r[e] = g_ka[64 + ax * 16 + i0 + e]; gka_r[2 + e] = g_ka[64 + ax * 16 + 8 + i0 + e]; }
            sweep_late(C, l, CQ_OUT, hq);
            int RB, RE; LAS unsigned char* lb = C.lds; LAS unsigned char* la = C.lds + 20736; LAS unsigned char* uql = C.lds + 59904; LAS unsigned char* ukl = C.lds + 20736;
            int rb, re; wave_rows(C.gw, C.NGW, 0, T, rb, re);
            { int t0_, t1_; wave_rows(C.vcu * NWAVES, C.NGW, 0, T, RB, t0_); wave_rows(C.vcu * NWAVES + NWAVES - 1, C.NGW, 0, T, t1_, RE);
              { u32x4 sq[5], sk[3];
#pragma unroll
                for (int q = 0; q < 5; ++q) { const int i = q * NTHR + C.tid, ic = (i < 72 * 32) ? i : 0, r_ = ic >> 5, ch = ic & 31; const int row = (RB + r_ < T) ? RB + r_ : T - 1;
                    sq[q] = *(const u32x4*)((const char*)(PROJ + (size_t)row * INCP + C_CQ) + ch * 16); }
#pragma unroll
                for (int q = 0; q < 3; ++q) { const int i = q * NTHR + C.tid, ic = (i < 72 * 16) ? i : 0, r_ = ic >> 4, ch = ic & 15; const int row = (RB + r_ < T) ? RB + r_ : T - 1;
                    sk[q] = *(const u32x4*)((const char*)(PROJ + (size_t)row * INCP + C_CKV) + ch * 16); }
#pragma unroll
                for (int q = 0; q < 5; ++q) { const int i = q * NTHR + C.tid; if (i < 72 * 32) *(LAS u32x4*)(la + (i >> 5) * 544 + (i & 31) * 16) = sq[q]; }
#pragma unroll
                for (int q = 0; q < 3; ++q) { const int i = q * NTHR + C.tid; if (i < 72 * 16) *(LAS u32x4*)(lb + (i >> 4) * 288 + (i & 15) * 16) = sk[q]; } }
              __syncthreads();
              local_upproj<8, 3, 256, 776, true>(C, la, 544, WB + WO_UQ, nullptr, RB, RE, uql);
              __syncthreads(); }
            for (int r0 = rb; r0 < re; r0 += 2) {
                u32x2 i_cq[2], i_uq[2]; unsigned i_q1[2], i_q2[2]; f32x4 t_a[2];
#pragma unroll
                for (int k = 0; k < 2; ++k) { const int r = (r0 + k < re) ? r0 + k : re - 1;
                    i_cq[k] = *(const LAS u32x2*)(la + (r - RB) * 544 + 8 * C.lane);
                    { const LAS unsigned char* ql = uql + (r - RB) * 776 + h * 96; i_uq[k] = *(const LAS u32x2*)(ql + 8 * j); i_q1[k] = *(const LAS unsigned short*)(ql + 64 + ax * 16 + i0); i_q2[k] = *(const LAS unsigned short*)(ql + 64 + ax * 16 + 8 + i0); }
                    { const int n_ = (r < TC) ? 0 : ((r - TC) & 4095), pos = ax ? (n_ & 63) : (n_ >> 6); t_a[k] = *(const f32x4*)(tabA + (pos * 8 + i0) * 2); } }
#pragma unroll
              for (int k = 0; k < 2; ++k) if (r0 + k < re) { const int r = r0 + k; const bool isctx = r < TC;
                float s1; { const u32x2 a = i_cq[k]; const float a0 = bflo(a.x), a1 = bfhi(a.x), a2 = bflo(a.y), a3 = bfhi(a.y); s1 = (a0 * a0 + a1 * a1) + (a2 * a2 + a3 * a3); }
                const float rs_cq = __builtin_amdgcn_rsqf(wave_sum(s1, C.lane) * (1.0f / 256.0f) + EPS);
                { unsigned char* qa = QA8 + (size_t)r * 1024 + h * 128;
                  const u32x2 a = i_uq[k];
                  const f32x2 a0 = __builtin_amdgcn_cvt_pk_f32_fp8((int)a.x, false), a1 = __builtin_amdgcn_cvt_pk_f32_fp8((int)a.x, true), a2 = __builtin_amdgcn_cvt_pk_f32_fp8((int)a.y, false), a3 = __builtin_amdgcn_cvt_pk_f32_fp8((int)a.y, true);
                  const f32x2 y1 = __builtin_amdgcn_cvt_pk_f32_fp8((int)i_q1[k], false), y2 = __builtin_amdgcn_cvt_pk_f32_fp8((int)i_q2[k], false);
                  float v[8] = {a0[0], a0[1], a1[0], a1[1], a2[0], a2[1], a3[0], a3[1]}; float x1[2] = {y1[0], y1[1]}, x2[2] = {y2[0], y2[1]};
                  const float rsq_ = rs_cq * (1.0f / (float)(1 << FP8_AEXP));
                  float ss = 0.f;
#pragma unroll
                  for (int e = 0; e < 8; ++e) { v[e] *= rsq_; ss += v[e] * v[e]; }
#pragma unroll
                  for (int e = 0; e < 2; ++e) { x1[e] *= rsq_; x2[e] *= rsq_; ss += x1[e] * x1[e] + x2[e] * x2[e]; }
                  const float rn = SCA * __builtin_amdgcn_rsqf(sum8(ss, C.lane) * (1.0f / 96.0f) + EPS);
#pragma unroll
                  for (int e = 0; e < 8; ++e) v[e] *= rn * gqa_n[e];
                  float o1[2], o2[2];
#pragma unroll
                  for (int e = 0; e < 2; ++e) { const float a1 = x1[e] * rn * gqa_r[e], a2 = x2[e] * rn * gqa_r[2 + e];
                      if (isctx) { o1[e] = a1; o2[e] = a2; } else { const float cc_ = t_a[k][2 * e], ss_ = t_a[k][2 * e + 1]; o1[e] = a1 * cc_ - a2 * ss_; o2[e] = a1 * ss_ + a2 * cc_; } }
                  constexpr float qs = (float)(1 << att::QEXP);
                  u32x4 w; w.x = pk4_fp8(v[0] * qs, v[1] * qs, v[2] * qs, v[3] * qs); w.y = pk4_fp8(v[4] * qs, v[5] * qs, v[6] * qs, v[7] * qs); w.z = pk4_fp8(o1[0] * qs, o1[1] * qs, o2[0] * qs, o2[1] * qs); w.w = 0u;
                  *(u32x4*)(qa + 16 * j) = w; }
              }
            }
            __syncthreads();
            local_upproj<4, 4, 128, 1040, true>(C, lb, 288, WB + WO_UKV, nullptr, RB, RE, ukl);
            __syncthreads();
            for (int r0 = rb; r0 < re; r0 += 2) {
                unsigned i_ckv[2], i_k1[2], i_k2[2]; u32x2 i_uk[2], i_uv[2], i_qb[2], i_kb[2], i_vb[2]; f32x4 t_a[2], t_b[2][4];
#pragma unroll
                for (int k = 0; k < 2; ++k) { const int r = (r0 + k < re) ? r0 + k : re - 1;
                    const bf16* pr = PROJ + (size_t)r * INCP; const LAS unsigned char* uk = ukl + (r - RB) * 1040 + h * 128;
#define NTL(T_, p_) __builtin_nontemporal_load((const T_*)(p_))
                    i_ckv[k] = *(const LAS unsigned*)(lb + (r - RB) * 288 + 4 * C.lane);
                    i_uk[k] = *(const LAS u32x2*)(uk + 8 * j); i_uv[k] = *(const LAS u32x2*)(uk + 64 + 8 * j);
                    i_k1[k] = NTL(unsigned, pr + C_KR + ax * 16 + i0); i_k2[k] = NTL(unsigned, pr + C_KR + ax * 16 + 8 + i0);
                    { const unsigned char* p8 = (const unsigned char*)pr; i_qb[k] = NTL(u32x2, p8 + PQ8 + h * 64 + 8 * j); i_kb[k] = NTL(u32x2, p8 + PK8 + (h & 1) * 64 + 8 * j); i_vb[k] = NTL(u32x2, p8 + PV8 + (C.lane & 15) * 8); }
#undef NTL
                    { const int n_ = (r < TC) ? 0 : ((r - TC) & 4095), pos = ax ? (n_ & 63) : (n_ >> 6);
                      t_a[k] = *(const f32x4*)(tabA + (pos * 8 + i0) * 2);
#pragma unroll
                      for (int q = 0; q < 4; ++q) t_b[k][q] = *(const f32x4*)(tabB + (pos * 16 + (j & 1) * 8 + 2 * q) * 2); } }
#pragma unroll
              for (int k = 0; k < 2; ++k) if (r0 + k < re) { const int r = r0 + k;
                const bool isctx = r < TC; const int b = isctx ? (r >> 8) : ((r - TC) >> 12); const int n = isctx ? (r & 255) : ((r - TC) & 4095);
                const int Lidx = isctx ? n : CTXL + n; const int prow = n >> 6, pcol = n & 63;
                const size_t krow = (size_t)b * LK + Lidx;
                float s2;
                { const unsigned c = i_ckv[k]; const float c0 = bflo(c), c1 = bfhi(c); s2 = c0 * c0 + c1 * c1; }
                const float rs_ckv = __builtin_amdgcn_rsqf(wave_sum(s2, C.lane) * (1.0f / 128.0f) + EPS);
                { const u32x2 a = i_uk[k], vv = i_uv[k];
                  const unsigned x1w = i_k1[k], x2w = i_k2[k];
                  const f32x2 a0 = __builtin_amdgcn_cvt_pk_f32_fp8((int)a.x, false), a1 = __builtin_amdgcn_cvt_pk_f32_fp8((int)a.x, true), a2 = __builtin_amdgcn_cvt_pk_f32_fp8((int)a.y, false), a3 = __builtin_amdgcn_cvt_pk_f32_fp8((int)a.y, true);
                  float v[8] = {a0[0], a0[1], a1[0], a1[1], a2[0], a2[1], a3[0], a3[1]}; float x1[2] = {bflo(x1w), bfhi(x1w)}, x2[2] = {bflo(x2w), bfhi(x2w)};
                  const float rsk_ = rs_ckv * (1.0f / (float)(1 << FP8_AEXP));
                  float ss = 0.f;
#pragma unroll
                  for (int e = 0; e < 8; ++e) { v[e] *= rsk_; ss += v[e] * v[e]; }
#pragma unroll
                  for (int e = 0; e < 2; ++e) ss += x1[e] * x1[e] + x2[e] * x2[e];
                  const float rn = __builtin_amdgcn_rsqf(sum8(ss, C.lane) * (1.0f / 96.0f) + EPS);
#pragma unroll
                  for (int e = 0; e < 8; ++e) v[e] *= rn * gka_n[e];
                  float o1[2], o2[2];
#pragma unroll
                  for (int e = 0; e < 2; ++e) { const float a1 = x1[e] * rn * gka_r[e], a2 = x2[e] * rn * gka_r[2 + e];
                      if (isctx) { o1[e] = a1; o2[e] = a2; } else { const float cc_ = t_a[k][2 * e], ss_ = t_a[k][2 * e + 1]; o1[e] = a1 * cc_ - a2 * ss_; o2[e] = a1 * ss_ + a2 * cc_; } }
                  unsigned char* ka = KA + krow * 1024 + h * 128;
                  u32x4 w; w.x = pk4_fp8(v[0], v[1], v[2], v[3]); w.y = pk4_fp8(v[4], v[5], v[6], v[7]); w.z = pk4_fp8(o1[0], o1[1], o2[0], o2[1]); w.w = 0u;
                  *(u32x4*)(ka + 16 * j) = w;
                  const f32x2 q0 = __builtin_amdgcn_cvt_pk_f32_fp8((int)vv.x, false), q1 = __builtin_amdgcn_cvt_pk_f32_fp8((int)vv.x, true), q2 = __builtin_amdgcn_cvt_pk_f32_fp8((int)vv.y, false), q3 = __builtin_amdgcn_cvt_pk_f32_fp8((int)vv.y, true);
                  u32x4 wv; wv.x = pk2(q0[0] * rsk_, q0[1] * rsk_); wv.y = pk2(q1[0] * rsk_, q1[1] * rsk_); wv.z = pk2(q2[0] * rsk_, q2[1] * rsk_); wv.w = pk2(q3[0] * rsk_, q3[1] * rsk_);
                  *(u32x4*)(VA + krow * 512 + h * 64 + 8 * j) = wv; }
#pragma unroll
                for (int pass = 0; pass < 2; ++pass) {
                    const int hh = pass ? (h & 1) : h;
                    const u32x2 a = pass ? i_kb[k] : i_qb[k];
                    const f32x2 a0 = __builtin_amdgcn_cvt_pk_f32_fp8((int)a.x, false), a1 = __builtin_amdgcn_cvt_pk_f32_fp8((int)a.x, true), a2 = __builtin_amdgcn_cvt_pk_f32_fp8((int)a.y, false), a3 = __builtin_amdgcn_cvt_pk_f32_fp8((int)a.y, true);
                    constexpr float u8_ = 1.0f / (float)(1 << FP8_AEXP);
                    float v[8] = {a0[0] * u8_, a0[1] * u8_, a1[0] * u8_, a1[1] * u8_, a2[0] * u8_, a2[1] * u8_, a3[0] * u8_, a3[1] * u8_};
                    float ss = 0.f;
#pragma unroll
                    for (int e = 0; e < 8; ++e) ss += v[e] * v[e];
                    const float rn = (pass ? 1.0f : SCB) * __builtin_amdgcn_rsqf(sum8(ss, C.lane) * (1.0f / 64.0f) + EPS);
#pragma unroll
                    for (int e = 0; e < 8; ++e) v[e] *= rn * (pass ? gkb8[e] : gqb8[e]);
                    float o[8];
#pragma unroll
                    for (int e = 0; e < 8; ++e) { const float px = dppf<DPP_X2>(v[e]);
                        if (isctx) o[e] = v[e];
                        else { const float cc_ = t_b[k][e >> 1][2 * (e & 1)], ss_ = t_b[k][e >> 1][2 * (e & 1) + 1]; o[e] = (j & 2) ? (px * ss_ + v[e] * cc_) : (v[e] * cc_ - px * ss_); } }
                    const float qs = pass ? 1.0f : (float)(1 << att::QEXP);
                    u32x2 w; w.x = pk4_fp8(o[0] * qs, o[1] * qs, o[2] * qs, o[3] * qs); w.y = pk4_fp8(o[4] * qs, o[5] * qs, o[6] * qs, o[7] * qs);
                    if (!pass) *(u32x2*)(QB + (size_t)r * 512 + h * 64 + 8 * j) = w;
                    else if (C.lane < 16) *(u32x2*)(KB + krow * 128 + hh * 64 + 8 * j) = w;
                }
                if (C.lane >= 16 && C.lane < 32) { const u32x2 a = i_vb[k]; constexpr float u8_ = 1.0f / (float)(1 << FP8_AEXP);
                    const f32x2 a0 = __builtin_amdgcn_cvt_pk_f32_fp8((int)a.x, false), a1 = __builtin_amdgcn_cvt_pk_f32_fp8((int)a.x, true), a2 = __builtin_amdgcn_cvt_pk_f32_fp8((int)a.y, false), a3 = __builtin_amdgcn_cvt_pk_f32_fp8((int)a.y, true);
                    u32x4 wv; wv.x = pk2(a0[0] * u8_, a0[1] * u8_); wv.y = pk2(a1[0] * u8_, a1[1] * u8_); wv.z = pk2(a2[0] * u8_, a2[1] * u8_); wv.w = pk2(a3[0] * u8_, a3[1] * u8_);
                    *(u32x4*)(VB + krow * 128 + (C.lane - 16) * 8) = wv; }
              }
            }
          }
        }
        SEAM(P + 3);

        if (EN(5) && IN(P + 4)) {
#pragma unroll 1
          for (int rep = 0; rep < NREP(5); ++rep) {
            PH();
            const float* cb = (const float*)(ws + WS_MISC + MO_CB) + l * 2;
            const float negA = cb[0], negB = cb[1];
            unsigned char* O = (unsigned char*)R1;
            const int NU = 1024 + (lastl ? 0 : 64);
            for (int u = C.vcu; u < NU; u += C.G) {
                int kind, b, hd, NT; size_t r0;
                if (u < 1024) { const int i = u >> 8, v = u & 255, idx = 2 * v + (i >> 1); kind = i & 1; NT = LK / 64;
                    if (kind == 0) { const int bh = idx >> 4, qb = idx & 15; b = bh >> 3; hd = bh & 7; r0 = (size_t)TC + (size_t)b * SEQ + qb * 256 + C.wave * 32; }
                    else { const int bk = idx >> 6, jj = idx & 63, qb = jj >> 2, g = jj & 3; b = bk >> 1; hd = (bk & 1) * 4 + g; r0 = (size_t)TC + (size_t)b * SEQ + qb * 256 + C.wave * 32; } }
                else { const int w = u - 1024, bh = w & 31; kind = w >> 5; b = bh >> 3; hd = bh & 7; NT = CTXL / 64; r0 = (size_t)b * CTXL + C.wave * 32; }
                if (kind == 0) att::attn_unit<96>(QA8 + r0 * 1024 + hd * 128, 1024, KA + (size_t)b * LK * 1024 + hd * 128, 1024, VA + (size_t)b * LK * 512 + hd * 64, 512, O + r0 * DM + hd * 64, NT, negA, C.lds);
                else att::attn_unit<64>(QB + r0 * 512 + hd * 64, 512, KB + (size_t)b * LK * 128 + (hd >> 2) * 64, 128, VB + (size_t)b * LK * 128 + (hd >> 2) * 64, 128, O + r0 * DM + 512 + hd * 64, NT, negB, C.lds);
            }
            if (!lastl && C.vcu + 1024 >= NU) { __syncthreads();
                const int g0 = convert_steal(C, l, CONV_NQUEUE, 1); if (g0 < 1 && l + 1 < NLAYER) (void)convert_steal(C, l + 1, CONV_NQUEUE, 1); }
          }
        }
        SEAM(P + 4);

        if (EN(6) && IN(P + 5)) {
#pragma unroll 1
          for (int rep = 0; rep < NREP(6); ++rep) {
            PH();
            const int M = T - TC; const unsigned char* O = (const unsigned char*)R1 + (size_t)TC * DM;
            constexpr int SW = 0x01010101 * (127 - FP8_WEXP), SA = 0x01010101 * (127 - FP8_AEXP);
            pg8::StaticOrder S; S.init(M, DM, C.G, (int)blockIdx.x, DM / 2, DM / 2);
            pg8::EpiGateF E{(unsigned char*)YY + (size_t)TC * DM, (const unsigned char*)PROJ + (size_t)TC * PROW};
            pg8::gemm_phase<pg8::EpiGateF, pg8::StaticOrder, false, 1, true>(C.lds, (const bf16*)O, DM / 2, WB + WO_OA, DM / 2, S, E, gtab, SW, SA);
            if (mrow0 == 0) ctx_mini_gemm<true>(C, (const unsigned char*)R1, (const unsigned char*)(WB + WO_OA), SW, SA, (unsigned char*)YY, (const unsigned char*)PROJ, nullptr, nullptr, nullptr);
            if ((S.nwg + C.G - 1 - S.c) / C.G < (S.nwg + C.G - 1) / C.G) { const int g0 = convert_steal(C, l, CONV_NQUEUE, 4); if (g0 < 4 && l + 1 < NLAYER) (void)convert_steal(C, l + 1, CONV_NQUEUE, 4 - g0); }
          }
        }
        SEAM(P + 5);

        if (EN(7) && IN(P + 6)) {
#pragma unroll 1
          for (int rep = 0; rep < (NREP(7) > 1 && l == 0 ? 2 : 1); ++rep) {
            PH();
            const int M = T - TC;
            constexpr int SW = 0x01010101 * (127 - FP8_WEXP), SA = 0x01010101 * (127 - FP8_AEXP);
            pg8::StaticOrder S; S.init(M, DM, C.G, (int)blockIdx.x, DM / 2, DM / 2);
            pg8::EpiRes E{XS, modl, TC, 2};
            pg8::gemm_phase<pg8::EpiRes, pg8::StaticOrder, false, 1>(C.lds, (const bf16*)((const unsigned char*)YY + (size_t)TC * DM), DM / 2, WB + WO_OUT, DM / 2, S, E, gtab, SW, SA);
            if (mrow0 == 0) ctx_mini_gemm<false>(C, (const unsigned char*)YY, (const unsigned char*)(WB + WO_OUT), SW, SA, nullptr, nullptr, nullptr, XS, modl + (size_t)(4 * 6 + 2) * DM);
            if ((S.nwg + C.G - 1 - S.c) / C.G < (S.nwg + C.G - 1) / C.G) { const int g0 = convert_steal(C, l, CONV_NQUEUE, 4); if (g0 < 4 && l + 1 < NLAYER) (void)convert_steal(C, l + 1, CONV_NQUEUE, 4 - g0); }
          }
        }
        SEAM(P + 6);

        if (EN(8) && IN(P + 7)) {
#pragma unroll 1
          for (int rep = 0; rep < NREP(8); ++rep) {
            PH();
            const unsigned hq = queue_head_early(C, l);
            float mA[10], mB[10]; f32x4 gv[4];
            LAS float* wT = (LAS float*)C.lds;
            { const f32x4* wsrc = (const f32x4*)CIN(20); f32x4 wq[8];
#pragma unroll
              for (int q = 0; q < 8; ++q) wq[q] = wsrc[q * NTHR + C.tid];
#pragma unroll
              for (int q = 0; q < 10; ++q) { const int i = q * NTHR + C.tid, w = i >> 10, j = i & 1023; mA[q] = modl[(size_t)(w * 6 + 3) * DM + j]; mB[q] = modl[(size_t)(w * 6 + 4) * DM + j]; }
#pragma unroll
              for (int j = 0; j < 4; ++j) gv[j] = *(const f32x4*)(CIN(7) + l * DM + j * 256 + 4 * C.lane);
              sweep_late(C, l, CONV_NQUEUE, hq);
#pragma unroll
              for (int q = 0; q < 8; ++q) { const int i4 = q * NTHR + C.tid, d = i4 >> 2, e0 = (i4 & 3) * 4;
#pragma unroll
                  for (int k = 0; k < 4; ++k) wT[(e0 + k) * DM + d] = wq[q][k]; } }
            LAS int* lcnt = (LAS int*)(C.lds + 65536);
            LAS int* rt_row = lcnt + 32; LAS int* rt_e = rt_row + 256; LAS int* rt_lp = rt_e + 512; LAS float* rt_w = (LAS float*)(rt_lp + 512);
            if (C.tid < 32) lcnt[C.tid] = 0;
            __syncthreads();
            const float* brt = CIN(21);
            LAS float* mt = (LAS float*)(C.lds + 80 * 1024);
#pragma unroll
            for (int q = 0; q < 10; ++q) { const int i = q * NTHR + C.tid; mt[i] = mA[q]; mt[5 * DM + i] = mB[q]; }
            __syncthreads();
            unsigned* cnt = ctl + CW_CNT + l * 1024 + ((rep + 1 < NREP(8)) ? 2048 : 0);
            int* liste = (int*)(ws + WS_ROUTE + RO_LISTE); float* roww = (float*)(ws + WS_ROUTE + RO_ROWW); int* tokpos = (int*)(ws + WS_ROUTE + RO_TOKPOS);
            int rb, re; wave_rows(C.gw, C.NGW, mrow0, T, rb, re);
            const int lb3 = (C.lane >> 3) & 1, lb2 = (C.lane >> 2) & 1, lb1 = (C.lane >> 1) & 1, lb0 = C.lane & 1;
            const float brl = brt[C.lane & 15];
            for (int r0 = rb; r0 < re; r0 += 3) {
                f32x4 v[3][4], f[3][4];
#pragma unroll
                for (int k = 0; k < 3; ++k) { const int r = (r0 + k < re) ? r0 + k : re - 1; xs_load(XS + (size_t)r * DM, C.lane, v[k]); }
#pragma unroll
                for (int k = 0; k < 3; ++k) { const int r = (r0 + k < re) ? r0 + k : re - 1, which = (r < TC) ? 4 : ((r - TC) >> 12);
                    norm_mod_row(C, v[k], gv, mt + which * DM, mt + (5 + which) * DM, (unsigned char*)R1 + (size_t)r * DM, f[k]); }
                float a[3][16];
#pragma unroll
                for (int e = 0; e < 16; ++e) { f32x4 w[4];
#pragma unroll
                    for (int j = 0; j < 4; ++j) w[j] = *(const LAS f32x4*)(wT + e * DM + j * 256 + 4 * C.lane);
#pragma unroll
                    for (int k = 0; k < 3; ++k) { f32x4 a4 = f[k][0] * w[0];
#pragma unroll
                        for (int j = 1; j < 4; ++j) a4 = f[k][j] * w[j] + a4;
                        float t = (a4.x + a4.y) + (a4.z + a4.w);
                        asm volatile("" : "+v"(t)); a[k][e] = t; }
                    if (e & 1) __builtin_amdgcn_sched_barrier(0); }
#pragma unroll
                for (int k = 0; k < 3; ++k) {
                    float b8[8], b4[4], b2[2], b1;
#pragma unroll
                    for (int i = 0; i < 8; ++i) { const float snd = lb3 ? a[k][i] : a[k][i + 8], kp = lb3 ? a[k][i + 8] : a[k][i]; b8[i] = kp + dppf<DPP_RM>(snd); }
#pragma unroll
                    for (int i = 0; i < 4; ++i) { const float snd = lb2 ? b8[i] : b8[i + 4], kp = lb2 ? b8[i + 4] : b8[i]; b4[i] = kp + dppf<DPP_HM>(snd); }
#pragma unroll
                    for (int i = 0; i < 2; ++i) { const float snd = lb1 ? b4[i] : b4[i + 2], kp = lb1 ? b4[i + 2] : b4[i]; b2[i] = kp + dppf<DPP_X2>(snd); }
                    { const float snd = lb0 ? b2[0] : b2[1], kp = lb0 ? b2[1] : b2[0]; b1 = kp + dppf<DPP_X1>(snd); }
                    b1 += shx(b1, C.lane, 16); b1 += shx(b1, C.lane, 32);
                    const float scl = sigmoidf_(b1), sel = scl + brl;
                    const float x1 = dppf<DPP_X1>(sel), x2 = dppf<DPP_X2>(sel), x3 = dppf<0x1B>(sel);
                    const float gsum = fmaxf(fmaxf(fmaxf(sel + x1, sel + x2), fmaxf(sel + x3, x1 + x2)), fmaxf(x1 + x3, x2 + x3));
                    float best = rlane(gsum, 0); int bg = 0;
#pragma unroll
                    for (int g = 1; g < 4; ++g) { const float gs = rlane(gsum, 4 * g); if (gs > best) { best = gs; bg = g; } }
                    float m1 = -1e30f, m2 = -1e30f, w1 = 0.f, w2 = 0.f; int e1 = 0, e2 = 0;
#pragma unroll
                    for (int q = 0; q < 4; ++q) { const int e = 4 * bg + q; const float x = rlane(sel, e), sv = rlane(scl, e);
                        if (x > m1) { m2 = m1; e2 = e1; w2 = w1; m1 = x; e1 = e; w1 = sv; } else if (x > m2) { m2 = x; e2 = e; w2 = sv; } }
                    if (r0 + k < re && C.lane == 0) { const int r = r0 + k, slot = C.wave * 32 + (r - rb); const float inv = 1.0f / (w1 + w2);
                        const int lp1 = __hip_atomic_fetch_add(lcnt + e1, 1, __ATOMIC_RELAXED, __HIP_MEMORY_SCOPE_WORKGROUP), lp2 = __hip_atomic_fetch_add(lcnt + e2, 1, __ATOMIC_RELAXED, __HIP_MEMORY_SCOPE_WORKGROUP);
                        rt_row[slot] = r; rt_e[2 * slot] = e1; rt_e[2 * slot + 1] = e2; rt_lp[2 * slot] = lp1; rt_lp[2 * slot + 1] = lp2; rt_w[2 * slot] = w1 * inv; rt_w[2 * slot + 1] = w2 * inv; }
                }
            }
            __syncthreads();
            if (C.tid < 16) { const int n = lcnt[C.tid]; lcnt[16 + C.tid] = (n > 0) ? (int)__hip_atomic_fetch_add(cnt + 64 * C.tid, (unsigned)n, __ATOMIC_RELAXED, __HIP_MEMORY_SCOPE_AGENT) : 0; }
            __syncthreads();
            if (C.lane < re - rb) { const int slot = C.wave * 32 + C.lane, r = rt_row[slot];
#pragma unroll
                for (int q = 0; q < 2; ++q) { const int e = rt_e[2 * slot + q], p = lcnt[16 + e] + rt_lp[2 * slot + q];
                    liste[(size_t)e * T + p] = r; roww[(size_t)e * T + p] = rt_w[2 * slot + q]; tokpos[2 * r + q] = (e << 20) | p; } }
            __syncthreads();
          }
        }
        SEAM(P + 7);

        if (EN(9) && IN(P + 8)) {
#pragma unroll 1
          for (int rep = 0; rep < NREP(9); ++rep) {
            PH();
            expert_prefix(ctl + CW_CNT + l * 1024, mrow0, pfxl, C.tid);
            constexpr int SW = 0x01010101 * (127 - FP8_WEXP), SA0 = 0x7f7f7f7f;
            pg8::GroupedOrder S{pfxl, C.G, C.vcu, DM / 2, (size_t)1024 * 1024, 0};
            { const int* liste = (const int*)(ws + WS_ROUTE + RO_LISTE); const unsigned* cnt = ctl + CW_CNT + l * 1024; pg8::Unit u;
              { const int un = C.tid >> 8, t8 = C.tid & 255; pg8::Unit u0 = {0, 0, 0, 0}, u1 = {0, 0, 0, 0}; const bool v0 = S.next(un, u0), v1 = S.next(un + 2, u1);
                int g0 = mrow0, g1 = mrow0;
                if (v0) { const int idx = u0.lt * 256 + t8; g0 = (u0.e == 16) ? (mrow0 + idx) : ((idx < pfxl[40 + (u0.e & 15)]) ? liste[(size_t)u0.e * T + idx] : mrow0); }
                if (v1) { const int idx = u1.lt * 256 + t8; g1 = (u1.e == 16) ? (mrow0 + idx) : ((idx < pfxl[40 + (u1.e & 15)]) ? liste[(size_t)u1.e * T + idx] : mrow0); }
                if (v0) gtab[un * 256 + t8] = g0;
                if (v1) gtab[(un + 2) * 256 + t8] = g1; }
#pragma unroll 1
              for (int i = 4; i < 8 && S.next(i, u); ++i) if (C.tid < 256) { const int idx = u.lt * 256 + C.tid;
                  gtab[i * 256 + C.tid] = (u.e == 16) ? (mrow0 + idx) : ((idx < (int)cnt[64 * u.e]) ? liste[(size_t)u.e * T + idx] : mrow0); } }
            __syncthreads();
            pg8::EpiGlu E{HH};
            pg8::gemm_phase<pg8::EpiGlu, pg8::GroupedOrder, true, 2>(C.lds, R1, DM / 2, WB + WO_GU, DM / 2, S, E, gtab, SW, SA0, 1.0f / (float)(1 << (I8_AEXP + I8_WEXP)));
            if (l + 1 < NLAYER) { const int nu = 4 * __builtin_amdgcn_readfirstlane(pfxl[17]); if ((nu + C.G - 1 - C.vcu) / C.G < (nu + C.G - 1) / C.G) (void)convert_steal(C, l + 1, CONV_NQUEUE, 2); }
          }
        }
        SEAM(P + 8);

        if (EN(10) && IN(P + 9)) {
#pragma unroll 1
          for (int rep = 0; rep < NREP(10); ++rep) {
            PH();
            if (!IN(P + 8)) expert_prefix(ctl + CW_CNT + l * 1024, mrow0, pfxl, C.tid);
            constexpr int SW = 0x01010101 * (127 - FP8_WEXP), SA = 0x01010101 * (127 - FP8_AEXP);
            pg8::GroupedOrder S{pfxl, C.G, C.vcu, FF / 2, (size_t)1024 * 512, (size_t)256 * FF};
            pg8::EpiDown E{(unsigned char*)PROJ, (const float*)(ws + WS_ROUTE + RO_ROWW)};
            pg8::gemm_phase<pg8::EpiDown, pg8::GroupedOrder, false, 1>(C.lds, HH, FF / 2, WB + WO_DN, FF / 2, S, E, gtab, SW, SA);
            if (l + 1 < NLAYER) { const int nu = 4 * __builtin_amdgcn_readfirstlane(pfxl[17]); if ((nu + C.G - 1 - C.vcu) / C.G < (nu + C.G - 1) / C.G) (void)convert_steal(C, l + 1, CONV_NQUEUE, 2); }
          }
        }
        SEAM(P + 9);
    }

    if (EN(11) && IN(NPHASE - 1)) {
#pragma unroll 1
      for (int rep = 0; rep < NREP(11); ++rep) {
        const int l = NLAYER - 1; PH();
        if (!IN(NPHASE - 3)) expert_prefix(ctl + CW_CNT + (NLAYER - 1) * 1024, TC, pfxl, C.tid);
        LAS float* mt = (LAS float*)C.lds; mod_chunk_to_lds(mt, modl, 5, C.tid); __syncthreads();
        int rb, re; wave_rows(C.gw, C.NGW, TC, T, rb, re);
        constexpr int NB = 4;
        CombIdx cn[NB];
#pragma unroll
        for (int k = 0; k < NB; ++k) { const int r = (rb + k < re) ? rb + k : re - 1; cn[k] = comb_idx(C, r, pfxl, TC); }
        for (int r0 = rb; r0 < re; r0 += NB) {
            f32x4 v[NB][4]; unsigned y[NB][3][4]; CombIdx ci[NB];
#pragma unroll
            for (int k = 0; k < NB; ++k) { const int r = (r0 + k < re) ? r0 + k : re - 1; ci[k] = cn[k]; xs_load(XS + (size_t)r * DM, C.lane, v[k]); }
#pragma unroll
            for (int k = 0; k < NB; ++k) comb_load(C, ci[k], y[k]);
#pragma unroll
            for (int k = 0; k < NB; ++k) { const int r = (r0 + NB + k < re) ? r0 + NB + k : re - 1; cn[k] = comb_idx(C, r, pfxl, TC); }
#pragma unroll
            for (int k = 0; k < NB; ++k) if (r0 + k < re) { const int r = r0 + k, which = (r - TC) >> 12; comb_apply(C, mt + which * DM, y[k], v[k]); float* dst = COUT + (size_t)(r - TC) * DM;
#pragma unroll
                for (int j = 0; j < 4; ++j) *(f32x4*)(dst + j * 256 + 4 * C.lane) = v[k][j]; }
        }
      }
    }
#undef IN
#undef SEAM
}

#ifndef MK_PER_PHASE
#define MK_PER_PHASE 0
#endif
extern "C" void kernel_launch(void* const* d_in, const int* in_sizes, int n_in, void* d_out, int out_size, void* d_ws, size_t ws_size, hipStream_t stream) {
    static int grid = 0;
    if (grid == 0) {
        if (n_in != 28 || out_size != TL * DM || ws_size < WS_END) { fprintf(stderr, "kernel_launch: unexpected shapes (n_in %d, out %d, ws %zu)\n", n_in, out_size, ws_size); grid = -1; return; }
        int dev = 0, cus = 0, per_cu = 0;
        if (hipGetDevice(&dev) != hipSuccess || hipDeviceGetAttribute(&cus, hipDeviceAttributeMultiprocessorCount, dev) != hipSuccess) { grid = -1; return; }
        if (hipFuncSetAttribute((const void*)fwd_kernel, hipFuncAttributeMaxDynamicSharedMemorySize, LDS_BYTES) != hipSuccess) { fprintf(stderr, "kernel_launch: hipFuncSetAttribute failed\n"); grid = -1; return; }
        if (hipOccupancyMaxActiveBlocksPerMultiprocessor(&per_cu, (const void*)fwd_kernel, NTHR, LDS_BYTES) != hipSuccess || per_cu < 1) { fprintf(stderr, "kernel_launch: occupancy query says %d\n", per_cu); }
        (void)hipGetLastError();
        grid = cus;
    }
    if (grid < 0) return;
    (void)hipMemsetAsync((char*)d_ws + WS_CTL, 0, CTL_ZERO_BYTES, stream);
    Args a{};
    for (int i = 0; i < 28; ++i) a.in[i] = (const float*)d_in[i];
    a.out = (float*)d_out; a.ws = (unsigned char*)d_ws;
#if MK_PER_PHASE
    for (int p = 0; p < NPHASE; ++p) { a.ph_lo = p; a.ph_hi = p + 1; a.li = p; hipLaunchKernelGGL(fwd_kernel, dim3(grid), dim3(NTHR), LDS_BYTES, stream, a); }
#else
    a.ph_lo = 0; a.ph_hi = NPHASE; a.li = 0;
    hipLaunchKernelGGL(fwd_kernel, dim3(grid), dim3(NTHR), LDS_BYTES, stream, a);
#endif
}
```
